# Optimizing an MI355X kernel written in HIP

```python
import math
import jax, jax.numpy as jnp
from jax import lax
import numpy as np

D_MODEL = 2048
BATCH = 4
SEQ = 2048
DEPTH = 2

HEAD_DIM = 128
A_HEADS = 6
A_QK = 64
A_V = 128
B_HEADS = 5
MOBA_BLOCK = 256
MOBA_TOPK = 3
MOBA_QCHUNK = 32
C_HEADS = 5
IDX_HEADS = 16
IDX_DIM = 64
DSA_TOPK = 256
DSA_QBLOCK = 128
DENSE_QBLOCK = 128
ROPE_THETA = 500000.0
ROPE_FRAC = 4
EPS = 1e-6
N_GROUPS = 4
EXPERTS_PER_GROUP = 8
N_EXPERTS = N_GROUPS * EXPERTS_PER_GROUP
EXPERT_FF = 512
TOPK_IN_GROUP = 2

IN_SIZES = (
    A_HEADS * 2 * A_QK,
    A_HEADS * 2 * A_QK,
    A_HEADS * A_V,
    B_HEADS * HEAD_DIM,
    B_HEADS * HEAD_DIM,
    B_HEADS * HEAD_DIM,
    C_HEADS * HEAD_DIM,
    HEAD_DIM,
    HEAD_DIM,
    IDX_HEADS * IDX_DIM,
    IDX_DIM,
    IDX_HEADS,
)
IN_DIM = sum(IN_SIZES)
IN_OFFSETS = [int(v) for v in np.cumsum(IN_SIZES)[:-1]]
MIX_WIDTH = A_HEADS * A_V + B_HEADS * HEAD_DIM + C_HEADS * HEAD_DIM

kernel_name = "hybrid_diff_moba_dsa_hmoe"


def rms_norm(x, g):
    xf = x.astype(jnp.float32)
    y = xf * lax.rsqrt(jnp.mean(xf * xf, axis=-1, keepdims=True) + EPS)
    return (y * g.astype(jnp.float32)).astype(x.dtype)


def rope_tables(seq, dim):
    rot = dim // ROPE_FRAC
    inv = 1.0 / (ROPE_THETA ** (jnp.arange(0, rot, 2, dtype=jnp.float32) / rot))
    ang = jnp.arange(seq, dtype=jnp.float32)[:, None] * inv[None, :]
    return jnp.cos(ang), jnp.sin(ang)


def apply_partial_rope(x, cos, sin):
    half = cos.shape[-1]
    rot = 2 * half
    x1, x2, xp = x[..., :half], x[..., half:rot], x[..., rot:]
    c = cos.astype(x.dtype)
    s = sin.astype(x.dtype)
    return jnp.concatenate([x1 * c - x2 * s, x2 * c + x1 * s, xp], axis=-1)


def diff_attention(q, k, v, lam):
    b_, h_, _, s_, dq = q.shape
    nqb = s_ // DENSE_QBLOCK
    scale = dq ** -0.5
    q_blocks = jnp.moveaxis(q.reshape(b_, h_, 2, nqb, DENSE_QBLOCK, dq), 3, 0)
    kpos = jnp.arange(s_)

    def block(args):
        qblk, i = args
        qpos = i * DENSE_QBLOCK + jnp.arange(DENSE_QBLOCK)
        s = jnp.einsum('bhcqd,bhckd->bhcqk', qblk, k).astype(jnp.float32) * scale
        s = jnp.where(kpos[None, :] <= qpos[:, None], s, -jnp.inf)
        p = jax.nn.softmax(s, axis=-1)
        a = p[:, :, 0] - lam * p[:, :, 1]
        return jnp.einsum('bhqk,bhkd->bhqd', a.astype(v.dtype), v)

    o = lax.map(block, (q_blocks, jnp.arange(nqb)))
    return jnp.moveaxis(o, 0, 2).reshape(b_, h_, s_, v.shape[-1])


def moba_attention(q, k, v):
    b_, h_, s_, d = q.shape
    nblk = -(-s_ // MOBA_BLOCK)
    s_pad = nblk * MOBA_BLOCK
    pad = ((0, 0), (0, 0), (0, s_pad - s_), (0, 0))
    k_pad = jnp.pad(k, pad)
    v_pad = jnp.pad(v, pad)
    kb = k_pad.reshape(b_, h_, nblk, MOBA_BLOCK, d)
    vb = v_pad.reshape(b_, h_, nblk, MOBA_BLOCK, d)
    k_mean = jnp.mean(kb.astype(jnp.float32), axis=3)
    qpos = jnp.arange(s_)
    own_blk = qpos // MOBA_BLOCK
    gate = jnp.einsum('bhsd,bhnd->bhsn', q.astype(jnp.float32), k_mean)
    fully_past = jnp.arange(nblk)[None, :] < own_blk[:, None]
    gate = jnp.where(fully_past, gate, -jnp.inf)
    n_sel = min(MOBA_TOPK, nblk)
    _, sel = lax.top_k(gate, n_sel)
    sel_valid = jnp.arange(n_sel)[None, :] < jnp.minimum(own_blk, MOBA_TOPK)[:, None]
    scale = d ** -0.5
    nqc = s_ // MOBA_QCHUNK
    q_c = jnp.moveaxis(q.reshape(b_, h_, nqc, MOBA_QCHUNK, d), 2, 0)
    sel_c = jnp.moveaxis(sel.reshape(b_, h_, nqc, MOBA_QCHUNK, n_sel), 2, 0)
    valid_c = sel_valid.reshape(nqc, MOBA_QCHUNK, n_sel)
    bi = jnp.arange(b_)[:, None, None, None]
    hi = jnp.arange(h_)[None, :, None, None]
    own_off = jnp.arange(MOBA_BLOCK)

    def chunk(args):
        qc, sc, vc, i = args
        start = i * MOBA_QCHUNK
        qp = start + jnp.arange(MOBA_QCHUNK)
        kg = kb[bi, hi, sc]
        vg = vb[bi, hi, sc]
        s_past = jnp.einsum('bhqd,bhqnkd->bhqnk', qc, kg).astype(jnp.float32) * scale
        s_past = jnp.where(vc[None, None, :, :, None], s_past, -jnp.inf)
        s_past = s_past.reshape(b_, h_, MOBA_QCHUNK, n_sel * MOBA_BLOCK)
        own_start = (start // MOBA_BLOCK) * MOBA_BLOCK
        k_own = lax.dynamic_slice_in_dim(k_pad, own_start, MOBA_BLOCK, axis=2)
        v_own = lax.dynamic_slice_in_dim(v_pad, own_start, MOBA_BLOCK, axis=2)
        s_own = jnp.einsum('bhqd,bhkd->bhqk', qc, k_own).astype(jnp.float32) * scale
        s_own = jnp.where((own_start + own_off)[None, :] <= qp[:, None], s_own, -jnp.inf)
        p = jax.nn.softmax(jnp.concatenate([s_own, s_past], axis=-1), axis=-1).astype(v.dtype)
        p_own = p[..., :MOBA_BLOCK]
        p_past = p[..., MOBA_BLOCK:].reshape(b_, h_, MOBA_QCHUNK, n_sel, MOBA_BLOCK)
        return (jnp.einsum('bhqk,bhkd->bhqd', p_own, v_own)
                + jnp.einsum('bhqnk,bhqnkd->bhqd', p_past, vg))

    o = lax.map(chunk, (q_c, sel_c, valid_c, jnp.arange(nqc)))
    return jnp.moveaxis(o, 0, 2).reshape(b_, h_, s_, d)


def dsa_attention(q, k, v, qi, ki, wi):
    b_, h_, s_, d = q.shape
    n_sel = min(DSA_TOPK, s_ // 4)
    nqb = s_ // DSA_QBLOCK
    kpos = jnp.arange(s_)
    scale = d ** -0.5
    q_b = jnp.moveaxis(q.reshape(b_, h_, nqb, DSA_QBLOCK, d), 2, 0)
    qi_b = jnp.moveaxis(qi.reshape(b_, IDX_HEADS, nqb, DSA_QBLOCK, IDX_DIM), 2, 0)
    wi_b = jnp.moveaxis(wi.reshape(b_, nqb, DSA_QBLOCK, IDX_HEADS), 1, 0)

    def take_rows(arr, idx):
        return jax.vmap(lambda a, ix: a[ix])(arr, idx)

    def block(args):
        qb, qib, wb, i = args
        qp = i * DSA_QBLOCK + jnp.arange(DSA_QBLOCK)
        logits = jnp.einsum('bhqd,bsd->bhqs', qib, ki).astype(jnp.float32)
        idx_score = jnp.einsum('bqh,bhqs->bqs', wb.astype(jnp.float32), jax.nn.relu(logits))
        idx_score = jnp.where(kpos[None, :] <= qp[:, None], idx_score, -jnp.inf)
        top_val, top_idx = lax.top_k(idx_score, n_sel)
        valid = jnp.isfinite(top_val)
        kg = take_rows(k, top_idx)
        vg = take_rows(v, top_idx)
        s = jnp.einsum('bhqd,bqnd->bhqn', qb, kg).astype(jnp.float32) * scale
        s = jnp.where(valid[:, None], s, -jnp.inf)
        p = jax.nn.softmax(s, axis=-1).astype(v.dtype)
        return jnp.einsum('bhqn,bqnd->bhqd', p, vg)

    o = lax.map(block, (q_b, qi_b, wi_b, jnp.arange(nqb)))
    return jnp.moveaxis(o, 0, 2).reshape(b_, h_, s_, d)


def hier_moe(x, w_group, b_group, w_expert, b_expert, w_gate, w_up, w_down):
    b_, s_, dm = x.shape
    t = x.reshape(b_ * s_, dm)
    n_tok = t.shape[0]
    g_logits = (t @ w_group).astype(jnp.float32) + b_group.astype(jnp.float32)
    g_prob = jax.nn.softmax(g_logits, axis=-1)
    g_idx = jnp.argmax(g_logits, axis=-1)
    g_w = jnp.take_along_axis(g_prob, g_idx[:, None], axis=1)[:, 0]
    e_logits = (t @ w_expert).astype(jnp.float32) + b_expert.astype(jnp.float32)
    e_logits = e_logits.reshape(n_tok, N_GROUPS, EXPERTS_PER_GROUP)
    e_in_group = jnp.take_along_axis(e_logits, g_idx[:, None, None], axis=1)[:, 0]
    e_prob = jax.nn.softmax(e_in_group, axis=-1)
    top_v, top_i = lax.top_k(e_prob, TOPK_IN_GROUP)
    top_v = top_v / jnp.sum(top_v, axis=-1, keepdims=True)
    gate_vals = g_w[:, None] * top_v
    expert_id = g_idx[:, None] * EXPERTS_PER_GROUP + top_i
    combine = jnp.sum(jax.nn.one_hot(expert_id, N_EXPERTS, dtype=jnp.float32)
                      * gate_vals[..., None], axis=1).astype(x.dtype)
    hdn = (jax.nn.silu(jnp.einsum('td,edf->tef', t, w_gate))
           * jnp.einsum('td,edf->tef', t, w_up))
    y = jnp.einsum('tef,efd->td', hdn * combine[:, :, None], w_down)
    return y.reshape(b_, s_, dm)


def setup_inputs(seed: int = 0) -> dict:
    key = jax.random.key(seed)
    ks = jax.random.split(key, 21)
    f32 = jnp.float32

    def nrm(k, shape, scale):
        return jax.random.normal(k, shape, f32) * scale

    def gain(k, shape):
        return 1.0 + 0.05 * jax.random.normal(k, shape, f32)

    return {
        "x": nrm(ks[0], (BATCH, SEQ, D_MODEL), 1.0),
        "norm1_g": gain(ks[1], (DEPTH, D_MODEL)),
        "w_in": nrm(ks[2], (DEPTH, D_MODEL, IN_DIM), D_MODEL ** -0.5),
        "a_qn_g": gain(ks[3], (DEPTH, A_QK)),
        "a_kn_g": gain(ks[4], (DEPTH, A_QK)),
        "a_lambda": nrm(ks[5], (DEPTH, 4, A_QK), 0.1),
        "a_subln_g": gain(ks[6], (DEPTH, A_V)),
        "b_qn_g": gain(ks[7], (DEPTH, HEAD_DIM)),
        "b_kn_g": gain(ks[8], (DEPTH, HEAD_DIM)),
        "c_qn_g": gain(ks[9], (DEPTH, HEAD_DIM)),
        "c_kn_g": gain(ks[10], (DEPTH, HEAD_DIM)),
        "idx_kn_g": gain(ks[11], (DEPTH, IDX_DIM)),
        "w_out": nrm(ks[12], (DEPTH, MIX_WIDTH, D_MODEL), MIX_WIDTH ** -0.5),
        "norm2_g": gain(ks[13], (DEPTH, D_MODEL)),
        "w_group": nrm(ks[14], (DEPTH, D_MODEL, N_GROUPS), D_MODEL ** -0.5),
        "b_group": nrm(ks[15], (DEPTH, N_GROUPS), 0.01),
        "w_expert": nrm(ks[16], (DEPTH, D_MODEL, N_EXPERTS), D_MODEL ** -0.5),
        "b_expert": nrm(ks[17], (DEPTH, N_EXPERTS), 0.01),
        "w_gate": nrm(ks[18], (DEPTH, N_EXPERTS, D_MODEL, EXPERT_FF), D_MODEL ** -0.5),
        "w_up": nrm(ks[19], (DEPTH, N_EXPERTS, D_MODEL, EXPERT_FF), D_MODEL ** -0.5),
        "w_down": nrm(ks[20], (DEPTH, N_EXPERTS, EXPERT_FF, D_MODEL), EXPERT_FF ** -0.5),
    }


def reference(x, norm1_g, w_in, a_qn_g, a_kn_g, a_lambda, a_subln_g, b_qn_g, b_kn_g,
              c_qn_g, c_kn_g, idx_kn_g, w_out, norm2_g, w_group, b_group, w_expert,
              b_expert, w_gate, w_up, w_down):
    b_, s_, _ = x.shape
    cos64, sin64 = rope_tables(s_, A_QK)
    cos128, sin128 = rope_tables(s_, HEAD_DIM)
    idx_w_scale = (IDX_HEADS ** -0.5) * (IDX_DIM ** -0.5)

    for l in range(DEPTH):
        h = rms_norm(x, norm1_g[l])
        proj = h @ w_in[l]
        (qa, ka, va, qb, kb, vb, qc, kc, vc, qi, ki, wi) = jnp.split(proj, IN_OFFSETS, axis=-1)

        qa = qa.reshape(b_, s_, A_HEADS, 2, A_QK).transpose(0, 2, 3, 1, 4)
        ka = ka.reshape(b_, s_, A_HEADS, 2, A_QK).transpose(0, 2, 3, 1, 4)
        qa = apply_partial_rope(rms_norm(qa, a_qn_g[l]), cos64, sin64)
        ka = apply_partial_rope(rms_norm(ka, a_kn_g[l]), cos64, sin64)
        va = va.reshape(b_, s_, A_HEADS, A_V).transpose(0, 2, 1, 3)
        lam_init = 0.8 - 0.6 * math.exp(-0.3 * l)
        lp = a_lambda[l].astype(jnp.float32)
        lam = jnp.exp(jnp.sum(lp[0] * lp[1])) - jnp.exp(jnp.sum(lp[2] * lp[3])) + lam_init
        oa = diff_attention(qa, ka, va, lam)
        oa = rms_norm(oa, a_subln_g[l]) * (1.0 - lam_init)
        oa = oa.transpose(0, 2, 1, 3).reshape(b_, s_, A_HEADS * A_V)

        qb = qb.reshape(b_, s_, B_HEADS, HEAD_DIM).transpose(0, 2, 1, 3)
        kb = kb.reshape(b_, s_, B_HEADS, HEAD_DIM).transpose(0, 2, 1, 3)
        vb = vb.reshape(b_, s_, B_HEADS, HEAD_DIM).transpose(0, 2, 1, 3)
        qb = apply_partial_rope(rms_norm(qb, b_qn_g[l]), cos128, sin128)
        kb = apply_partial_rope(rms_norm(kb, b_kn_g[l]), cos128, sin128)
        ob = moba_attention(qb, kb, vb)
        ob = ob.transpose(0, 2, 1, 3).reshape(b_, s_, B_HEADS * HEAD_DIM)

        qc = qc.reshape(b_, s_, C_HEADS, HEAD_DIM).transpose(0, 2, 1, 3)
        qc = apply_partial_rope(rms_norm(qc, c_qn_g[l]), cos128, sin128)
        kc = apply_partial_rope(rms_norm(kc, c_kn_g[l]), cos128, sin128)
        qi = qi.reshape(b_, s_, IDX_HEADS, IDX_DIM).transpose(0, 2, 1, 3)
        qi = apply_partial_rope(qi, cos64, sin64)
        ki = apply_partial_rope(rms_norm(ki, idx_kn_g[l]), cos64, sin64)
        wi = wi * idx_w_scale
        oc = dsa_attention(qc, kc, vc, qi, ki, wi)
        oc = oc.transpose(0, 2, 1, 3).reshape(b_, s_, C_HEADS * HEAD_DIM)

        mix = jnp.concatenate([oa, ob, oc], axis=-1) @ w_out[l]
        x = x + mix

        x = x + hier_moe(rms_norm(x, norm2_g[l]), w_group[l], b_group[l], w_expert[l],
                         b_expert[l], w_gate[l], w_up[l], w_down[l])
    return x
```

```cpp
#include <hip/hip_runtime.h>
#include <cstdio>
#include <cstdint>

#ifndef DBG_VAR
#define DBG_VAR 0
#endif
#ifndef REPEAT_PH
#define REPEAT_PH -1
#endif
#ifndef MK_ONE_LAUNCH
#define MK_ONE_LAUNCH 1
#endif

#define LAS __attribute__((address_space(3)))
typedef unsigned short bf16_t;
typedef short bf16x8 __attribute__((ext_vector_type(8)));
typedef float f32x4 __attribute__((ext_vector_type(4)));
typedef float f32x16 __attribute__((ext_vector_type(16)));
typedef unsigned u32x4 __attribute__((ext_vector_type(4)));
typedef unsigned u32x2 __attribute__((ext_vector_type(2)));

constexpr int NB = 4, SEQ = 2048, DM = 2048, NT = NB * SEQ, NL = 2;
constexpr int IN_DIM = 6224, NPAD = 6400;
constexpr int OQA = 0, OKA = 768, OVA = 1536, OQB = 2304, OKB = 2944, OVB = 3584, OQC = 4224, OKC = 4864, OVC = 4992, OQI = 5120, OKI = 6144, OWI = 6208;
constexpr int NE = 32, FF = 512;
constexpr int HROWS = 24576;
constexpr float EPS = 1e-6f;
constexpr float LOG2E = 1.4426950408889634f;
constexpr int NTHR = 512;

constexpr size_t WS_CTL = 0;
constexpr size_t CTL_BYTES = 65536;
constexpr size_t WS_WIN = WS_CTL + CTL_BYTES;
constexpr size_t WS_WOUT = WS_WIN + (size_t)NL * NPAD * DM * 2;
constexpr size_t WS_W1 = WS_WOUT + (size_t)NL * DM * DM * 2;
constexpr size_t WS_WD = WS_W1 + (size_t)NL * NE * 1024 * DM * 2;
constexpr size_t WS_WR = WS_WD + (size_t)NL * NE * DM * FF * 2;
constexpr size_t WS_XB = WS_WR + (size_t)NL * 64 * DM * 4;
constexpr size_t WS_RSTD1 = WS_XB + (size_t)NT * DM * 2;
constexpr size_t WS_PROJ = WS_RSTD1 + (size_t)NT * 4;
constexpr size_t WS_Y = WS_PROJ;
constexpr size_t WS_QA = WS_PROJ + (size_t)NT * NPAD * 2;
constexpr size_t WS_KA = WS_QA + (size_t)NT * 768 * 2;
constexpr size_t WS_VAT = WS_KA + (size_t)NT * 768 * 2;
constexpr size_t WS_QB = WS_VAT + (size_t)NT * 768 * 2;
constexpr size_t WS_KB = WS_QB + (size_t)NT * 640 * 2;
constexpr size_t WS_VBT = WS_KB + (size_t)NT * 640 * 2;
constexpr size_t WS_KMEAN = WS_VBT + (size_t)NT * 640 * 2;
constexpr size_t WS_QC = WS_KMEAN + (size_t)NB * 5 * 8 * 128 * 4;
constexpr size_t WS_KC = WS_QC + (size_t)NT * 640 * 2;
constexpr size_t WS_VCT = WS_KC + (size_t)NT * 128 * 2;
constexpr size_t WS_QI = WS_VCT + (size_t)NT * 128 * 2;
constexpr size_t WS_KI = WS_QI + (size_t)NT * 1024 * 2;
constexpr size_t WS_WI = WS_KI + (size_t)NT * 64 * 2;
constexpr size_t WS_MASK = WS_WI + (size_t)NT * 16 * 4;
constexpr size_t WS_MIXO = WS_MASK + (size_t)NT * 64 * 4;
constexpr size_t WS_XM = WS_MIXO + (size_t)NT * DM * 2;
constexpr size_t WS_XMB = WS_XM + (size_t)NT * DM * 4;
constexpr size_t WS_TOKE = WS_XMB + (size_t)NT * DM * 2;
constexpr size_t WS_TOKP = WS_TOKE + (size_t)NT * 2 * 4;
constexpr size_t WS_RSTD2 = WS_TOKP + (size_t)NT * 2 * 4;
constexpr size_t WS_LIST = WS_RSTD2 + (size_t)NT * 4;
constexpr size_t WS_LISTG = WS_LIST + (size_t)NE * NT * 4;
constexpr size_t WS_H = WS_LISTG + (size_t)NE * NT * 4;
constexpr size_t WS_X1 = WS_H + (size_t)HROWS * FF * 2;
constexpr size_t WS_END = WS_X1 + (size_t)NT * DM * 4;
static_assert((size_t)HROWS * DM * 2 <= (size_t)NT * NPAD * 2, "Y must fit in PROJ");

constexpr int CW_BAR = 0;
constexpr int CW_CNT = 4096;
constexpr int CW_Q = 4096 + 64;

constexpr int LDS_STAGE = 131072;
constexpr int LDS_CTL = LDS_STAGE;
constexpr int LDS_BYTES = 147456;

__device__ __forceinline__ float bf2f(bf16_t b) { return __uint_as_float(((unsigned)b) << 16); }
__device__ __forceinline__ float bflo(unsigned w) { return __uint_as_float(w << 16); }
__device__ __forceinline__ float bfhi(unsigned w) { return __uint_as_float(w & 0xffff0000u); }
typedef __bf16 bf16x2_t __attribute__((ext_vector_type(2)));
__device__ __forceinline__ unsigned cvt_pk(float lo, float hi) { bf16x2_t v = {(__bf16)lo, (__bf16)hi}; return __builtin_bit_cast(unsigned, v); }
__device__ __forceinline__ float pairmax(float x) { auto r = __builtin_amdgcn_permlane32_swap(__float_as_uint(x), __float_as_uint(x), false, false); return fmaxf(__uint_as_float(r[0]), __uint_as_float(r[1])); }
__device__ __forceinline__ float pairsum(float x) { auto r = __builtin_amdgcn_permlane32_swap(__float_as_uint(x), __float_as_uint(x), false, false); return __uint_as_float(r[0]) + __uint_as_float(r[1]); }
__device__ __forceinline__ float wave_sum(float x) {
#pragma unroll
    for (int o = 32; o > 0; o >>= 1) x += __shfl_xor(x, o, 64);
    return x;
}
__device__ __forceinline__ int ltid() { int t = (int)threadIdx.x; asm volatile("" : "+v"(t)); return t; }
__device__ __forceinline__ int half_sum_i32(int v) {
    v += __builtin_amdgcn_update_dpp(0, v, 0xB1, 0xF, 0xF, true);
    v += __builtin_amdgcn_update_dpp(0, v, 0x4E, 0xF, 0xF, true);
    v += __builtin_amdgcn_update_dpp(0, v, 0x141, 0xF, 0xF, true);
    v += __builtin_amdgcn_update_dpp(0, v, 0x140, 0xF, 0xF, true);
    v += __shfl_xor(v, 16, 64);
    return v;
}
__device__ __forceinline__ unsigned ld_agent(const unsigned* p) { return __hip_atomic_load(p, __ATOMIC_RELAXED, __HIP_MEMORY_SCOPE_AGENT); }

#define XB_TMO      128
#define XB_XCNT(j)  (256  + 64 * (j))
#define XB_XSUB(j)  (1280 + 64 * (j))
#define XB_XGEN(j)  (2304 + 64 * (j))
#define XB_TOP      3328
#define XB_TOPGEN   3392
#define XCD_BAR_WORDS 3456
#define XB_SPIN_CAP (1u << 22)

__device__ __forceinline__ unsigned xb_ld(unsigned* p)              { return __hip_atomic_load(p, __ATOMIC_RELAXED, __HIP_MEMORY_SCOPE_AGENT); }
__device__ __forceinline__ unsigned xb_add(unsigned* p, unsigned v) { return __hip_atomic_fetch_add(p, v, __ATOMIC_RELAXED, __HIP_MEMORY_SCOPE_AGENT); }
__device__ __forceinline__ unsigned xb_xcc_id() { return (unsigned)__builtin_amdgcn_s_getreg((3 << 11) | 20) & 0xFu; }
#define XB_SPIN(cond, bar) do { unsigned _sp = 0; while (cond) { __builtin_amdgcn_s_sleep(1); \
    if ((++_sp & 255u) == 0u) { if (xb_ld(&(bar)[XB_TMO])) break; if (_sp > XB_SPIN_CAP) { atomicAdd(&(bar)[XB_TMO], 1u); break; } } } } while (0)

struct XcdBarrier { unsigned* bar; unsigned x; volatile LAS unsigned* st; };

__device__ __forceinline__ XcdBarrier xcd_barrier_post(unsigned* bar, volatile LAS unsigned* st) {
    XcdBarrier b; b.bar = bar; b.x = xb_xcc_id(); b.st = st;
    if (threadIdx.x == 0) (void)xb_add(&bar[XB_XCNT(b.x)], 1u);
    return b;
}
__device__ __forceinline__ void xcd_barrier_complete(unsigned* bar, unsigned x, unsigned& nloc, unsigned& nx) {
    const unsigned G = gridDim.x * gridDim.y * gridDim.z;
    unsigned sum, cnt, mine, sp = 0u;
    for (;;) {
        sum = 0u; cnt = 0u; mine = 0u;
#pragma unroll
        for (unsigned j = 0; j < 16; ++j) { const unsigned c = xb_ld(&bar[XB_XCNT(j)]); sum += c; cnt += (c > 0u) ? 1u : 0u; mine = (j == x) ? c : mine; }
        if (sum == G) break;
        __builtin_amdgcn_s_sleep(1);
        if ((++sp & 255u) == 0u) { if (xb_ld(&bar[XB_TMO])) break; if (sp > XB_SPIN_CAP) { atomicAdd(&bar[XB_TMO], 1u); break; } }
    }
    nloc = mine > 0u ? mine : 1u; nx = cnt > 0u ? cnt : 1u;
}
__device__ __forceinline__ void xcd_barrier(const XcdBarrier& b) {
    asm volatile("s_waitcnt vmcnt(0)" ::: "memory");
    __syncthreads();
    if (threadIdx.x == 0) {
        unsigned* bar = b.bar;
        __builtin_amdgcn_s_waitcnt(0);
        unsigned nloc = b.st[0], nx = b.st[1];
        if (nloc == 0u) { xcd_barrier_complete(bar, b.x, nloc, nx); b.st[0] = nloc; b.st[1] = nx; }
        const unsigned old = xb_add(&bar[XB_XSUB(b.x)], 1u);
        const unsigned gen = old / nloc;
        if (old + 1u == (gen + 1u) * nloc) {
            __builtin_amdgcn_fence(__ATOMIC_RELEASE, "agent");
            asm volatile("s_waitcnt vmcnt(0)" ::: "memory");
            const unsigned og = xb_add(&bar[XB_TOP], 1u);
            const unsigned tg = og / nx;
            if (og + 1u == (tg + 1u) * nx) xb_add(&bar[XB_TOPGEN], 1u);
            else XB_SPIN(xb_ld(&bar[XB_TOPGEN]) == tg, bar);
            __builtin_amdgcn_fence(__ATOMIC_ACQUIRE, "agent");
            xb_add(&bar[XB_XGEN(b.x)], 1u);
            asm volatile("s_waitcnt vmcnt(0)" ::: "memory");
        } else {
            XB_SPIN(xb_ld(&bar[XB_XGEN(b.x)]) == gen, bar);
            __builtin_amdgcn_fence(__ATOMIC_ACQUIRE, "agent");
            asm volatile("s_waitcnt vmcnt(0)" ::: "memory");
        }
    }
    __syncthreads();
}

struct Args { const float* in[21]; float* out; unsigned char* ws; int ph_lo, ph_hi; };
enum { I_X = 0, I_N1G, I_WIN, I_AQN, I_AKN, I_ALAM, I_ASUB, I_BQN, I_BKN, I_CQN, I_CKN, I_IKN, I_WOUT, I_N2G, I_WGRP, I_BGRP, I_WEXP, I_BEXP, I_WGATE, I_WUP, I_WDOWN };

__device__ __forceinline__ int next_unit(unsigned* ctr, volatile LAS int* slot) {
    __syncthreads();
    if (threadIdx.x == 0) *slot = (int)atomicAdd(ctr, 1u);
    __syncthreads();
    return *slot;
}

namespace pg8 {
constexpr int BM = 256, BK = 64, HALF = 128, HTB = HALF * BK * 2, STAGE_BYTES = 8 * HTB;
__device__ __forceinline__ int lds_byte(int r, int c) { const int st = (r >> 4) * 2 + (c >> 5), rr = r & 15, cc = c & 31, ob = rr * 64 + cc * 2; return st * 1024 + (ob ^ (((ob >> 9) & 1) << 5)); }
__device__ __forceinline__ void stage_rc(int b, int& R, int& C) { const int st = b / 1024, sb = b % 1024, swz = sb ^ (((sb >> 9) & 1) << 5); R = (st >> 1) * 16 + swz / 64; C = (st & 1) * 32 + (swz % 64) / 2; }

__device__ __forceinline__ int perm32(int rho) { const int n = rho >> 4, i = rho & 15; return 8 * (i >> 2) + 4 * n + (i & 3); }
struct Unit { const char* a; const char* b; int m0, n0, e, cnt; };

template <class Epi, class Sched>
__device__ __forceinline__ void gemm_phase(LAS unsigned char* lds, const int K, const Sched& S, const Epi& E) {
    const int tid = ltid(), wid = __builtin_amdgcn_readfirstlane(tid >> 6), lane = tid & 63, wr = wid >> 2, wc = wid & 3, fr = lane & 15, fq = lane >> 4;
    const int nt = K / BK;
    int Rst[2], Cst[2]; unsigned voffB[2];
#pragma unroll
    for (int i = 0; i < 2; ++i) { int R, C; stage_rc(tid * 16 + i * 8192, R, C); Rst[i] = R; Cst[i] = C; const int Rb = Epi::PERM ? ((R & ~31) + perm32(R & 31)) : R; voffB[i] = (unsigned)(Rb * K + C) * 2u; }
    const size_t kstep = (size_t)(BK * 2);
    const size_t hstep = (size_t)HALF * K * 2;
    const unsigned ldsw = (unsigned)wid * 1024u;
    const int aoff = lds_byte(wr * 64 + fr, fq * 8), boff = lds_byte(wc * 32 + fr, fq * 8);
#define PG8_SA(b, h) (((b) * 2 + (h)) * HTB)
#define PG8_SB(b, h) ((4 + (b) * 2 + (h)) * HTB)
#define PG8_STAGE2(bufoff, gbase, o0, o1) do { \
        __builtin_amdgcn_global_load_lds((const unsigned*)((const char*)(gbase) + (o0)), (LAS unsigned*)(lds + (bufoff) + ldsw), 16, 0, 0); \
        __builtin_amdgcn_global_load_lds((const unsigned*)((const char*)(gbase) + (o1)), (LAS unsigned*)(lds + (bufoff) + ldsw + 8192), 16, 0, 0); } while (0)
#define PG8_STAGEB(bufoff, gbase) PG8_STAGE2(bufoff, gbase, voffB[0], voffB[1])
#define PG8_LDA(dst, b, h) do { _Pragma("unroll") for (int m = 0; m < 4; ++m) _Pragma("unroll") for (int k = 0; k < 2; ++k) dst[m][k] = *(const LAS bf16x8*)(lds + PG8_SA(b, h) + aoff + m * 2048 + k * 1024); } while (0)
#define PG8_LDB(dst, b, h) do { _Pragma("unroll") for (int n = 0; n < 2; ++n) _Pragma("unroll") for (int k = 0; k < 2; ++k) dst[n][k] = *(const LAS bf16x8*)(lds + PG8_SB(b, h) + boff + n * 2048 + k * 1024); } while (0)
#define PG8_MMA(ai, bj, At, Bt) do { __builtin_amdgcn_s_setprio(1); _Pragma("unroll") for (int m = 0; m < 4; ++m) _Pragma("unroll") for (int n = 0; n < 2; ++n) _Pragma("unroll") for (int k = 0; k < 2; ++k) \
        acc[ai][bj][m][n] = __builtin_amdgcn_mfma_f32_16x16x32_bf16(Bt[n][k], At[m][k], acc[ai][bj][m][n], 0, 0, 0); __builtin_amdgcn_s_setprio(0); } while (0)
#define PG8_WAIT_V(n) asm volatile("s_waitcnt vmcnt(" #n ")" ::: "memory")
#define PG8_WAIT_L(n) asm volatile("s_waitcnt lgkmcnt(" #n ")" ::: "memory")
#define PG8_BAR __builtin_amdgcn_s_barrier()
#define PG8_SCHED __builtin_amdgcn_sched_barrier(0)
    Unit cur, nxt; int ui = 0;
    if (!S.next(0, cur)) return;
    f32x4 acc[2][2][4][2];
#pragma unroll
    for (int a = 0; a < 2; ++a)
#pragma unroll
        for (int b = 0; b < 2; ++b)
#pragma unroll
            for (int m = 0; m < 4; ++m)
#pragma unroll
                for (int n = 0; n < 2; ++n) acc[a][b][m][n] = (f32x4){0.f, 0.f, 0.f, 0.f};
    bf16x8 At[4][2], B0[2][2], B1[2][2];
    unsigned c00, c01, c10, c11, n00, n01, n10, n11;
    c00 = S.arow(cur, Rst[0]) + Cst[0] * 2; c01 = S.arow(cur, Rst[1]) + Cst[1] * 2; c10 = S.arow(cur, 128 + Rst[0]) + Cst[0] * 2; c11 = S.arow(cur, 128 + Rst[1]) + Cst[1] * 2;
    const char* cA = cur.a; const char* cB = cur.b;
    PG8_STAGEB(PG8_SB(0, 0), cB); PG8_STAGE2(PG8_SA(0, 0), cA, c00, c01); PG8_STAGEB(PG8_SB(0, 1), cB + hstep); PG8_STAGE2(PG8_SA(0, 1), cA, c10, c11);
    if (wr == 1) PG8_BAR;
    PG8_WAIT_V(4); PG8_BAR;
    PG8_STAGEB(PG8_SB(1, 0), cB + kstep); PG8_STAGE2(PG8_SA(1, 0), cA + kstep, c00, c01); PG8_STAGEB(PG8_SB(1, 1), cB + hstep + kstep);
    PG8_WAIT_V(6); PG8_BAR;
    for (;;) {
        const bool has_next = S.next(ui + 1, nxt);
        const char* nA = cA; const char* nB = cB; n00 = c00; n01 = c01; n10 = c10; n11 = c11;
        if (has_next) { nA = nxt.a; nB = nxt.b;
            n00 = S.arow(nxt, Rst[0]) + Cst[0] * 2; n01 = S.arow(nxt, Rst[1]) + Cst[1] * 2; n10 = S.arow(nxt, 128 + Rst[0]) + Cst[0] * 2; n11 = S.arow(nxt, 128 + Rst[1]) + Cst[1] * 2; }
        for (int t = 0; t < nt; t += 2) {
            const bool last = (t == nt - 2);
            const char* a1 = cA + (size_t)(t + 1) * kstep;
            const char* a2 = last ? nA : cA + (size_t)(t + 2) * kstep; const char* b2 = last ? nB : cB + (size_t)(t + 2) * kstep;
            const char* a3 = a2 + kstep; const char* b3 = b2 + kstep;
            const unsigned o00 = last ? n00 : c00, o01 = last ? n01 : c01, o10 = last ? n10 : c10, o11 = last ? n11 : c11;
            PG8_LDB(B0, 0, 0); PG8_SCHED; PG8_LDA(At, 0, 0); PG8_STAGE2(PG8_SA(1, 1), a1, c10, c11);
            PG8_WAIT_L(8); PG8_BAR; PG8_WAIT_L(0); PG8_MMA(0, 0, At, B0); PG8_BAR; PG8_SCHED;
            PG8_LDB(B1, 0, 1); PG8_STAGEB(PG8_SB(0, 0), b2);
            PG8_BAR; PG8_WAIT_L(0); PG8_MMA(0, 1, At, B1); PG8_BAR;
            PG8_LDA(At, 0, 1); PG8_STAGE2(PG8_SA(0, 0), a2, o00, o01);
            PG8_BAR; PG8_WAIT_L(0); PG8_MMA(1, 0, At, B0); PG8_BAR; PG8_SCHED;
            PG8_STAGEB(PG8_SB(0, 1), b2 + hstep);
            PG8_WAIT_V(6); PG8_BAR; PG8_MMA(1, 1, At, B1); PG8_BAR;
            PG8_LDB(B0, 1, 0); PG8_SCHED; PG8_LDA(At, 1, 0); PG8_STAGE2(PG8_SA(0, 1), a2, o10, o11);
            PG8_WAIT_L(8); PG8_BAR; PG8_WAIT_L(0); PG8_MMA(0, 0, At, B0); PG8_BAR; PG8_SCHED;
            PG8_LDB(B1, 1, 1); PG8_STAGEB(PG8_SB(1, 0), b3);
            PG8_BAR; PG8_WAIT_L(0); PG8_MMA(0, 1, At, B1); PG8_BAR;
            PG8_LDA(At, 1, 1); PG8_STAGE2(PG8_SA(1, 0), a3, o00, o01);
            PG8_BAR; PG8_WAIT_L(0); PG8_MMA(1, 0, At, B0); PG8_BAR; PG8_SCHED;
            PG8_STAGEB(PG8_SB(1, 1), b3 + hstep);
            PG8_WAIT_V(6); PG8_BAR; PG8_MMA(1, 1, At, B1); PG8_BAR;
        }
        E(acc, cur, wr, wc, fr, fq);
        if (!has_next) break;
#pragma unroll
        for (int a = 0; a < 2; ++a)
#pragma unroll
            for (int b = 0; b < 2; ++b)
#pragma unroll
                for (int m = 0; m < 4; ++m)
#pragma unroll
                    for (int n = 0; n < 2; ++n) acc[a][b][m][n] = (f32x4){0.f, 0.f, 0.f, 0.f};
        cur = nxt; cA = nA; cB = nB; c00 = n00; c01 = n01; c10 = n10; c11 = n11; ++ui;
    }
    PG8_WAIT_V(0);
    if (wr == 0) PG8_BAR;
    PG8_BAR;
#undef PG8_SA
#undef PG8_SB
#undef PG8_STAGE2
#undef PG8_STAGEB
#undef PG8_LDA
#undef PG8_LDB
#undef PG8_MMA
#undef PG8_WAIT_V
#undef PG8_WAIT_L
#undef PG8_BAR
#undef PG8_SCHED
}

struct DenseSched {
    const char* A; const char* Bt; int K, nM, nN, nwg, G, c;
    __device__ __forceinline__ void init(const void* A_, const void* Bt_, int M, int N, int K_, int G_, int c_) { A = (const char*)A_; Bt = (const char*)Bt_; K = K_; nM = M / BM; nN = N / BM; nwg = nM * nN; G = G_; c = c_; }
    __device__ __forceinline__ bool next(int i, Unit& u) const {
        const long L = (long)i * G + c; if (L >= nwg) return false;
        int wgid = (int)L; { const int q = nwg / 8, r = nwg % 8, xcd = wgid % 8, off = wgid / 8; wgid = (xcd < r ? xcd * (q + 1) : r * (q + 1) + (xcd - r) * q) + off; }
        const int nig = 8 * nN, gid = wgid / nig, fm = gid * 8, gsz = (nM - fm) < 8 ? (nM - fm) : 8;
        const int pm = fm + ((wgid % nig) % gsz), pn = (wgid % nig) / gsz;
        u.m0 = pm * BM; u.n0 = pn * BM; u.e = 0; u.cnt = 0;
        u.a = A + (size_t)u.m0 * K * 2; u.b = Bt + (size_t)u.n0 * K * 2; return true;
    }
    __device__ __forceinline__ unsigned arow(const Unit&, int r) const { return (unsigned)(r * K) * 2u; }
};

template <bool GATHER>
struct MoeSched {
    const char* A; const char* Bt; const int* list; volatile LAS int* tpre; volatile LAS int* cnt; int K, NPN, ntiles, G, c; size_t bstride;
    __device__ __forceinline__ bool next(int i, Unit& u) const {
        const long L = (long)i * G + c; if (L >= (long)ntiles * NPN) return false;
        const int mg = (int)(L / NPN), pn = (int)(L % NPN);
        int e = 0;
#pragma unroll 1
        for (int j = 1; j < NE; ++j) e = (tpre[j] <= mg) ? j : e;
        e = __builtin_amdgcn_readfirstlane(e);
        u.e = e; u.m0 = (mg - tpre[e]) * BM; u.cnt = cnt[e]; u.n0 = pn * BM;
        u.b = Bt + (size_t)e * bstride + (size_t)u.n0 * K * 2;
        if (GATHER) u.a = A; else u.a = A + (size_t)mg * BM * K * 2;
        return true;
    }
    __device__ __forceinline__ unsigned arow(const Unit& u, int r) const {
        if (GATHER) { int m = u.m0 + r; m = m < u.cnt ? m : u.m0; const int tok = list[(size_t)u.e * NT + m]; return (unsigned)(tok * K) * 2u; }
        return (unsigned)(r * K) * 2u;
    }
};
}

struct EpiProj {
    static constexpr bool PERM = true;
    bf16_t* out; const float* rstd;
    __device__ __forceinline__ void operator()(const f32x4 (&acc)[2][2][4][2], const pg8::Unit& u, int wr, int wc, int fr, int fq) const {
        float rs[2][4];
#pragma unroll
        for (int ai = 0; ai < 2; ++ai)
#pragma unroll
            for (int m = 0; m < 4; ++m) rs[ai][m] = rstd[u.m0 + 128 * ai + 64 * wr + 16 * m + fr];
        __builtin_amdgcn_sched_barrier(0);
#pragma unroll
        for (int ai = 0; ai < 2; ++ai)
#pragma unroll
            for (int m = 0; m < 4; ++m) {
                const int row = u.m0 + 128 * ai + 64 * wr + 16 * m + fr;
                bf16_t* rp = out + (size_t)row * NPAD + u.n0 + 32 * wc + 8 * fq;
#pragma unroll
                for (int bj = 0; bj < 2; ++bj) { const f32x4 v0 = acc[ai][bj][m][0] * rs[ai][m], v1 = acc[ai][bj][m][1] * rs[ai][m];
                    u32x4 w = {cvt_pk(v0[0], v0[1]), cvt_pk(v0[2], v0[3]), cvt_pk(v1[0], v1[1]), cvt_pk(v1[2], v1[3])}; *(u32x4*)(rp + 128 * bj) = w; }
            }
    }
};
struct EpiOut {
    static constexpr bool PERM = true;
    const float* xin; float* xm; bf16_t* xmb;
    __device__ __forceinline__ void operator()(const f32x4 (&acc)[2][2][4][2], const pg8::Unit& u, int wr, int wc, int fr, int fq) const {
#pragma unroll
        for (int ai = 0; ai < 2; ++ai) {
            f32x4 xv[4][2][2];
#pragma unroll
            for (int m = 0; m < 4; ++m) { const int row = u.m0 + 128 * ai + 64 * wr + 16 * m + fr; const size_t o = (size_t)row * DM + u.n0 + 32 * wc + 8 * fq;
#pragma unroll
                for (int bj = 0; bj < 2; ++bj)
#pragma unroll
                    for (int n = 0; n < 2; ++n) xv[m][bj][n] = *(const f32x4*)(xin + o + 128 * bj + 4 * n); }
            __builtin_amdgcn_sched_barrier(0);
#pragma unroll
            for (int m = 0; m < 4; ++m) { const int row = u.m0 + 128 * ai + 64 * wr + 16 * m + fr; const size_t o = (size_t)row * DM + u.n0 + 32 * wc + 8 * fq;
#pragma unroll
                for (int bj = 0; bj < 2; ++bj) { const size_t oo = o + 128 * bj; const f32x4 v0 = acc[ai][bj][m][0] + xv[m][bj][0], v1 = acc[ai][bj][m][1] + xv[m][bj][1];
                    *(f32x4*)(xm + oo) = v0; *(f32x4*)(xm + oo + 4) = v1;
                    u32x4 w = {cvt_pk(v0[0], v0[1]), cvt_pk(v0[2], v0[3]), cvt_pk(v1[0], v1[1]), cvt_pk(v1[2], v1[3])}; *(u32x4*)(xmb + oo) = w; } }
            __builtin_amdgcn_sched_barrier(0);
        }
    }
};
struct EpiUp {
    static constexpr bool PERM = true;
    bf16_t* H; const int* list; const float* listg; const float* rstd2; volatile LAS int* tpre;
    __device__ __forceinline__ void operator()(const f32x4 (&acc)[2][2][4][2], const pg8::Unit& u, int wr, int wc, int fr, int fq) const {
        const int rowbase = tpre[u.e] * 256;
        int tok[2][4]; float gv[2][4], rs[2][4];
#pragma unroll
        for (int ai = 0; ai < 2; ++ai)
#pragma unroll
            for (int m = 0; m < 4; ++m) { int mr = u.m0 + 128 * ai + 64 * wr + 16 * m + fr; mr = mr < u.cnt ? mr : u.m0; tok[ai][m] = list[(size_t)u.e * NT + mr]; gv[ai][m] = listg[(size_t)u.e * NT + mr]; }
        __builtin_amdgcn_sched_barrier(0);
#pragma unroll
        for (int ai = 0; ai < 2; ++ai)
#pragma unroll
            for (int m = 0; m < 4; ++m) rs[ai][m] = rstd2[tok[ai][m]];
        __builtin_amdgcn_sched_barrier(0);
#pragma unroll
        for (int ai = 0; ai < 2; ++ai)
#pragma unroll
            for (int m = 0; m < 4; ++m) {
                const int mr = u.m0 + 128 * ai + 64 * wr + 16 * m + fr;
                if (mr < u.cnt) {
                    bf16_t* rp = H + (size_t)(rowbase + mr) * FF + (u.n0 >> 1) + 32 * wc + 8 * fq;
                    float h[8];
#pragma unroll
                    for (int n = 0; n < 2; ++n) { const f32x4 g = acc[ai][0][m][n] * rs[ai][m], up = acc[ai][1][m][n] * rs[ai][m];
#pragma unroll
                        for (int j = 0; j < 4; ++j) { const float s = g[j] / (1.f + __expf(-g[j])); h[4 * n + j] = s * up[j] * gv[ai][m]; } }
                    u32x4 w = {cvt_pk(h[0], h[1]), cvt_pk(h[2], h[3]), cvt_pk(h[4], h[5]), cvt_pk(h[6], h[7])}; *(u32x4*)rp = w;
                }
            }
    }
};
struct EpiDown {
    static constexpr bool PERM = true;
    bf16_t* Y; volatile LAS int* tpre;
    __device__ __forceinline__ void operator()(const f32x4 (&acc)[2][2][4][2], const pg8::Unit& u, int wr, int wc, int fr, int fq) const {
        const int rowbase = tpre[u.e] * 256;
#pragma unroll
        for (int ai = 0; ai < 2; ++ai)
#pragma unroll
            for (int m = 0; m < 4; ++m) {
                const int mr = u.m0 + 128 * ai + 64 * wr + 16 * m + fr;
                if (mr < u.cnt) {
                    bf16_t* rp = Y + (size_t)(rowbase + mr) * DM + u.n0 + 32 * wc + 8 * fq;
#pragma unroll
                    for (int bj = 0; bj < 2; ++bj) { const f32x4 v0 = acc[ai][bj][m][0], v1 = acc[ai][bj][m][1];
                        u32x4 w = {cvt_pk(v0[0], v0[1]), cvt_pk(v0[2], v0[3]), cvt_pk(v1[0], v1[1]), cvt_pk(v1[2], v1[3])}; *(u32x4*)(rp + 128 * bj) = w; }
                }
            }
    }
};

struct CvtJob { const float* src; const float* gain; bf16_t* dst; int ld, nvalid, k0, n0; size_t dst_ld, dst_row0; };
__device__ __forceinline__ void cvt_decode(const Args& a, int job, CvtJob& J) {
    unsigned char* ws = a.ws;
    constexpr int J_W1 = NL * NE * 2 * 16 * 8, J_WD = NL * NE * 4 * 32, J_WIN = NL * 16 * 100;
    int j = job;
    if (j < J_W1) {
        const int nt = j & 7; j >>= 3; const int kt = j & 15; j >>= 4; const int which = j & 1; j >>= 1; const int e = j & 31; const int l = j >> 5;
        const int f0 = nt * 64;
        J.src = (which ? a.in[I_WUP] : a.in[I_WGATE]) + ((size_t)(l * NE + e)) * DM * FF; J.gain = a.in[I_N2G] + l * DM;
        J.dst = (bf16_t*)(ws + WS_W1) + ((size_t)(l * NE + e)) * 1024 * DM; J.ld = FF; J.nvalid = FF; J.k0 = kt * 128; J.n0 = f0; J.dst_ld = DM;
        J.dst_row0 = (size_t)((f0 >> 7) * 256 + which * 128 + (f0 & 127));
    } else if ((j -= J_W1) < J_WD) {
        const int nt = j & 31; j >>= 5; const int kt = j & 3; j >>= 2; const int e = j & 31; const int l = j >> 5;
        J.src = a.in[I_WDOWN] + ((size_t)(l * NE + e)) * FF * DM; J.gain = nullptr;
        J.dst = (bf16_t*)(ws + WS_WD) + ((size_t)(l * NE + e)) * DM * FF; J.ld = DM; J.nvalid = DM; J.k0 = kt * 128; J.n0 = nt * 64; J.dst_ld = FF; J.dst_row0 = (size_t)(nt * 64);
    } else if ((j -= J_WD) < J_WIN) {
        const int nt = j % 100; j /= 100; const int kt = j & 15; const int l = j >> 4;
        J.src = a.in[I_WIN] + (size_t)l * DM * IN_DIM; J.gain = a.in[I_N1G] + l * DM;
        J.dst = (bf16_t*)(ws + WS_WIN) + (size_t)l * NPAD * DM; J.ld = IN_DIM; J.nvalid = IN_DIM; J.k0 = kt * 128; J.n0 = nt * 64; J.dst_ld = DM; J.dst_row0 = (size_t)(nt * 64);
    } else {
        j -= J_WIN; const int nt = j & 31; j >>= 5; const int kt = j & 15; const int l = j >> 4;
        J.src = a.in[I_WOUT] + (size_t)l * DM * DM; J.gain = nullptr;
        J.dst = (bf16_t*)(ws + WS_WOUT) + (size_t)l * DM * DM; J.ld = DM; J.nvalid = DM; J.k0 = kt * 128; J.n0 = nt * 64; J.dst_ld = DM; J.dst_row0 = (size_t)(nt * 64);
    }
}
__device__ __forceinline__ void cvt_load(const CvtJob& J, int tid, f32x4 (&v)[4], float (&g)[4]) {
    const int kk = tid >> 4, nn = (tid & 15) * 4;
#pragma unroll
    for (int i = 0; i < 4; ++i) { const int k = J.k0 + kk + 32 * i;
        float z = 0.f; asm volatile("" : "+v"(z));
        v[i] = (f32x4){z, z, z, z};
        if (J.n0 + nn < J.nvalid) v[i] = *(const f32x4*)(J.src + (size_t)k * J.ld + J.n0 + nn);
        g[i] = J.gain ? J.gain[k] : 1.f; }
}
__device__ __forceinline__ void cvt_store(LAS unsigned char* lds, const CvtJob& J, int tid, const f32x4 (&v)[4], const float (&g)[4]) {
    LAS bf16_t* T = (LAS bf16_t*)lds;
    constexpr int P = 130;
    { const int kk = tid >> 4, nn = (tid & 15) * 4;
#pragma unroll
      for (int i = 0; i < 4; ++i) { const int k = kk + 32 * i; const f32x4 x = v[i] * g[i];
          const unsigned w0 = cvt_pk(x[0], x[1]), w1 = cvt_pk(x[2], x[3]);
          T[(nn + 0) * P + k] = (bf16_t)(w0 & 0xffffu); T[(nn + 1) * P + k] = (bf16_t)(w0 >> 16);
          T[(nn + 2) * P + k] = (bf16_t)(w1 & 0xffffu); T[(nn + 3) * P + k] = (bf16_t)(w1 >> 16); } }
    __syncthreads();
    { const int n = tid >> 3, kc = (tid & 7) * 16;
      const LAS unsigned* rp = (const LAS unsigned*)(T + n * P + kc);
      u32x4 a = {rp[0], rp[1], rp[2], rp[3]}, b = {rp[4], rp[5], rp[6], rp[7]};
      bf16_t* dp = J.dst + (J.dst_row0 + n) * J.dst_ld + J.k0 + kc;
      *(u32x4*)dp = a; *(u32x4*)(dp + 8) = b; }
    __syncthreads();
}

constexpr int DEF_LO = NE * 2 * 16 * 8, DEF_N = 6400, DEF_HI = DEF_LO + DEF_N;
constexpr int DEF_QUOTA = 32;
constexpr int DEF2_LO = NL * NE * 2 * 16 * 8 + NE * 4 * 32, DEF2_N = 0, DEF2_HI = DEF2_LO + DEF2_N;
__device__ __forceinline__ void cvt_deferred(const Args& a, LAS unsigned char* lds, int s_rank, int ns, const int DLO, const int DN) {
    const int tid = ltid();
    CvtJob J0, J1; f32x4 v0[4], v1[4]; float g0[4], g1[4];
#pragma unroll
    for (int i = 0; i < 4; ++i) { v0[i] = (f32x4){0.f, 0.f, 0.f, 0.f}; v1[i] = v0[i]; g0[i] = 0.f; g1[i] = 0.f; }
    int job = s_rank;
    if (job < DN) { cvt_decode(a, DLO + job, J0); cvt_load(J0, tid, v0, g0); }
    for (; job < DN; job += 2 * ns) {
        const bool h1 = (job + ns) < DN;
        if (h1) { cvt_decode(a, DLO + job + ns, J1); cvt_load(J1, tid, v1, g1); }
        cvt_store(lds, J0, tid, v0, g0);
        const bool h2 = (job + 2 * ns) < DN;
        if (h2) { cvt_decode(a, DLO + job + 2 * ns, J0); cvt_load(J0, tid, v0, g0); }
        if (h1) cvt_store(lds, J1, tid, v1, g1);
    }
}
__device__ __forceinline__ void p0_prologue(const Args& a, LAS unsigned char* lds) {
    unsigned char* ws = a.ws;
    const int G = gridDim.x, bx = blockIdx.x, tid = ltid();
    constexpr int J_ALL = NL * NE * 2 * 16 * 8 + NL * NE * 4 * 32 + NL * 16 * 100 + NL * 16 * 32;
    constexpr int J_RUN = J_ALL - DEF_N - DEF2_N;
#define PRO_ID(j) ((j) < DEF_LO ? (j) : ((j) + DEF_N < DEF2_LO ? (j) + DEF_N : (j) + DEF_N + DEF2_N))
    {
        CvtJob J0, J1; f32x4 v0[4], v1[4]; float g0[4], g1[4];
        int job = bx;
        if (job < J_RUN) { cvt_decode(a, PRO_ID(job), J0); cvt_load(J0, tid, v0, g0); }
        for (; job < J_RUN; job += 2 * G) {
            const bool h1 = (job + G) < J_RUN;
            if (h1) { cvt_decode(a, PRO_ID(job + G), J1); cvt_load(J1, tid, v1, g1); }
            cvt_store(lds, J0, tid, v0, g0);
            const bool h2 = (job + 2 * G) < J_RUN;
            if (h2) { cvt_decode(a, PRO_ID(job + 2 * G), J0); cvt_load(J0, tid, v0, g0); }
            if (h1) cvt_store(lds, J1, tid, v1, g1);
        }
    }
#undef PRO_ID
    for (int i = bx * NTHR + tid; i < NL * 36 * DM; i += G * NTHR) {
        const int k = i % DM; const int jj = (i / DM) % 36; const int l = i / (DM * 36);
        const float g = a.in[I_N2G][l * DM + k];
        const float w = jj < 4 ? a.in[I_WGRP][((size_t)l * DM + k) * 4 + jj] : a.in[I_WEXP][((size_t)l * DM + k) * 32 + (jj - 4)];
        ((float*)(ws + WS_WR))[((size_t)l * 64 + (jj < 4 ? 32 + jj : jj - 4)) * DM + k] = g * w;
    }
    { const int wave = tid >> 6, lane = tid & 63;
      for (int row = bx * 8 + wave; row < NT; row += G * 8) {
          const float* xp = a.in[I_X] + (size_t)row * DM; bf16_t* bp = (bf16_t*)(ws + WS_XB) + (size_t)row * DM; float ss = 0.f;
          f32x4 xv[8];
#pragma unroll
          for (int i = 0; i < 8; ++i) xv[i] = *(const f32x4*)(xp + i * 256 + lane * 4);
          __builtin_amdgcn_sched_barrier(0);
#pragma unroll
          for (int i = 0; i < 8; ++i) { const f32x4 v = xv[i]; ss += v[0] * v[0] + v[1] * v[1] + v[2] * v[2] + v[3] * v[3];
              u32x2 w = {cvt_pk(v[0], v[1]), cvt_pk(v[2], v[3])}; *(u32x2*)(bp + i * 256 + lane * 4) = w; }
          ss = wave_sum(ss);
          if (lane == 0) ((float*)(ws + WS_RSTD1))[row] = rsqrtf(ss * (1.f / DM) + EPS);
      } }
}

template <int HALFR>
__device__ __forceinline__ void rope_inplace(float* v, int pos) {
#pragma unroll
    for (int i = 0; i < HALFR; ++i) {
        const float inv = exp2f(-(float)(2 * i) / (float)(2 * HALFR) * 18.931568569324174f);
        const float ang = (float)pos * inv;
        float t = ang * 0.15915494309189535f; t -= rintf(t);
        const float s = __builtin_amdgcn_sinf(t), c = __builtin_amdgcn_cosf(t);
        const float x1 = v[i], x2 = v[i + HALFR];
        v[i] = x1 * c - x2 * s; v[i + HALFR] = x2 * c + x1 * s;
    }
}
__device__ __forceinline__ void load64(const bf16_t* p, float* v) {
#pragma unroll
    for (int i = 0; i < 8; ++i) { const u32x4 w = *(const u32x4*)(p + i * 8);
#pragma unroll
        for (int j = 0; j < 4; ++j) { v[i * 8 + 2 * j] = bflo(w[j]); v[i * 8 + 2 * j + 1] = bfhi(w[j]); } }
}
__device__ __forceinline__ void store64(bf16_t* p, const float* v) {
#pragma unroll
    for (int i = 0; i < 8; ++i) { u32x4 w;
#pragma unroll
        for (int j = 0; j < 4; ++j) w[j] = cvt_pk(v[i * 8 + 2 * j], v[i * 8 + 2 * j + 1]);
        *(u32x4*)(p + i * 8) = w; }
}

__device__ __forceinline__ void p2_prep(const Args& a, int l, LAS unsigned char* lds) {
    unsigned char* ws = a.ws;
    const int G = gridDim.x, bx = blockIdx.x, tid = ltid(), wave = tid >> 6, lane = tid & 63;
    const bf16_t* PROJ = (const bf16_t*)(ws + WS_PROJ);
    constexpr int NJOB = 49;
    for (int unit = bx; unit < 32 * NJOB; unit += G) {
        const int rb = unit / NJOB, job = unit % NJOB;
        const int b = rb >> 3, blk = rb & 7, s0 = blk * 256, tok0 = rb * 256;
        const bool is_v = (job >= 12 && job < 18) || (job >= 28 && job < 33) || job == 39;
        if (is_v) {
            int col0; bf16_t* dst;
            if (job < 18) { const int h = job - 12; col0 = OVA + h * 128; dst = (bf16_t*)(ws + WS_VAT) + ((size_t)(b * 6 + h) * 128) * SEQ; }
            else if (job < 33) { const int h = job - 28; col0 = OVB + h * 128; dst = (bf16_t*)(ws + WS_VBT) + ((size_t)(b * 5 + h) * 128) * SEQ; }
            else { col0 = OVC; dst = (bf16_t*)(ws + WS_VCT) + ((size_t)b * 128) * SEQ; }
            { const int c = tid & 15;
#pragma unroll
              for (int i = 0; i < 8; ++i) { const int t = (tid >> 4) + 32 * i;
                  const u32x4 w = *(const u32x4*)(PROJ + (size_t)(tok0 + t) * NPAD + col0 + c * 8);
                  *(LAS u32x4*)(lds + t * 256 + c * 16) = w; } }
            __syncthreads();
            {
              unsigned lo[16], hi[16];
#pragma unroll
              for (int i = 0; i < 16; ++i) {
                  const unsigned w0 = *(const LAS unsigned*)(lds + (wave * 32 + 2 * i) * 256 + lane * 4);
                  const unsigned w1 = *(const LAS unsigned*)(lds + (wave * 32 + 2 * i + 1) * 256 + lane * 4);
                  lo[i] = (w0 & 0xffffu) | (w1 << 16); hi[i] = (w0 >> 16) | (w1 & 0xffff0000u); }
              bf16_t* d0 = dst + (size_t)(2 * lane) * SEQ + s0 + wave * 32; bf16_t* d1 = d0 + SEQ;
#pragma unroll
              for (int i = 0; i < 4; ++i) { u32x4 x = {lo[4 * i], lo[4 * i + 1], lo[4 * i + 2], lo[4 * i + 3]}, y = {hi[4 * i], hi[4 * i + 1], hi[4 * i + 2], hi[4 * i + 3]};
                  *(u32x4*)(d0 + i * 8) = x; *(u32x4*)(d1 + i * 8) = y; } }
            __syncthreads();
        } else {
            const int t = tid >> 1, half = tid & 1, tok = tok0 + t, pos = s0 + t;
            float v[64];
            if (job < 12) {
                const bool isq = job < 6; const int h = isq ? job : job - 6;
                load64(PROJ + (size_t)tok * NPAD + (isq ? OQA : OKA) + h * 128 + half * 64, v);
                float ss = 0.f;
#pragma unroll
                for (int i = 0; i < 64; ++i) ss += v[i] * v[i];
                const float rs = rsqrtf(ss * (1.f / 64.f) + EPS);
                const float* g = a.in[isq ? I_AQN : I_AKN] + l * 64;
#pragma unroll
                for (int i = 0; i < 64; ++i) v[i] = v[i] * rs * g[i];
                rope_inplace<8>(v, pos);
                if (isq) {
#pragma unroll
                    for (int i = 0; i < 64; ++i) v[i] *= 0.125f * LOG2E;
                }
                store64((bf16_t*)(ws + (isq ? WS_QA : WS_KA)) + ((size_t)(b * 6 + h) * SEQ + pos) * 128 + half * 64, v);
            } else if (job < 40) {
                int col0, gi; bf16_t* dst; bool isq = false, iskb = false; int hh = 0;
                if (job < 23) { hh = job - 18; col0 = OQB + hh * 128; gi = I_BQN; dst = (bf16_t*)(ws + WS_QB) + ((size_t)(b * 5 + hh) * SEQ + pos) * 128; isq = true; }
                else if (job < 28) { hh = job - 23; col0 = OKB + hh * 128; gi = I_BKN; dst = (bf16_t*)(ws + WS_KB) + ((size_t)(b * 5 + hh) * SEQ + pos) * 128; iskb = true; }
                else if (job < 38) { hh = job - 33; col0 = OQC + hh * 128; gi = I_CQN; dst = (bf16_t*)(ws + WS_QC) + ((size_t)(b * 5 + hh) * SEQ + pos) * 128; isq = true; }
                else { col0 = OKC; gi = I_CKN; dst = (bf16_t*)(ws + WS_KC) + ((size_t)b * SEQ + pos) * 128; }
                load64(PROJ + (size_t)tok * NPAD + col0 + half * 64, v);
                float ss = 0.f;
#pragma unroll
                for (int i = 0; i < 64; ++i) ss += v[i] * v[i];
                ss += __shfl_xor(ss, 1, 64);
                const float rs = rsqrtf(ss * (1.f / 128.f) + EPS);
                const float* g = a.in[gi] + l * 128 + half * 64;
#pragma unroll
                for (int i = 0; i < 64; ++i) v[i] = v[i] * rs * g[i];
                if (half == 0) rope_inplace<16>(v, pos);
                if (iskb) {
                    LAS float* red = (LAS float*)lds;
#pragma unroll
                    for (int i = 0; i < 64; ++i) { float x = v[i];
                        x += __shfl_xor(x, 2, 64); x += __shfl_xor(x, 4, 64); x += __shfl_xor(x, 8, 64); x += __shfl_xor(x, 16, 64); x += __shfl_xor(x, 32, 64);
                        if (lane < 2) red[wave * 128 + half * 64 + i] = x; }
                    __syncthreads();
                    if (tid < 128) { float s = 0.f;
#pragma unroll
                        for (int w = 0; w < 8; ++w) s += red[w * 128 + tid];
                        ((float*)(ws + WS_KMEAN))[((size_t)(b * 5 + hh) * 8 + blk) * 128 + tid] = s * (1.f / 256.f); }
                    __syncthreads();
                }
                if (isq) {
#pragma unroll
                    for (int i = 0; i < 64; ++i) v[i] *= 0.08838834764831845f * LOG2E;
                }
                store64(dst + half * 64, v);
            } else if (job < 48) {
                const int h = (job - 40) * 2 + half;
                load64(PROJ + (size_t)tok * NPAD + OQI + h * 64, v);
                rope_inplace<8>(v, pos);
                store64((bf16_t*)(ws + WS_QI) + (size_t)tok * 1024 + h * 64, v);
            } else {
                if (half == 0) {
                    load64(PROJ + (size_t)tok * NPAD + OKI, v);
                    float ss = 0.f;
#pragma unroll
                    for (int i = 0; i < 64; ++i) ss += v[i] * v[i];
                    const float rs = rsqrtf(ss * (1.f / 64.f) + EPS);
                    const float* g = a.in[I_IKN] + l * 64;
#pragma unroll
                    for (int i = 0; i < 64; ++i) v[i] = v[i] * rs * g[i];
                    rope_inplace<8>(v, pos);
                    store64((bf16_t*)(ws + WS_KI) + (size_t)tok * 64, v);
                } else {
                    const bf16_t* p = PROJ + (size_t)tok * NPAD + OWI; float* wo = (float*)(ws + WS_WI) + (size_t)tok * 16;
                    const u32x4 w0 = *(const u32x4*)p, w1 = *(const u32x4*)(p + 8);
#pragma unroll
                    for (int j = 0; j < 4; ++j) { wo[2 * j] = bflo(w0[j]) * 0.03125f; wo[2 * j + 1] = bfhi(w0[j]) * 0.03125f; wo[8 + 2 * j] = bflo(w1[j]) * 0.03125f; wo[8 + 2 * j + 1] = bfhi(w1[j]) * 0.03125f; }
                }
            }
        }
    }
}

__device__ __forceinline__ unsigned f2key(float f) { const unsigned u = __float_as_uint(f); return (u & 0x80000000u) ? ~u : (u | 0x80000000u); }
__device__ __forceinline__ float key2f(unsigned k) { const unsigned u = (k & 0x80000000u) ? (k & 0x7fffffffu) : ~k; return __uint_as_float(u); }

constexpr int IX_P = 144, IX_BUF = 256 * IX_P;
__device__ __forceinline__ void idx_unit(const Args& a, int unit, LAS unsigned char* lds) {
    unsigned char* ws = a.ws;
    const int tid = ltid(), wave = tid >> 6, lane = tid & 63, l31 = lane & 31, hi = lane >> 5;
    const int qblk = 511 - unit;
    const int tokb = qblk * 16, tok0 = tokb + wave * 2;
    const int b = tok0 >> 11, sa = tok0 & 2047;
    const int myq = sa + hi;
    const int nchunk = (((tokb & 2047) + 15) >> 8) + 1;
    const bf16_t* QI = (const bf16_t*)(ws + WS_QI); const bf16_t* KI = (const bf16_t*)(ws + WS_KI) + (size_t)b * SEQ * 64; const float* WI = (const float*)(ws + WS_WI);
    bf16x8 qf[4];
    { const int qloc = l31 >> 4, head = l31 & 15; const bf16_t* qp = QI + (size_t)(tok0 + qloc) * 1024 + head * 64 + 8 * hi;
#pragma unroll
      for (int ks = 0; ks < 4; ++ks) qf[ks] = *(const bf16x8*)(qp + ks * 16); }
    float wq[16];
    { const f32x4 a0 = *(const f32x4*)(WI + (size_t)tok0 * 16 + 4 * hi), a1 = *(const f32x4*)(WI + (size_t)tok0 * 16 + 8 + 4 * hi);
      const f32x4 b0 = *(const f32x4*)(WI + (size_t)(tok0 + 1) * 16 + 4 * hi), b1 = *(const f32x4*)(WI + (size_t)(tok0 + 1) * 16 + 8 + 4 * hi);
#pragma unroll
      for (int j = 0; j < 4; ++j) { wq[j] = 0.5f * a0[j]; wq[4 + j] = 0.5f * a1[j]; wq[8 + j] = 0.5f * b0[j]; wq[12 + j] = 0.5f * b1[j]; } }
    u32x4 st[4];
    const u32x4* gsrc = (const u32x4*)KI + tid;
    int ldst[4];
#pragma unroll
    for (int i = 0; i < 4; ++i) { const int p = tid + 512 * i; ldst[i] = (p >> 3) * IX_P + (p & 7) * 16; }
#pragma unroll
    for (int i = 0; i < 4; ++i) st[i] = gsrc[512 * i];
#pragma unroll
    for (int i = 0; i < 4; ++i) *(LAS u32x4*)(lds + ldst[i]) = st[i];
    __syncthreads();
    const int rdo = l31 * IX_P + 16 * hi;
    float sc[64];
#pragma unroll
    for (int c = 0; c < 8; ++c) {
        if (c < nchunk) {
            const bool more = (c + 1) < nchunk;
            if (more) {
#pragma unroll
                for (int i = 0; i < 4; ++i) st[i] = gsrc[(c + 1) * 2048 + 512 * i]; }
            const LAS unsigned char* B = lds + (c & 1) * IX_BUF + rdo;
#pragma unroll
            for (int tp = 0; tp < 8; tp += 2) {
                bf16x8 kf[2][4];
#pragma unroll
                for (int u = 0; u < 2; ++u)
#pragma unroll
                    for (int ks = 0; ks < 4; ++ks) kf[u][ks] = *(const LAS bf16x8*)(B + (tp + u) * 32 * IX_P + ks * 32);
                __builtin_amdgcn_sched_barrier(0);
                f32x16 acc0 = {0.f, 0.f, 0.f, 0.f, 0.f, 0.f, 0.f, 0.f, 0.f, 0.f, 0.f, 0.f, 0.f, 0.f, 0.f, 0.f}, acc1 = acc0;
#pragma unroll
                for (int ks = 0; ks < 4; ++ks) { acc0 = __builtin_amdgcn_mfma_f32_32x32x16_bf16(qf[ks], kf[0][ks], acc0, 0, 0, 0); acc1 = __builtin_amdgcn_mfma_f32_32x32x16_bf16(qf[ks], kf[1][ks], acc1, 0, 0, 0); }
                __builtin_amdgcn_sched_barrier(0);
#pragma unroll
                for (int u = 0; u < 2; ++u) { const int tt = tp + u;
                    float p0 = 0.f, p1 = 0.f;
#pragma unroll
                    for (int r = 0; r < 8; ++r) { const float x0 = u ? acc1[r] : acc0[r], x1 = u ? acc1[8 + r] : acc0[8 + r];
                        p0 = fmaf(wq[r], x0, p0); p0 = fmaf(wq[r], __builtin_fabsf(x0), p0); p1 = fmaf(wq[8 + r], x1, p1); p1 = fmaf(wq[8 + r], __builtin_fabsf(x1), p1); }
                    auto sw = __builtin_amdgcn_permlane32_swap(__float_as_uint(p0), __float_as_uint(p1), false, false);
                    const float s = __uint_as_float(sw[0]) + __uint_as_float(sw[1]);
                    const int key = (c * 8 + tt) * 32 + l31;
                    sc[c * 8 + tt] = (key <= myq) ? s : -INFINITY; }
            }
            if (more) {
#pragma unroll
                for (int i = 0; i < 4; ++i) *(LAS u32x4*)(lds + ((c + 1) & 1) * IX_BUF + ldst[i]) = st[i]; }
            __syncthreads();
        } else {
#pragma unroll
            for (int tt = 0; tt < 8; ++tt) sc[c * 8 + tt] = -INFINITY;
        }
    }
    float thr = -3.0e38f;
    const bool need = (myq + 1) > 256;
    if (__any(need)) {
        float vmin = 3.0e38f, vmax = -3.0e38f;
#pragma unroll
        for (int t = 0; t < 64; ++t) { vmax = fmaxf(vmax, sc[t]); vmin = fminf(vmin, (sc[t] == -INFINITY) ? 3.0e38f : sc[t]); }
#pragma unroll
        for (int o = 1; o < 32; o <<= 1) { vmax = fmaxf(vmax, __shfl_xor(vmax, o, 64)); vmin = fminf(vmin, __shfl_xor(vmin, o, 64)); }
        float lo_v = vmin, hi_v = vmax; int c_lo = myq + 1, c_hi = 1;
        bool done = !need;
        for (int it = 0; it < 128; ++it) {
            const unsigned klo = f2key(lo_v), khi = f2key(hi_v);
            float t = lo_v + (hi_v - lo_v) * (((float)(c_lo - 256) + 0.5f) / (float)(c_lo - c_hi));
            if ((it % 3) == 2 || !(t > lo_v && t < hi_v)) t = key2f(klo + ((khi - klo) >> 1));
            if (c_lo == 256 || khi - klo <= 1u) done = true;
            if (__all(done)) break;
            unsigned n0 = 0u, n1 = 0u, n2 = 0u, n3 = 0u;
#pragma unroll
            for (int q = 0; q < 64; q += 4) { n0 += __float_as_uint(sc[q] - t) >> 31; n1 += __float_as_uint(sc[q + 1] - t) >> 31; n2 += __float_as_uint(sc[q + 2] - t) >> 31; n3 += __float_as_uint(sc[q + 3] - t) >> 31; }
            int c = 64 - (int)((n0 + n1) + (n2 + n3));
            c = half_sum_i32(c);
            if (!done) { if (c >= 256) { lo_v = t; c_lo = c; } else { hi_v = t; c_hi = c; } }
        }
        if (need) thr = lo_v;
    }
    unsigned mylo = 0u, myhi = 0u;
#pragma unroll
    for (int t = 0; t < 64; ++t) {
        const unsigned long long bal = __ballot(sc[t] >= thr);
        if (lane == t) { mylo = (unsigned)bal; myhi = (unsigned)(bal >> 32); }
    }
    unsigned* MASK = (unsigned*)(ws + WS_MASK);
    MASK[(size_t)tok0 * 64 + lane] = mylo;
    MASK[(size_t)(tok0 + 1) * 64 + lane] = myhi;
}

constexpr int AT_KP = 272, AT_VP = 144, AT_KB = 64 * AT_KP, AT_VB = 128 * AT_VP, AT_BUF = AT_KB + AT_VB;

__device__ __forceinline__ bf16x8 pack8(float a0, float a1, float a2, float a3, float a4, float a5, float a6, float a7) {
    u32x4 w = {cvt_pk(a0, a1), cvt_pk(a2, a3), cvt_pk(a4, a5), cvt_pk(a6, a7)}; return __builtin_bit_cast(bf16x8, w);
}

template <int KD, int MODE, int DBG = 0>
__device__ __forceinline__ void attn_core(LAS unsigned char* lds, const bf16_t* kg, const bf16_t* vtg, const int n_kt, const bf16_t* qrow, const int kcol0,
                                          const int qpos, const int wqmax, const unsigned selbits, const int own0, const unsigned* mrow, f32x16 (&o)[4], float& l_out) {
    const int tid = ltid(), lane = tid & 63, l31 = lane & 31, hi = lane >> 5;
    constexpr int NKS = KD / 16;
    bf16x8 qf[NKS];
#pragma unroll
    for (int ks = 0; ks < NKS; ++ks) qf[ks] = *(const bf16x8*)(qrow + kcol0 + ks * 16 + 8 * hi);
#pragma unroll
    for (int d = 0; d < 4; ++d)
#pragma unroll
        for (int r = 0; r < 16; ++r) o[d][r] = 0.f;
    float m = 0.f, l = 0.f; bool has = false;
    const int kc = tid & 15, kr = tid >> 4;
    const int vc = tid & 7, vd = tid >> 3;
    const bf16_t* kgp = kg + (size_t)kr * 128 + kc * 8;
    const bf16_t* vgp = vtg + (size_t)vd * SEQ + vc * 8;
    const int klo = kr * AT_KP + kc * 16, vlo = AT_KB + vd * AT_VP + vc * 16;
    const int kap = (l31 & 0x13) | ((l31 & 4) << 1) | ((l31 & 8) >> 1);
    const int kro = kap * AT_KP + (kcol0 + 8 * hi) * 2, vro = AT_KB + l31 * AT_VP + 16 * hi;
    u32x4 st0, st1, st2, st3;
    st0 = *(const u32x4*)(kgp); st1 = *(const u32x4*)(kgp + 32 * 128); st2 = *(const u32x4*)(vgp); st3 = *(const u32x4*)(vgp + 64 * SEQ);
    *(LAS u32x4*)(lds + klo) = st0; *(LAS u32x4*)(lds + klo + 32 * AT_KP) = st1; *(LAS u32x4*)(lds + vlo) = st2; *(LAS u32x4*)(lds + vlo + 64 * AT_VP) = st3;
    __syncthreads();
    u32x2 mw = {0u, 0u};
    if (MODE == 2) mw = *(const u32x2*)(mrow);
    for (int kt = 0; kt < n_kt; ++kt) {
        const bool more = (kt + 1) < n_kt;
        if (more && !(DBG & 1)) { const bf16_t* kp = kgp + (size_t)(kt + 1) * 64 * 128; const bf16_t* vp = vgp + (kt + 1) * 64;
            st0 = *(const u32x4*)(kp); st1 = *(const u32x4*)(kp + 32 * 128); st2 = *(const u32x4*)(vp); st3 = *(const u32x4*)(vp + 64 * SEQ); }
        const int key0 = kt * 64;
        bool act = key0 <= wqmax;
        const bool past = (MODE == 1) && (key0 < own0);
        const bool selq = ((selbits >> (key0 >> 8)) & 1u) != 0u;
        if (MODE == 1 && past) act = __ballot(selq) != 0ull;
        u32x2 mwn = {0u, 0u};
        if (MODE == 2 && more) mwn = *(const u32x2*)(mrow + 2 * (kt + 1));
        if (act) {
            const LAS unsigned char* B = lds + (kt & 1) * AT_BUF;
            f32x16 s0, s1;
#pragma unroll
            for (int r = 0; r < 16; ++r) { s0[r] = 0.f; s1[r] = 0.f; }
            {
                bf16x8 kf[2 * NKS];
#pragma unroll
                for (int ks = 0; ks < NKS; ++ks) { kf[2 * ks] = *(const LAS bf16x8*)(B + kro + ks * 32); kf[2 * ks + 1] = *(const LAS bf16x8*)(B + kro + 32 * AT_KP + ks * 32); }
                __builtin_amdgcn_sched_barrier(0);
#pragma unroll
                for (int ks = 0; ks < NKS; ++ks) {
                    s0 = __builtin_amdgcn_mfma_f32_32x32x16_bf16(kf[2 * ks], qf[ks], s0, 0, 0, 0);
                    s1 = __builtin_amdgcn_mfma_f32_32x32x16_bf16(kf[2 * ks + 1], qf[ks], s1, 0, 0, 0);
                }
                __builtin_amdgcn_sched_barrier(0);
            }
            bf16x8 vf[16];
#pragma unroll
            for (int kk = 0; kk < 4; ++kk)
#pragma unroll
                for (int d = 0; d < 4; ++d) vf[kk * 4 + d] = *(const LAS bf16x8*)(B + vro + d * 32 * AT_VP + kk * 32);
            __builtin_amdgcn_sched_barrier(0);
            const bool diag = (MODE != 2) && !past && (key0 + 63 > wqmax - 31);
            if (!(DBG & 2)) {
            if (diag) {
                const int d0 = qpos - key0 - 8 * hi;
#pragma unroll
                for (int r = 0; r < 16; ++r) { const int c = 16 * (r >> 3) + (r & 7);
                    s0[r] = (c <= d0) ? s0[r] : -3.0e38f; s1[r] = (c + 32 <= d0) ? s1[r] : -3.0e38f; }
            }
            float mx = fmaxf(s0[0], s1[0]);
#pragma unroll
            for (int r = 1; r < 16; ++r) mx = fmaxf(mx, fmaxf(s0[r], s1[r]));
            mx = pairmax(mx);
            const bool needm = (mx > -1.0e30f) && (!has || (mx - m) > 12.f);
            if (__any(needm)) {
                const float mn = needm ? (has ? fmaxf(m, mx) : mx) : m;
                const float alpha = has ? __builtin_amdgcn_exp2f(m - mn) : 1.f;
                m = mn; has = has || needm; l *= alpha;
#pragma unroll
                for (int d = 0; d < 4; ++d)
#pragma unroll
                    for (int r = 0; r < 16; ++r) o[d][r] *= alpha;
            }
#pragma unroll
            for (int r = 0; r < 16; ++r) { s0[r] = __builtin_amdgcn_exp2f(s0[r] - m); s1[r] = __builtin_amdgcn_exp2f(s1[r] - m); }
            if (MODE == 2) {
                const int w0 = (int)(mw[0] >> (8 * hi)), w1 = (int)(mw[1] >> (8 * hi));
#pragma unroll
                for (int r = 0; r < 16; ++r) { const int c = 16 * (r >> 3) + (r & 7);
                    s0[r] = __uint_as_float(__float_as_uint(s0[r]) & (unsigned)__builtin_amdgcn_sbfe(w0, c, 1));
                    s1[r] = __uint_as_float(__float_as_uint(s1[r]) & (unsigned)__builtin_amdgcn_sbfe(w1, c, 1)); }
            } else if (MODE == 1 && past) {
                const unsigned km = selq ? 0xffffffffu : 0u;
#pragma unroll
                for (int r = 0; r < 16; ++r) { s0[r] = __uint_as_float(__float_as_uint(s0[r]) & km); s1[r] = __uint_as_float(__float_as_uint(s1[r]) & km); }
            }
            float ps = 0.f;
#pragma unroll
            for (int r = 0; r < 16; ++r) ps += s0[r] + s1[r];
            l += ps;
            } else { l += 1.f; }
            bf16x8 pf[4];
            pf[0] = pack8(s0[0], s0[1], s0[2], s0[3], s0[4], s0[5], s0[6], s0[7]);
            pf[1] = pack8(s0[8], s0[9], s0[10], s0[11], s0[12], s0[13], s0[14], s0[15]);
            pf[2] = pack8(s1[0], s1[1], s1[2], s1[3], s1[4], s1[5], s1[6], s1[7]);
            pf[3] = pack8(s1[8], s1[9], s1[10], s1[11], s1[12], s1[13], s1[14], s1[15]);
            __builtin_amdgcn_sched_barrier(0);
#pragma unroll
            for (int kk = 0; kk < 4; ++kk)
#pragma unroll
                for (int d = 0; d < 4; ++d) o[d] = __builtin_amdgcn_mfma_f32_32x32x16_bf16(vf[kk * 4 + d], pf[kk], o[d], 0, 0, 0);
            __builtin_amdgcn_sched_barrier(0);
        }
        if (MODE == 2) mw = mwn;
        if (more && !(DBG & 1)) { LAS unsigned char* Bn = lds + ((kt + 1) & 1) * AT_BUF;
            *(LAS u32x4*)(Bn + klo) = st0; *(LAS u32x4*)(Bn + klo + 32 * AT_KP) = st1; *(LAS u32x4*)(Bn + vlo) = st2; *(LAS u32x4*)(Bn + vlo + 64 * AT_VP) = st3; }
        if (!(DBG & 16)) __syncthreads();
    }
    if (DBG & 16) __syncthreads();
    l_out = pairsum(l);
}

__device__ __forceinline__ void store_o(bf16_t* orow, const f32x16 (&o)[4], float scale, int hi) {
#pragma unroll
    for (int d = 0; d < 4; ++d)
#pragma unroll
        for (int g = 0; g < 4; ++g) {
            u32x2 w = {cvt_pk(o[d][4 * g] * scale, o[d][4 * g + 1] * scale), cvt_pk(o[d][4 * g + 2] * scale, o[d][4 * g + 3] * scale)};
            *(u32x2*)(orow + d * 32 + 8 * g + 4 * hi) = w;
        }
}

__device__ __forceinline__ void attnA_unit(const Args& a, int l, int unit, LAS unsigned char* lds) {
    unsigned char* ws = a.ws;
    const int tid = ltid(), wave = tid >> 6, lane = tid & 63, l31 = lane & 31, hi = lane >> 5;
    const int qt = 15 - unit / 24, bh = unit % 24, b = bh / 6, h = bh % 6, q0 = qt * 128;
    const int comp = wave >> 2, wq0 = q0 + (wave & 3) * 32, qpos = wq0 + l31;
    const bf16_t* kg = (const bf16_t*)(ws + WS_KA) + (size_t)(b * 6 + h) * SEQ * 128;
    const bf16_t* vtg = (const bf16_t*)(ws + WS_VAT) + (size_t)(b * 6 + h) * 128 * SEQ;
    const bf16_t* qrow = (const bf16_t*)(ws + WS_QA) + ((size_t)(b * 6 + h) * SEQ + qpos) * 128;
    f32x16 o[4]; float lsum;
    attn_core<64, 0>(lds, kg, vtg, (q0 + 128) / 64, qrow, comp * 64, qpos, wq0 + 31, 0u, 0, nullptr, o, lsum);
    const float inv = 1.f / lsum;
    LAS float* xp = (LAS float*)lds + (wave & 3) * 4096 + lane;
    if (comp == 1) {
#pragma unroll
        for (int d = 0; d < 4; ++d)
#pragma unroll
            for (int r = 0; r < 16; ++r) xp[(d * 16 + r) * 64] = o[d][r] * inv;
    }
    __syncthreads();
    if (comp == 0) {
        const float* lp = a.in[I_ALAM] + l * 256;
        const float s01 = wave_sum(lp[lane] * lp[64 + lane]), s23 = wave_sum(lp[128 + lane] * lp[192 + lane]);
        const float lam_init = 0.8f - 0.6f * __expf(-0.3f * (float)l);
        const float lam = __expf(s01) - __expf(s23) + lam_init;
        float ss = 0.f;
#pragma unroll
        for (int d = 0; d < 4; ++d) {
            asm volatile("" ::: "memory");
#pragma unroll
            for (int r = 0; r < 16; ++r) { const float v = o[d][r] * inv - lam * xp[(d * 16 + r) * 64]; o[d][r] = v; ss += v * v; }
        }
        ss = pairsum(ss);
        const float rs = rsqrtf(ss * (1.f / 128.f) + EPS) * (1.f - lam_init);
        const float* g = a.in[I_ASUB] + l * 128;
        { f32x4 gv[16];
#pragma unroll
          for (int d = 0; d < 4; ++d)
#pragma unroll
              for (int gq = 0; gq < 4; ++gq) gv[d * 4 + gq] = *(const f32x4*)(g + d * 32 + 8 * gq + 4 * hi);
          __builtin_amdgcn_sched_barrier(0);
#pragma unroll
          for (int d = 0; d < 4; ++d)
#pragma unroll
              for (int gq = 0; gq < 4; ++gq)
#pragma unroll
                  for (int j = 0; j < 4; ++j) o[d][4 * gq + j] *= gv[d * 4 + gq][j]; }
        store_o((bf16_t*)(ws + WS_MIXO) + (size_t)(b * SEQ + qpos) * DM + h * 128, o, rs, hi);
    }
}

template <int DBG>
__device__ __forceinline__ void attnB_unit(const Args& a, int unit, LAS unsigned char* lds) {
    unsigned char* ws = a.ws;
    const int tid = ltid(), wave = tid >> 6, lane = tid & 63, l31 = lane & 31, hi = lane >> 5;
    const int jb = 7 - unit / 20, bh = unit % 20, b = bh / 5, h = bh % 5, q0 = jb * 256;
    const int wq0 = q0 + wave * 32, qpos = wq0 + l31;
    const bf16_t* kg = (const bf16_t*)(ws + WS_KB) + (size_t)(b * 5 + h) * SEQ * 128;
    const bf16_t* vtg = (const bf16_t*)(ws + WS_VBT) + (size_t)(b * 5 + h) * 128 * SEQ;
    const bf16_t* qrow = (const bf16_t*)(ws + WS_QB) + ((size_t)(b * 5 + h) * SEQ + qpos) * 128;
    unsigned sel = 0u;
    if (jb <= 3) sel = (1u << jb) - 1u;
    else {
        float qv[64];
#pragma unroll
        for (int ks = 0; ks < 8; ++ks) { const u32x4 w = *(const u32x4*)(qrow + ks * 16 + 8 * hi);
#pragma unroll
            for (int j = 0; j < 4; ++j) { qv[ks * 8 + 2 * j] = bflo(w[j]); qv[ks * 8 + 2 * j + 1] = bfhi(w[j]); } }
        LAS float* kml = (LAS float*)(lds + 2 * AT_BUF);
        { const float* km = (const float*)(ws + WS_KMEAN) + (size_t)(b * 5 + h) * 8 * 128; const float k0 = km[tid], k1 = km[tid + 512]; kml[tid] = k0; kml[tid + 512] = k1; }
        __syncthreads();
        float gt[7];
#pragma unroll
        for (int n = 0; n < 7; ++n) {
            float sgate = -INFINITY;
            if (n < jb) {
                f32x4 kv[16];
#pragma unroll
                for (int ks = 0; ks < 8; ++ks) { kv[2 * ks] = *(const LAS f32x4*)(kml + n * 128 + ks * 16 + 8 * hi); kv[2 * ks + 1] = *(const LAS f32x4*)(kml + n * 128 + ks * 16 + 8 * hi + 4); }
                __builtin_amdgcn_sched_barrier(0);
                float sacc = 0.f;
#pragma unroll
                for (int ks = 0; ks < 8; ++ks)
#pragma unroll
                    for (int j = 0; j < 4; ++j) { sacc = fmaf(qv[ks * 8 + j], kv[2 * ks][j], sacc); sacc = fmaf(qv[ks * 8 + 4 + j], kv[2 * ks + 1][j], sacc); }
                sgate = pairsum(sacc); }
            gt[n] = sgate;
        }
#pragma unroll
        for (int pick = 0; pick < 3; ++pick) { float best = -INFINITY; int bi = 0;
#pragma unroll
            for (int n = 0; n < 7; ++n) { const bool ok = (n < jb) && !((sel >> n) & 1u) && (gt[n] > best); best = ok ? gt[n] : best; bi = ok ? n : bi; }
            sel |= 1u << bi; }
    }
    f32x16 o[4]; float lsum;
    attn_core<128, 1, DBG>(lds, kg, vtg, (q0 + 256) / 64, qrow, 0, qpos, wq0 + 31, sel, q0, nullptr, o, lsum);
    store_o((bf16_t*)(ws + (DBG ? WS_XM : WS_MIXO)) + (size_t)(b * SEQ + qpos) * DM + 768 + h * 128, o, 1.f / lsum, hi);
}

__device__ __forceinline__ void attnC_unit(const Args& a, int unit, LAS unsigned char* lds) {
    unsigned char* ws = a.ws;
    const int tid = ltid(), wave = tid >> 6, lane = tid & 63, l31 = lane & 31, hi = lane >> 5;
    const int jb = 7 - unit / 20, bh = unit % 20, b = bh / 5, h = bh % 5, q0 = jb * 256;
    const int wq0 = q0 + wave * 32, qpos = wq0 + l31;
    const bf16_t* kg = (const bf16_t*)(ws + WS_KC) + (size_t)b * SEQ * 128;
    const bf16_t* vtg = (const bf16_t*)(ws + WS_VCT) + (size_t)b * 128 * SEQ;
    const bf16_t* qrow = (const bf16_t*)(ws + WS_QC) + ((size_t)(b * 5 + h) * SEQ + qpos) * 128;
    const unsigned* mrow = (const unsigned*)(ws + WS_MASK) + (size_t)(b * SEQ + qpos) * 64;
    f32x16 o[4]; float lsum;
    attn_core<128, 2>(lds, kg, vtg, (q0 + 256) / 64, qrow, 0, qpos, wq0 + 31, 0u, 0, mrow, o, lsum);
    store_o((bf16_t*)(ws + WS_MIXO) + (size_t)(b * SEQ + qpos) * DM + 1408 + h * 128, o, 1.f / lsum, hi);
}

__device__ __forceinline__ float sel8(const float* v, int i) {
    float r = v[0];
#pragma unroll
    for (int k = 1; k < 8; ++k) r = (i == k) ? v[k] : r;
    return r;
}
__device__ __forceinline__ void p6_router(const Args& a, int l, LAS unsigned char* lds) {
    unsigned char* ws = a.ws;
    const int G = gridDim.x, bx = blockIdx.x, tid = ltid(), wave = tid >> 6, lane = tid & 63, l31 = lane & 31, hi = lane >> 5;
    const float* XM = (const float*)(ws + WS_XM); const float* WR = (const float*)(ws + WS_WR) + (size_t)l * 64 * DM;
    unsigned* cnt = (unsigned*)(ws + WS_CTL) + CW_CNT + l * 32;
    int* LIST = (int*)(ws + WS_LIST); float* LISTG = (float*)(ws + WS_LISTG); int* TOKE = (int*)(ws + WS_TOKE); int* TOKP = (int*)(ws + WS_TOKP);
    LAS float* red = (LAS float*)lds;
    LAS float* ssred = (LAS float*)(lds + 65536);
    LAS float* lg = (LAS float*)(lds + 65536 + 1024);
    LAS int* lcnt = (LAS int*)(lds + 65536 + 1024 + 8192);
    for (int tb = bx; tb < NT / 32; tb += G) {
        const int tok0 = tb * 32;
        f32x16 acc0, acc1;
#pragma unroll
        for (int r = 0; r < 16; ++r) { acc0[r] = 0.f; acc1[r] = 0.f; }
        float ss = 0.f;
        const float* xp = XM + (size_t)(tok0 + l31) * DM + wave * 256 + 4 * hi;
        const float* w0 = WR + (size_t)l31 * DM + wave * 256 + 4 * hi;
        const float* w1 = WR + (size_t)(32 + l31) * DM + wave * 256 + 4 * hi;
        if (tid < 32) lcnt[tid] = 0;
#pragma unroll 4
        for (int it = 0; it < 32; ++it) {
            const f32x4 xv = *(const f32x4*)(xp + it * 8), b0 = *(const f32x4*)(w0 + it * 8), b1 = *(const f32x4*)(w1 + it * 8);
            ss += xv[0] * xv[0] + xv[1] * xv[1] + xv[2] * xv[2] + xv[3] * xv[3];
#pragma unroll
            for (int s = 0; s < 4; ++s) { acc0 = __builtin_amdgcn_mfma_f32_32x32x2f32(xv[s], b0[s], acc0, 0, 0, 0); acc1 = __builtin_amdgcn_mfma_f32_32x32x2f32(xv[s], b1[s], acc1, 0, 0, 0); }
        }
#pragma unroll
        for (int r = 0; r < 16; ++r) { const int trow = (r & 3) + 8 * (r >> 2) + 4 * hi;
            red[(wave * 32 + trow) * 64 + l31] = acc0[r]; red[(wave * 32 + trow) * 64 + 32 + l31] = acc1[r]; }
        ss = pairsum(ss);
        if (hi == 0) ssred[wave * 32 + l31] = ss;
        __syncthreads();
        { const int t = tid >> 4, c4 = (tid & 15) * 4;
          f32x4 sum = {0.f, 0.f, 0.f, 0.f}; float st = 0.f;
#pragma unroll
          for (int w = 0; w < 8; ++w) { sum += *(const LAS f32x4*)(red + (w * 32 + t) * 64 + c4); st += ssred[w * 32 + t]; }
          const float rs = rsqrtf(st * (1.f / DM) + EPS);
          if (c4 < 36) {
#pragma unroll
              for (int j = 0; j < 4; ++j) { const int c = c4 + j; const float bias = c < 32 ? a.in[I_BEXP][l * 32 + c] : a.in[I_BGRP][l * 4 + (c - 32)]; lg[t * 64 + c] = sum[j] * rs + bias; }
          }
          if (c4 == 60) lg[t * 64 + 63] = rs; }
        __syncthreads();
        int e0 = 0, e1 = 0, lp0 = 0, lp1 = 0; float g0 = 0.f, g1 = 0.f;
        if (tid < 32) {
            const LAS float* L = lg + tid * 64;
            int gi = 0; float gm = L[32];
            for (int j = 1; j < 4; ++j) { const float v = L[32 + j]; if (v > gm) { gm = v; gi = j; } }
            float gs = 0.f;
            for (int j = 0; j < 4; ++j) gs += __expf(L[32 + j] - gm);
            const float gw = 1.f / gs;
            float em = L[gi * 8];
            for (int k = 1; k < 8; ++k) em = fmaxf(em, L[gi * 8 + k]);
            float es = 0.f;
            for (int k = 0; k < 8; ++k) es += __expf(L[gi * 8 + k] - em);
            const float ies = 1.f / es;
            int i0 = 0; float v0 = -1.f;
            for (int k = 0; k < 8; ++k) { const float p = __expf(L[gi * 8 + k] - em) * ies; if (p > v0) { v0 = p; i0 = k; } }
            int i1 = 0; float v1 = -1.f;
            for (int k = 0; k < 8; ++k) { const float p = __expf(L[gi * 8 + k] - em) * ies; if (k != i0 && p > v1) { v1 = p; i1 = k; } }
            const float inv = 1.f / (v0 + v1);
            g0 = gw * v0 * inv; g1 = gw * v1 * inv; e0 = gi * 8 + i0; e1 = gi * 8 + i1;
            lp0 = atomicAdd((int*)(lcnt + e0), 1); lp1 = atomicAdd((int*)(lcnt + e1), 1);
        }
        __syncthreads();
        if (tid < 32) { const int c = lcnt[tid]; lcnt[32 + tid] = c > 0 ? (int)atomicAdd(cnt + tid, (unsigned)c) : 0; }
        __syncthreads();
        if (tid < 32) {
            const int tok = tok0 + tid, p0 = lcnt[32 + e0] + lp0, p1 = lcnt[32 + e1] + lp1;
            LIST[(size_t)e0 * NT + p0] = tok; LISTG[(size_t)e0 * NT + p0] = g0; LIST[(size_t)e1 * NT + p1] = tok; LISTG[(size_t)e1 * NT + p1] = g1;
            TOKE[tok * 2] = e0; TOKE[tok * 2 + 1] = e1; TOKP[tok * 2] = p0; TOKP[tok * 2 + 1] = p1;
            ((float*)(ws + WS_RSTD2))[tok] = lg[tid * 64 + 63];
        }
        __syncthreads();
    }
}

constexpr int SK_MAX = 0;
struct MoeTab { volatile LAS int* tpre; volatile LAS int* dcnt; volatile LAS int* skrows; volatile LAS int* skbase; volatile LAS int* ske; volatile LAS int* skn; };
__device__ __forceinline__ MoeTab moe_tab_ptrs(LAS unsigned char* lds) {
    MoeTab T; T.tpre = (volatile LAS int*)(lds + LDS_CTL + 64); T.dcnt = (volatile LAS int*)(lds + LDS_CTL + 256); T.skrows = (volatile LAS int*)(lds + LDS_CTL + 384);
    T.skbase = (volatile LAS int*)(lds + LDS_CTL + 512); T.ske = (volatile LAS int*)(lds + LDS_CTL + 640); T.skn = (volatile LAS int*)(lds + LDS_CTL + 768); return T;
}
__device__ __forceinline__ void moe_table(const Args& a, int l, const MoeTab& T) {
    const unsigned* cnt = (const unsigned*)(a.ws + WS_CTL) + CW_CNT + l * 32;
    const int tid = ltid();
    __syncthreads();
    if (tid < 32) T.dcnt[tid] = (int)ld_agent(cnt + tid);
    __syncthreads();
    if (tid == 0) { int acc = 0, nsk = 0;
#pragma unroll 1
        for (int e = 0; e < NE; ++e) { const int c = T.dcnt[e], f = c >> 8, rem = c & 255; const int sk = (rem > 0 && rem <= SK_MAX) ? rem : 0;
            T.tpre[e] = acc; acc += f + ((rem > SK_MAX) ? 1 : 0); T.dcnt[e] = sk ? (f << 8) : c; T.skrows[e] = sk; if (sk) { T.ske[nsk] = e; ++nsk; } }
        T.tpre[NE] = acc; *T.skn = nsk;
        int base = acc * 256;
#pragma unroll 1
        for (int i = 0; i < nsk; ++i) { T.skbase[T.ske[i]] = base; base += 64; } }
    __syncthreads();
}
__device__ __forceinline__ size_t moe_row(const MoeTab& T, int e, int pos) {
    const int d = T.dcnt[e]; return pos < d ? (size_t)T.tpre[e] * 256 + pos : (size_t)T.skbase[e] + (pos - d);
}

template <int NR, int NC, int U = 4>
__device__ __forceinline__ void wave_gemm(const bf16_t* const (&ap)[NR], const bf16_t* const (&bp)[NC], const int nr, const int nsteps, f32x4 (&acc)[NR][NC]) {
#pragma unroll
    for (int i = 0; i < NR; ++i)
#pragma unroll
        for (int j = 0; j < NC; ++j) acc[i][j] = (f32x4){0.f, 0.f, 0.f, 0.f};
#pragma unroll 1
    for (int s0 = 0; s0 < nsteps; s0 += U) {
        bf16x8 af[U][NR], bf[U][NC];
#pragma unroll
        for (int u = 0; u < U; ++u) {
#pragma unroll
            for (int i = 0; i < NR; ++i) if (i < nr) af[u][i] = *(const bf16x8*)(ap[i] + (s0 + u) * 32);
#pragma unroll
            for (int j = 0; j < NC; ++j) bf[u][j] = *(const bf16x8*)(bp[j] + (s0 + u) * 32);
        }
        __builtin_amdgcn_sched_barrier(0);
#pragma unroll
        for (int u = 0; u < U; ++u)
#pragma unroll
            for (int i = 0; i < NR; ++i) if (i < nr)
#pragma unroll
                for (int j = 0; j < NC; ++j) acc[i][j] = __builtin_amdgcn_mfma_f32_16x16x32_bf16(bf[u][j], af[u][i], acc[i][j], 0, 0, 0);
    }
}

__device__ __forceinline__ void skinny_kiwi(const Args& a, int l, LAS unsigned char* lds) {
    unsigned char* ws = a.ws;
    const int G = gridDim.x, bx = blockIdx.x, tid = ltid(), wave = tid >> 6, lane = tid & 63, fr = lane & 15, fq = lane >> 4, rg = wave >> 2, kq = wave & 3;
    const bf16_t* XB = (const bf16_t*)(ws + WS_XB); const bf16_t* W = (const bf16_t*)(ws + WS_WIN) + (size_t)l * NPAD * DM; bf16_t* PROJ = (bf16_t*)(ws + WS_PROJ);
    LAS f32x4* red = (LAS f32x4*)lds;
    for (int rb = bx; rb < NT / 32; rb += G) {
        const int row = rb * 32 + rg * 16 + fr;
        const bf16_t* ap[1] = {XB + (size_t)row * DM + kq * 512 + 8 * fq};
        const bf16_t* bp[5];
#pragma unroll
        for (int j = 0; j < 5; ++j) bp[j] = W + (size_t)(6144 + 16 * j + fr) * DM + kq * 512 + 8 * fq;
        f32x4 acc[1][5];
        wave_gemm<1, 5>(ap, bp, 1, 16, acc);
        if (kq > 0) {
#pragma unroll
            for (int j = 0; j < 5; ++j) red[((rg * 3 + kq - 1) * 5 + j) * 64 + lane] = acc[0][j]; }
        __syncthreads();
        if (kq == 0) { const float rs = ((const float*)(ws + WS_RSTD1))[row];
#pragma unroll
            for (int j = 0; j < 5; ++j) { f32x4 v = acc[0][j];
#pragma unroll
                for (int k = 0; k < 3; ++k) v += red[((rg * 3 + k) * 5 + j) * 64 + lane];
                v = v * rs; u32x2 w = {cvt_pk(v[0], v[1]), cvt_pk(v[2], v[3])}; *(u32x2*)(PROJ + (size_t)row * NPAD + 6144 + 16 * j + 4 * fq) = w; } }
        __syncthreads();
    }
}

__device__ __forceinline__ void skinny_up(const Args& a, int l, LAS unsigned char* lds, const MoeTab& T) {
    unsigned char* ws = a.ws;
    const int G = gridDim.x, bx = blockIdx.x, tid = ltid(), wave = tid >> 6, lane = tid & 63, fr = lane & 15, fq = lane >> 4;
    const bf16_t* XMB = (const bf16_t*)(ws + WS_XMB); const int* LIST = (const int*)(ws + WS_LIST); const float* LISTG = (const float*)(ws + WS_LISTG);
    bf16_t* H = (bf16_t*)(ws + WS_H);
    const int ntask = (*T.skn) * 16;
    for (int bt = bx; bt < ntask; bt += G) {
        const int e = T.ske[bt >> 4], rows = T.skrows[e], p0 = T.dcnt[e];
        const int wt = (bt & 15) * 8 + wave, rg = wt >> 5, f0 = (wt & 31) * 16;
        if (rg * 16 < rows) {
            const bf16_t* W = (const bf16_t*)(ws + WS_W1) + ((size_t)(l * NE + e)) * 1024 * DM;
            int r = 16 * rg + fr; const bool rv = r < rows; r = rv ? r : rows - 1;
            const int tok = LIST[(size_t)e * NT + p0 + r];
            const bf16_t* ap[1] = {XMB + (size_t)tok * DM + 8 * fq};
            const bf16_t* bp[2];
            bp[0] = W + (size_t)((f0 >> 7) * 256 + (f0 & 127) + fr) * DM + 8 * fq; bp[1] = bp[0] + (size_t)128 * DM;
            f32x4 acc[1][2];
            wave_gemm<1, 2, 8>(ap, bp, 1, 64, acc);
            if (rv) { const float rs = ((const float*)(ws + WS_RSTD2))[tok], gv = LISTG[(size_t)e * NT + p0 + r]; const f32x4 g = acc[0][0] * rs, up = acc[0][1] * rs; float h[4];
#pragma unroll
                for (int q = 0; q < 4; ++q) { const float sg = g[q] / (1.f + __expf(-g[q])); h[q] = sg * up[q] * gv; }
                u32x2 w = {cvt_pk(h[0], h[1]), cvt_pk(h[2], h[3])}; *(u32x2*)(H + ((size_t)T.skbase[e] + r) * FF + f0 + 4 * fq) = w; }
        }
    }
}

__device__ __forceinline__ void skinny_down(const Args& a, int l, const MoeTab& T) {
    unsigned char* ws = a.ws;
    const int G = gridDim.x, bx = blockIdx.x, tid = ltid(), wave = tid >> 6, lane = tid & 63, fr = lane & 15, fq = lane >> 4;
    const bf16_t* H = (const bf16_t*)(ws + WS_H); bf16_t* Y = (bf16_t*)(ws + WS_Y);
    const int ntask = (*T.skn) * 8;
    for (int bt = bx; bt < ntask; bt += G) {
        const int e = T.ske[bt >> 3], rows = T.skrows[e], nr = (rows + 15) >> 4, n0 = (bt & 7) * 256 + wave * 32;
        const size_t rb = (size_t)T.skbase[e];
        const bf16_t* W = (const bf16_t*)(ws + WS_WD) + ((size_t)(l * NE + e)) * DM * FF;
        const bf16_t* ap[4];
#pragma unroll
        for (int i = 0; i < 4; ++i) { int r = 16 * i + fr; r = r < rows ? r : rows - 1; ap[i] = H + (rb + r) * FF + 8 * fq; }
        const bf16_t* bp[2] = {W + (size_t)(n0 + fr) * FF + 8 * fq, W + (size_t)(n0 + 16 + fr) * FF + 8 * fq};
        f32x4 acc[4][2];
        wave_gemm<4, 2>(ap, bp, nr, 16, acc);
#pragma unroll
        for (int i = 0; i < 4; ++i) { const int r = 16 * i + fr;
            if (r < rows) {
#pragma unroll
                for (int j = 0; j < 2; ++j) { const f32x4 v = acc[i][j]; u32x2 w = {cvt_pk(v[0], v[1]), cvt_pk(v[2], v[3])}; *(u32x2*)(Y + (rb + r) * DM + n0 + 16 * j + 4 * fq) = w; } } }
    }
}

__device__ __forceinline__ void p9_combine(const Args& a, int l, const MoeTab& T) {
    unsigned char* ws = a.ws;
    const int G = gridDim.x, bx = blockIdx.x, tid = ltid(), wave = tid >> 6, lane = tid & 63;
    const float* XM = (const float*)(ws + WS_XM); const bf16_t* Y = (const bf16_t*)(ws + WS_Y);
    const int* TOKE = (const int*)(ws + WS_TOKE); const int* TOKP = (const int*)(ws + WS_TOKP);
    float* xo = (l == NL - 1) ? a.out : (float*)(ws + WS_X1);
    bf16_t* XB = (bf16_t*)(ws + WS_XB); float* RSTD1 = (float*)(ws + WS_RSTD1);
    for (int row = bx * 8 + wave; row < NT; row += G * 8) {
        const int e0 = TOKE[row * 2], e1 = TOKE[row * 2 + 1];
        const size_t r0 = moe_row(T, e0, TOKP[row * 2]), r1 = moe_row(T, e1, TOKP[row * 2 + 1]);
        float ss = 0.f;
        f32x4 xv[8]; u32x2 ya[8], yb[8];
#pragma unroll
        for (int i = 0; i < 8; ++i) { const int c = i * 256 + lane * 4;
            xv[i] = *(const f32x4*)(XM + (size_t)row * DM + c); ya[i] = *(const u32x2*)(Y + r0 * DM + c); yb[i] = *(const u32x2*)(Y + r1 * DM + c); }
        __builtin_amdgcn_sched_barrier(0);
#pragma unroll
        for (int i = 0; i < 8; ++i) { const int c = i * 256 + lane * 4;
            f32x4 v = xv[i]; const u32x2 y0 = ya[i], y1 = yb[i];
            v[0] = (v[0] + bflo(y0[0])) + bflo(y1[0]); v[1] = (v[1] + bfhi(y0[0])) + bfhi(y1[0]); v[2] = (v[2] + bflo(y0[1])) + bflo(y1[1]); v[3] = (v[3] + bfhi(y0[1])) + bfhi(y1[1]);
            *(f32x4*)(xo + (size_t)row * DM + c) = v;
            ss += v[0] * v[0] + v[1] * v[1] + v[2] * v[2] + v[3] * v[3];
            u32x2 w = {cvt_pk(v[0], v[1]), cvt_pk(v[2], v[3])}; *(u32x2*)(XB + (size_t)row * DM + c) = w; }
        ss = wave_sum(ss);
        if (lane == 0) RSTD1[row] = rsqrtf(ss * (1.f / DM) + EPS);
    }
}

constexpr int N_PHASES = 1 + 9 * NL;
typedef const Args __attribute__((address_space(4)))* ArgsP;
#define PHASE_FN static __device__ __forceinline__ void
__device__ __forceinline__ Args ld_args(ArgsP ap) {
    Args a;
#pragma unroll
    for (int i = 0; i < 21; ++i) a.in[i] = ap->in[i];
    a.out = ap->out; a.ws = ap->ws; a.ph_lo = ap->ph_lo; a.ph_hi = ap->ph_hi; return a;
}

PHASE_FN ph_prologue(ArgsP ap, LAS unsigned char* lds) { asm volatile("" : "+s"(ap)); const Args a = ld_args(ap); p0_prologue(a, lds); }
PHASE_FN ph_inproj(ArgsP ap, LAS unsigned char* lds, int l) {
    asm volatile("" : "+s"(ap)); const Args a = ld_args(ap); unsigned char* ws = a.ws;
    pg8::DenseSched S; S.init(ws + WS_XB, ws + WS_WIN + (size_t)l * NPAD * DM * 2, NT, 6144, DM, gridDim.x, blockIdx.x);
    EpiProj E{(bf16_t*)(ws + WS_PROJ), (const float*)(ws + WS_RSTD1)};
    pg8::gemm_phase(lds, DM, S, E);
    skinny_kiwi(a, l, lds);
    if (REPEAT_PH == 11) { skinny_kiwi(a, l, lds); skinny_kiwi(a, l, lds); }
}
PHASE_FN ph_prep(ArgsP ap, LAS unsigned char* lds, int l) { asm volatile("" : "+s"(ap)); const Args a = ld_args(ap); p2_prep(a, l, lds); }
PHASE_FN ph_idx(ArgsP ap, LAS unsigned char* lds, int l, int rep) {
    asm volatile("" : "+s"(ap)); const Args a = ld_args(ap); unsigned* qh = (unsigned*)(a.ws + WS_CTL) + CW_Q + l * 8 * 64; volatile LAS int* slot = (volatile LAS int*)(lds + LDS_CTL + 32);
    for (;;) { const int u = next_unit(qh + (0 + 4 * rep) * 64, slot); if (u >= 512) break; idx_unit(a, u, lds); }
}
PHASE_FN ph_attnA(ArgsP ap, LAS unsigned char* lds, int l, int rep) {
    asm volatile("" : "+s"(ap)); const Args a = ld_args(ap); unsigned* qh = (unsigned*)(a.ws + WS_CTL) + CW_Q + l * 8 * 64; volatile LAS int* slot = (volatile LAS int*)(lds + LDS_CTL + 32);
    for (;;) { const int u = next_unit(qh + (1 + 4 * rep) * 64, slot); if (u >= 384) break; attnA_unit(a, l, u, lds); }
}
template <int DBG>
PHASE_FN ph_attnB(ArgsP ap, LAS unsigned char* lds, int l, int rep) {
    asm volatile("" : "+s"(ap)); const Args a = ld_args(ap); unsigned* qh = (unsigned*)(a.ws + WS_CTL) + CW_Q + l * 8 * 64; volatile LAS int* slot = (volatile LAS int*)(lds + LDS_CTL + 32);
    for (;;) { const int u = next_unit(qh + (2 + 4 * rep) * 64, slot); if (u >= 160) break; attnB_unit<DBG>(a, u, lds); }
}
PHASE_FN ph_attnC(ArgsP ap, LAS unsigned char* lds, int l, int rep) {
    asm volatile("" : "+s"(ap)); const Args a = ld_args(ap); unsigned* qh = (unsigned*)(a.ws + WS_CTL) + CW_Q + l * 8 * 64; volatile LAS int* slot = (volatile LAS int*)(lds + LDS_CTL + 32);
    for (;;) { const int u = next_unit(qh + (3 + 4 * rep) * 64, slot); if (u >= 160) break; attnC_unit(a, u, lds); }
}
PHASE_FN ph_outproj(ArgsP ap, LAS unsigned char* lds, int l) {
    asm volatile("" : "+s"(ap)); const Args a = ld_args(ap); unsigned char* ws = a.ws;
    pg8::DenseSched S; S.init(ws + WS_MIXO, ws + WS_WOUT + (size_t)l * DM * DM * 2, NT, DM, DM, gridDim.x, blockIdx.x);
    EpiOut E{l == 0 ? a.in[I_X] : (const float*)(ws + WS_X1), (float*)(ws + WS_XM), (bf16_t*)(ws + WS_XMB)};
    pg8::gemm_phase(lds, DM, S, E);
}
PHASE_FN ph_router(ArgsP ap, LAS unsigned char* lds, int l) { asm volatile("" : "+s"(ap)); const Args a = ld_args(ap); p6_router(a, l, lds); }
PHASE_FN ph_moe_up(ArgsP ap, LAS unsigned char* lds, int l) {
    asm volatile("" : "+s"(ap)); const Args a = ld_args(ap); unsigned char* ws = a.ws;
    const MoeTab T = moe_tab_ptrs(lds);
    const int G = gridDim.x, bx = blockIdx.x; const int vcu = (G % 8 == 0) ? (bx % 8) * (G / 8) + bx / 8 : bx;
    moe_table(a, l, T);
    pg8::MoeSched<true> S{(const char*)(ws + WS_XMB), (const char*)(ws + WS_W1 + (size_t)l * NE * 1024 * DM * 2), (const int*)(ws + WS_LIST), T.tpre, T.dcnt, DM, 4, T.tpre[NE], G, vcu, (size_t)1024 * DM * 2};
    EpiUp E{(bf16_t*)(ws + WS_H), (const int*)(ws + WS_LIST), (const float*)(ws + WS_LISTG), (const float*)(ws + WS_RSTD2), T.tpre};
    pg8::gemm_phase(lds, DM, S, E);
    skinny_up(a, l, lds, T);
    if (REPEAT_PH == 71) { skinny_up(a, l, lds, T); skinny_up(a, l, lds, T); }
}
PHASE_FN ph_moe_down(ArgsP ap, LAS unsigned char* lds, int l) {
    asm volatile("" : "+s"(ap)); const Args a = ld_args(ap); unsigned char* ws = a.ws;
    const MoeTab T = moe_tab_ptrs(lds);
    const int G = gridDim.x, bx = blockIdx.x; const int vcu = (G % 8 == 0) ? (bx % 8) * (G / 8) + bx / 8 : bx;
    moe_table(a, l, T);
    pg8::MoeSched<false> S{(const char*)(ws + WS_H), (const char*)(ws + WS_WD + (size_t)l * NE * DM * FF * 2), nullptr, T.tpre, T.dcnt, FF, 8, T.tpre[NE], G, vcu, (size_t)DM * FF * 2};
    EpiDown E{(bf16_t*)(ws + WS_Y), T.tpre};
    pg8::gemm_phase(lds, FF, S, E);
    skinny_down(a, l, T);
    if (REPEAT_PH == 81) { skinny_down(a, l, T); skinny_down(a, l, T); }
}
PHASE_FN ph_deferred(ArgsP ap, LAS unsigned char* lds, int which) {
    asm volatile("" : "+s"(ap)); const Args a = ld_args(ap);
    const MoeTab T = moe_tab_ptrs(lds);
    const int G = gridDim.x, bx = blockIdx.x; const int vcu = (G % 8 == 0) ? (bx % 8) * (G / 8) + bx / 8 : bx;
    const int nunits = T.tpre[NE] * (which ? 8 : 4), e = nunits % G;
    const int DLO = which ? DEF2_LO : DEF_LO, DN = which ? DEF2_N : DEF_N;
    const int ns = (e == 0) ? G : G - e; int p1 = ns * DEF_QUOTA; p1 = p1 < DN ? p1 : DN;
    if (e == 0) cvt_deferred(a, lds, vcu, G, DLO, p1);
    else if (vcu >= e) cvt_deferred(a, lds, vcu - e, ns, DLO, p1);
    if (p1 < DN) cvt_deferred(a, lds, vcu, G, DLO + p1, DN - p1);
}
PHASE_FN ph_combine(ArgsP ap, LAS unsigned char* lds, int l) {
    asm volatile("" : "+s"(ap)); const Args a = ld_args(ap);
    const MoeTab T = moe_tab_ptrs(lds);
    moe_table(a, l, T);
    p9_combine(a, l, T);
}

__global__ void __launch_bounds__(NTHR, 2) mk_fwd(Args a_unused) {
    extern __shared__ __attribute__((aligned(16))) unsigned char lds_raw[];
    LAS unsigned char* lds = (LAS unsigned char*)lds_raw;
    volatile LAS unsigned* lctl = (volatile LAS unsigned*)(lds + LDS_CTL);
    ArgsP ap = (ArgsP)__builtin_amdgcn_kernarg_segment_ptr();
    const int tid = ltid();
    if (tid < 128) lctl[tid] = 0u;
    __syncthreads();
    unsigned* ctl = (unsigned*)(ap->ws + WS_CTL);
    const int lo = ap->ph_lo, hi = ap->ph_hi;
    XcdBarrier bar; bar.bar = ctl + CW_BAR; bar.x = 0; bar.st = lctl;
    if (hi - lo > 1) bar = xcd_barrier_post(ctl + CW_BAR, lctl);
#define IN(k) (lo <= (k) && (k) < hi)
#define SEAM(k) do { if (IN(k) && IN((k) + 1)) xcd_barrier(bar); } while (0)
#ifndef REPEAT_PH
#define REPEAT_PH -1
#endif
#ifndef REPEAT_N
#define REPEAT_N 2
#endif
#define NREP(k) ((REPEAT_PH == (k)) ? REPEAT_N : 1)
#define RSEAM(k, r, n) do { if ((r) + 1 < (n)) xcd_barrier(bar); else SEAM(k); } while (0)
    if (IN(0)) { for (int r = 0; r < NREP(0); ++r) { ph_prologue(ap, lds); RSEAM(0, r, NREP(0)); } }
    for (int l = 0; l < NL; ++l) {
        const int pb = 1 + 9 * l;
        if (IN(pb + 0)) { for (int r = 0; r < NREP(1); ++r) { ph_inproj(ap, lds, l); RSEAM(pb + 0, r, NREP(1)); } }
        if (IN(pb + 1)) { for (int r = 0; r < NREP(2); ++r) { ph_prep(ap, lds, l); RSEAM(pb + 1, r, NREP(2)); } }
        if (IN(pb + 2)) { for (int r = 0; r < NREP(3); ++r) { ph_idx(ap, lds, l, r); ph_attnA(ap, lds, l, r); RSEAM(pb + 2, r, NREP(3)); }
            if (REPEAT_PH == 31) { xcd_barrier(bar); ph_idx(ap, lds, l, 1); }
            if (REPEAT_PH == 32) { xcd_barrier(bar); ph_attnA(ap, lds, l, 1); } }
        if (IN(pb + 3)) { for (int r = 0; r < NREP(4); ++r) { ph_attnB<0>(ap, lds, l, r); ph_attnC(ap, lds, l, r); RSEAM(pb + 3, r, NREP(4)); }
            if (REPEAT_PH == 41) { xcd_barrier(bar); ph_attnB<DBG_VAR>(ap, lds, l, 1); xcd_barrier(bar); }
            if (REPEAT_PH == 42) { xcd_barrier(bar); ph_attnC(ap, lds, l, 1); } }
        if (IN(pb + 4)) { for (int r = 0; r < NREP(5); ++r) { ph_outproj(ap, lds, l); RSEAM(pb + 4, r, NREP(5)); } }
        if (IN(pb + 5)) { ph_router(ap, lds, l); SEAM(pb + 5); }
        if (IN(pb + 6)) { for (int r = 0; r < NREP(7); ++r) { ph_moe_up(ap, lds, l); if (l == 0 && r == 0) ph_deferred(ap, lds, 0); RSEAM(pb + 6, r, NREP(7)); } }
        if (IN(pb + 7)) { for (int r = 0; r < NREP(8); ++r) { ph_moe_down(ap, lds, l); RSEAM(pb + 7, r, NREP(8)); } }
        if (IN(pb + 8)) { for (int r = 0; r < NREP(9); ++r) { ph_combine(ap, lds, l); RSEAM(pb + 8, r, NREP(9)); } }
    }
#undef IN
#undef SEAM
}

extern "C" void kernel_launch(void* const* d_in, const int* in_sizes, int n_in, void* d_out, int out_size, void* d_ws, size_t ws_size, hipStream_t stream) {
    static int grid = 0;
    if (grid == 0) {
        if (n_in != 21 || out_size != NT * DM || ws_size < WS_END) { fprintf(stderr, "kernel_launch: unexpected problem (n_in %d, out %d, ws %zu < %zu)\n", n_in, out_size, ws_size, (size_t)WS_END); grid = -1; return; }
        int dev = 0, cus = 0, per_cu = 0;
        if (hipGetDevice(&dev) != hipSuccess || hipDeviceGetAttribute(&cus, hipDeviceAttributeMultiprocessorCount, dev) != hipSuccess) { grid = -1; return; }
        if (hipFuncSetAttribute((const void*)mk_fwd, hipFuncAttributeMaxDynamicSharedMemorySize, LDS_BYTES) != hipSuccess) { fprintf(stderr, "kernel_launch: hipFuncSetAttribute failed\n"); grid = -1; return; }
        if (hipOccupancyMaxActiveBlocksPerMultiprocessor(&per_cu, (const void*)mk_fwd, NTHR, LDS_BYTES) != hipSuccess || per_cu < 1) { fprintf(stderr, "kernel_launch: occupancy query says %d\n", per_cu); }
        (void)hipGetLastError();
        grid = cus;
    }
    if (grid < 0) return;
    (void)hipMemsetAsync((char*)d_ws + WS_CTL, 0, CTL_BYTES, stream);
    Args a{};
    for (int i = 0; i < 21; ++i) a.in[i] = (const float*)d_in[i];
    a.out = (float*)d_out; a.ws = (unsigned char*)d_ws;
#if MK_ONE_LAUNCH
    a.ph_lo = 0; a.ph_hi = N_PHASES;
    hipLaunchKernelGGL(mk_fwd, dim3(grid), dim3(NTHR), LDS_BYTES, stream, a);
#else
    for (int p = 0; p < N_PHASES; ++p) { a.ph_lo = p; a.ph_hi = p + 1; hipLaunchKernelGGL(mk_fwd, dim3(grid), dim3(NTHR), LDS_BYTES, stream, a); }
#endif
}
```

```cpp
#include <hip/hip_runtime.h>
#include <cstdio>
#include <cstdint>

#ifndef DBG_VAR
#define DBG_VAR 0
#endif
#ifndef REPEAT_PH
#define REPEAT_PH -1
#endif
#ifndef MK_ONE_LAUNCH
#define MK_ONE_LAUNCH 1
#endif

#define LAS __attribute__((address_space(3)))
typedef unsigned short bf16_t;
typedef short bf16x8 __attribute__((ext_vector_type(8)));
typedef float f32x4 __attribute__((ext_vector_type(4)));
typedef float f32x16 __attribute__((ext_vector_type(16)));
typedef unsigned u32x4 __attribute__((ext_vector_type(4)));
typedef unsigned u32x2 __attribute__((ext_vector_type(2)));

constexpr int NB = 4, SEQ = 2048, DM = 2048, NT = NB * SEQ, NL = 2;
constexpr int IN_DIM = 6224, NPAD = 6400;
constexpr int OQA = 0, OKA = 768, OVA = 1536, OQB = 2304, OKB = 2944, OVB = 3584, OQC = 4224, OKC = 4864, OVC = 4992, OQI = 5120, OKI = 6144, OWI = 6208;
constexpr int NE = 32, FF = 512;
constexpr int HROWS = 24576;
constexpr float EPS = 1e-6f;
constexpr float LOG2E = 1.4426950408889634f;
constexpr int NTHR = 512;

constexpr size_t WS_CTL = 0;
constexpr size_t CTL_BYTES = 65536;
constexpr size_t WS_WIN = WS_CTL + CTL_BYTES;
constexpr size_t WS_WOUT = WS_WIN + (size_t)NL * NPAD * DM * 2;
constexpr size_t WS_W1 = WS_WOUT + (size_t)NL * DM * DM * 2;
constexpr size_t WS_WD = WS_W1 + (size_t)NL * NE * 1024 * DM * 2;
constexpr size_t WS_WR = WS_WD + (size_t)NL * NE * DM * FF * 2;
constexpr size_t WS_XB = WS_WR + (size_t)NL * 64 * DM * 4;
constexpr size_t WS_RSTD1 = WS_XB + (size_t)NT * DM * 2;
constexpr size_t WS_PROJ = WS_RSTD1 + (size_t)NT * 4;
constexpr size_t WS_Y = WS_PROJ;
constexpr size_t WS_QA = WS_PROJ + (size_t)NT * NPAD * 2;
constexpr size_t WS_KA = WS_QA + (size_t)NT * 768 * 2;
constexpr size_t WS_VAT = WS_KA + (size_t)NT * 768 * 2;
constexpr size_t WS_QB = WS_VAT + (size_t)NT * 768 * 2;
constexpr size_t WS_KB = WS_QB + (size_t)NT * 640 * 2;
constexpr size_t WS_VBT = WS_KB + (size_t)NT * 640 * 2;
constexpr size_t WS_KMEAN = WS_VBT + (size_t)NT * 640 * 2;
constexpr size_t WS_QC = WS_KMEAN + (size_t)NB * 5 * 8 * 128 * 4;
constexpr size_t WS_KC = WS_QC + (size_t)NT * 640 * 2;
constexpr size_t WS_VCT = WS_KC + (size_t)NT * 128 * 2;
constexpr size_t WS_QI = WS_VCT + (size_t)NT * 128 * 2;
constexpr size_t WS_KI = WS_QI + (size_t)NT * 1024 * 2;
constexpr size_t WS_WI = WS_KI + (size_t)NT * 64 * 2;
constexpr size_t WS_MASK = WS_WI + (size_t)NT * 16 * 4;
constexpr size_t WS_MIXO = WS_MASK + (size_t)NT * 64 * 4;
constexpr size_t WS_XM = WS_MIXO + (size_t)NT * DM * 2;
constexpr size_t WS_XMB = WS_XM + (size_t)NT * DM * 4;
constexpr size_t WS_TOKE = WS_XMB + (size_t)NT * DM * 2;
constexpr size_t WS_TOKP = WS_TOKE + (size_t)NT * 2 * 4;
constexpr size_t WS_RSTD2 = WS_TOKP + (size_t)NT * 2 * 4;
constexpr size_t WS_LIST = WS_RSTD2 + (size_t)NT * 4;
constexpr size_t WS_LISTG = WS_LIST + (size_t)NE * NT * 4;
constexpr size_t WS_H = WS_LISTG + (size_t)NE * NT * 4;
constexpr size_t WS_X1 = WS_H + (size_t)HROWS * FF * 2;
constexpr size_t WS_END = WS_X1 + (size_t)NT * DM * 4;
static_assert((size_t)HROWS * DM * 2 <= (size_t)NT * NPAD * 2, "Y must fit in PROJ");

constexpr int CW_BAR = 0;
constexpr int CW_CNT = 4096;
constexpr int CW_Q = 4096 + 64;

constexpr int LDS_STAGE = 131072;
constexpr int LDS_CTL = LDS_STAGE;
constexpr int LDS_BYTES = 147456;

__device__ __forceinline__ float bf2f(bf16_t b) { return __uint_as_float(((unsigned)b) << 16); }
__device__ __forceinline__ float bflo(unsigned w) { return __uint_as_float(w << 16); }
__device__ __forceinline__ float bfhi(unsigned w) { return __uint_as_float(w & 0xffff0000u); }
typedef __bf16 bf16x2_t __attribute__((ext_vector_type(2)));
__device__ __forceinline__ unsigned cvt_pk(float lo, float hi) { bf16x2_t v = {(__bf16)lo, (__bf16)hi}; return __builtin_bit_cast(unsigned, v); }
__device__ __forceinline__ float pairmax(float x) { auto r = __builtin_amdgcn_permlane32_swap(__float_as_uint(x), __float_as_uint(x), false, false); return fmaxf(__uint_as_float(r[0]), __uint_as_float(r[1])); }
__device__ __forceinline__ float pairsum(float x) { auto r = __builtin_amdgcn_permlane32_swap(__float_as_uint(x), __float_as_uint(x), false, false); return __uint_as_float(r[0]) + __uint_as_float(r[1]); }
__device__ __forceinline__ float wave_sum(float x) {
#pragma unroll
    for (int o = 32; o > 0; o >>= 1) x += __shfl_xor(x, o, 64);
    return x;
}
__device__ __forceinline__ int ltid() { int t = (int)threadIdx.x; asm volatile("" : "+v"(t)); return t; }
__device__ __forceinline__ int half_sum_i32(int v) {
    v += __builtin_amdgcn_update_dpp(0, v, 0xB1, 0xF, 0xF, true);
    v += __builtin_amdgcn_update_dpp(0, v, 0x4E, 0xF, 0xF, true);
    v += __builtin_amdgcn_update_dpp(0, v, 0x141, 0xF, 0xF, true);
    v += __builtin_amdgcn_update_dpp(0, v, 0x140, 0xF, 0xF, true);
    v += __shfl_xor(v, 16, 64);
    return v;
}
__device__ __forceinline__ unsigned ld_agent(const unsigned* p) { return __hip_atomic_load(p, __ATOMIC_RELAXED, __HIP_MEMORY_SCOPE_AGENT); }

#define XB_TMO      128
#define XB_XCNT(j)  (256  + 64 * (j))
#define XB_XSUB(j)  (1280 + 64 * (j))
#define XB_XGEN(j)  (2304 + 64 * (j))
#define XB_TOP      3328
#define XB_TOPGEN   3392
#define XCD_BAR_WORDS 3456
#define XB_SPIN_CAP (1u << 22)

__device__ __forceinline__ unsigned xb_ld(unsigned* p)              { return __hip_atomic_load(p, __ATOMIC_RELAXED, __HIP_MEMORY_SCOPE_AGENT); }
__device__ __forceinline__ unsigned xb_add(unsigned* p, unsigned v) { return __hip_atomic_fetch_add(p, v, __ATOMIC_RELAXED, __HIP_MEMORY_SCOPE_AGENT); }
__device__ __forceinline__ unsigned xb_xcc_id() { return (unsigned)__builtin_amdgcn_s_getreg((3 << 11) | 20) & 0xFu; }
#define XB_SPIN(cond, bar) do { unsigned _sp = 0; while (cond) { __builtin_amdgcn_s_sleep(1); \
    if ((++_sp & 255u) == 0u) { if (xb_ld(&(bar)[XB_TMO])) break; if (_sp > XB_SPIN_CAP) { atomicAdd(&(bar)[XB_TMO], 1u); break; } } } } while (0)

struct XcdBarrier { unsigned* bar; unsigned x; volatile LAS unsigned* st; };

__device__ __forceinline__ XcdBarrier xcd_barrier_post(unsigned* bar, volatile LAS unsigned* st) {
    XcdBarrier b; b.bar = bar; b.x = xb_xcc_id(); b.st = st;
    if (threadIdx.x == 0) (void)xb_add(&bar[XB_XCNT(b.x)], 1u);
    return b;
}
__device__ __forceinline__ void xcd_barrier_complete(unsigned* bar, unsigned x, unsigned& nloc, unsigned& nx) {
    const unsigned G = gridDim.x * gridDim.y * gridDim.z;
    unsigned sum, cnt, mine, sp = 0u;
    for (;;) {
        sum = 0u; cnt = 0u; mine = 0u;
#pragma unroll
        for (unsigned j = 0; j < 16; ++j) { const unsigned c = xb_ld(&bar[XB_XCNT(j)]); sum += c; cnt += (c > 0u) ? 1u : 0u; mine = (j == x) ? c : mine; }
        if (sum == G) break;
        __builtin_amdgcn_s_sleep(1);
        if ((++sp & 255u) == 0u) { if (xb_ld(&bar[XB_TMO])) break; if (sp > XB_SPIN_CAP) { atomicAdd(&bar[XB_TMO], 1u); break; } }
    }
    nloc = mine > 0u ? mine : 1u; nx = cnt > 0u ? cnt : 1u;
}
__device__ __forceinline__ void xcd_barrier(const XcdBarrier& b) {
    asm volatile("s_waitcnt vmcnt(0)" ::: "memory");
    __syncthreads();
    if (threadIdx.x == 0) {
        unsigned* bar = b.bar;
        __builtin_amdgcn_s_waitcnt(0);
        unsigned nloc = b.st[0], nx = b.st[1];
        if (nloc == 0u) { xcd_barrier_complete(bar, b.x, nloc, nx); b.st[0] = nloc; b.st[1] = nx; }
        const unsigned old = xb_add(&bar[XB_XSUB(b.x)], 1u);
        const unsigned gen = old / nloc;
        if (old + 1u == (gen + 1u) * nloc) {
            __builtin_amdgcn_fence(__ATOMIC_RELEASE, "agent");
            asm volatile("s_waitcnt vmcnt(0)" ::: "memory");
            const unsigned og = xb_add(&bar[XB_TOP], 1u);
            const unsigned tg = og / nx;
            if (og + 1u == (tg + 1u) * nx) xb_add(&bar[XB_TOPGEN], 1u);
            else XB_SPIN(xb_ld(&bar[XB_TOPGEN]) == tg, bar);
            __builtin_amdgcn_fence(__ATOMIC_ACQUIRE, "agent");
            xb_add(&bar[XB_XGEN(b.x)], 1u);
            asm volatile("s_waitcnt vmcnt(0)" ::: "memory");
        } else {
            XB_SPIN(xb_ld(&bar[XB_XGEN(b.x)]) == gen, bar);
            __builtin_amdgcn_fence(__ATOMIC_ACQUIRE, "agent");
            asm volatile("s_waitcnt vmcnt(0)" ::: "memory");
        }
    }
    __syncthreads();
}

struct Args { const float* in[21]; float* out; unsigned char* ws; int ph_lo, ph_hi; };
enum { I_X = 0, I_N1G, I_WIN, I_AQN, I_AKN, I_ALAM, I_ASUB, I_BQN, I_BKN, I_CQN, I_CKN, I_IKN, I_WOUT, I_N2G, I_WGRP, I_BGRP, I_WEXP, I_BEXP, I_WGATE, I_WUP, I_WDOWN };

__device__ __forceinline__ int next_unit(unsigned* ctr, volatile LAS int* slot) {
    __syncthreads();
    if (threadIdx.x == 0) *slot = (int)atomicAdd(ctr, 1u);
    __syncthreads();
    return *slot;
}

namespace pg8 {
constexpr int BM = 256, BK = 64, HALF = 128, HTB = HALF * BK * 2, STAGE_BYTES = 8 * HTB;
__device__ __forceinline__ int lds_byte(int r, int c) { const int st = (r >> 4) * 2 + (c >> 5), rr = r & 15, cc = c & 31, ob = rr * 64 + cc * 2; return st * 1024 + (ob ^ (((ob >> 9) & 1) << 5)); }
__device__ __forceinline__ void stage_rc(int b, int& R, int& C) { const int st = b / 1024, sb = b % 1024, swz = sb ^ (((sb >> 9) & 1) << 5); R = (st >> 1) * 16 + swz / 64; C = (st & 1) * 32 + (swz % 64) / 2; }

__device__ __forceinline__ int perm32(int rho) { const int n = rho >> 4, i = rho & 15; return 8 * (i >> 2) + 4 * n + (i & 3); }
struct Unit { const char* a; const char* b; int m0, n0, e, cnt; };

template <class Epi, class Sched>
__device__ __forceinline__ void gemm_phase(LAS unsigned char* lds, const int K, const Sched& S, const Epi& E) {
    const int tid = ltid(), wid = __builtin_amdgcn_readfirstlane(tid >> 6), lane = tid & 63, wr = wid >> 2, wc = wid & 3, fr = lane & 15, fq = lane >> 4;
    const int nt = K / BK;
    int Rst[2], Cst[2]; unsigned voffB[2];
#pragma unroll
    for (int i = 0; i < 2; ++i) { int R, C; stage_rc(tid * 16 + i * 8192, R, C); Rst[i] = R; Cst[i] = C; const int Rb = Epi::PERM ? ((R & ~31) + perm32(R & 31)) : R; voffB[i] = (unsigned)(Rb * K + C) * 2u; }
    const size_t kstep = (size_t)(BK * 2);
    const size_t hstep = (size_t)HALF * K * 2;
    const unsigned ldsw = (unsigned)wid * 1024u;
    const int aoff = lds_byte(wr * 64 + fr, fq * 8), boff = lds_byte(wc * 32 + fr, fq * 8);
#define PG8_SA(b, h) (((b) * 2 + (h)) * HTB)
#define PG8_SB(b, h) ((4 + (b) * 2 + (h)) * HTB)
#define PG8_STAGE2(bufoff, gbase, o0, o1) do { \
        __builtin_amdgcn_global_load_lds((const unsigned*)((const char*)(gbase) + (o0)), (LAS unsigned*)(lds + (bufoff) + ldsw), 16, 0, 0); \
        __builtin_amdgcn_global_load_lds((const unsigned*)((const char*)(gbase) + (o1)), (LAS unsigned*)(lds + (bufoff) + ldsw + 8192), 16, 0, 0); } while (0)
#define PG8_STAGEB(bufoff, gbase) PG8_STAGE2(bufoff, gbase, voffB[0], voffB[1])
#define PG8_LDA(dst, b, h) do { _Pragma("unroll") for (int m = 0; m < 4; ++m) _Pragma("unroll") for (int k = 0; k < 2; ++k) dst[m][k] = *(const LAS bf16x8*)(lds + PG8_SA(b, h) + aoff + m * 2048 + k * 1024); } while (0)
#define PG8_LDB(dst, b, h) do { _Pragma("unroll") for (int n = 0; n < 2; ++n) _Pragma("unroll") for (int k = 0; k < 2; ++k) dst[n][k] = *(const LAS bf16x8*)(lds + PG8_SB(b, h) + boff + n * 2048 + k * 1024); } while (0)
#define PG8_MMA(ai, bj, At, Bt) do { __builtin_amdgcn_s_setprio(1); _Pragma("unroll") for (int m = 0; m < 4; ++m) _Pragma("unroll") for (int n = 0; n < 2; ++n) _Pragma("unroll") for (int k = 0; k < 2; ++k) \
        acc[ai][bj][m][n] = __builtin_amdgcn_mfma_f32_16x16x32_bf16(Bt[n][k], At[m][k], acc[ai][bj][m][n], 0, 0, 0); __builtin_amdgcn_s_setprio(0); } while (0)
#define PG8_WAIT_V(n) asm volatile("s_waitcnt vmcnt(" #n ")" ::: "memory")
#define PG8_WAIT_L(n) asm volatile("s_waitcnt lgkmcnt(" #n ")" ::: "memory")
#define PG8_BAR __builtin_amdgcn_s_barrier()
#define PG8_SCHED __builtin_amdgcn_sched_barrier(0)
    Unit cur, nxt; int ui = 0;
    if (!S.next(0, cur)) return;
    f32x4 acc[2][2][4][2];
#pragma unroll
    for (int a = 0; a < 2; ++a)
#pragma unroll
        for (int b = 0; b < 2; ++b)
#pragma unroll
            for (int m = 0; m < 4; ++m)
#pragma unroll
                for (int n = 0; n < 2; ++n) acc[a][b][m][n] = (f32x4){0.f, 0.f, 0.f, 0.f};
    bf16x8 At[4][2], B0[2][2], B1[2][2];
    unsigned c00, c01, c10, c11, n00, n01, n10, n11;
    c00 = S.arow(cur, Rst[0]) + Cst[0] * 2; c01 = S.arow(cur, Rst[1]) + Cst[1] * 2; c10 = S.arow(cur, 128 + Rst[0]) + Cst[0] * 2; c11 = S.arow(cur, 128 + Rst[1]) + Cst[1] * 2;
    const char* cA = cur.a; const char* cB = cur.b;
    PG8_STAGEB(PG8_SB(0, 0), cB); PG8_STAGE2(PG8_SA(0, 0), cA, c00, c01); PG8_STAGEB(PG8_SB(0, 1), cB + hstep); PG8_STAGE2(PG8_SA(0, 1), cA, c10, c11);
    if (wr == 1) PG8_BAR;
    PG8_WAIT_V(4); PG8_BAR;
    PG8_STAGEB(PG8_SB(1, 0), cB + kstep); PG8_STAGE2(PG8_SA(1, 0), cA + kstep, c00, c01); PG8_STAGEB(PG8_SB(1, 1), cB + hstep + kstep);
    PG8_WAIT_V(6); PG8_BAR;
    for (;;) {
        const bool has_next = S.next(ui + 1, nxt);
        const char* nA = cA; const char* nB = cB; n00 = c00; n01 = c01; n10 = c10; n11 = c11;
        if (has_next) { nA = nxt.a; nB = nxt.b;
            n00 = S.arow(nxt, Rst[0]) + Cst[0] * 2; n01 = S.arow(nxt, Rst[1]) + Cst[1] * 2; n10 = S.arow(nxt, 128 + Rst[0]) + Cst[0] * 2; n11 = S.arow(nxt, 128 + Rst[1]) + Cst[1] * 2; }
        for (int t = 0; t < nt; t += 2) {
            const bool last = (t == nt - 2);
            const char* a1 = cA + (size_t)(t + 1) * kstep;
            const char* a2 = last ? nA : cA + (size_t)(t + 2) * kstep; const char* b2 = last ? nB : cB + (size_t)(t + 2) * kstep;
            const char* a3 = a2 + kstep; const char* b3 = b2 + kstep;
            const unsigned o00 = last ? n00 : c00, o01 = last ? n01 : c01, o10 = last ? n10 : c10, o11 = last ? n11 : c11;
            PG8_LDB(B0, 0, 0); PG8_SCHED; PG8_LDA(At, 0, 0); PG8_STAGE2(PG8_SA(1, 1), a1, c10, c11);
            PG8_WAIT_L(8); PG8_BAR; PG8_WAIT_L(0); PG8_MMA(0, 0, At, B0); PG8_BAR; PG8_SCHED;
            PG8_LDB(B1, 0, 1); PG8_STAGEB(PG8_SB(0, 0), b2);
            PG8_BAR; PG8_WAIT_L(0); PG8_MMA(0, 1, At, B1); PG8_BAR;
            PG8_LDA(At, 0, 1); PG8_STAGE2(PG8_SA(0, 0), a2, o00, o01);
            PG8_BAR; PG8_WAIT_L(0); PG8_MMA(1, 0, At, B0); PG8_BAR; PG8_SCHED;
            PG8_STAGEB(PG8_SB(0, 1), b2 + hstep);
            PG8_WAIT_V(6); PG8_BAR; PG8_MMA(1, 1, At, B1); PG8_BAR;
            PG8_LDB(B0, 1, 0); PG8_SCHED; PG8_LDA(At, 1, 0); PG8_STAGE2(PG8_SA(0, 1), a2, o10, o11);
            PG8_WAIT_L(8); PG8_BAR; PG8_WAIT_L(0); PG8_MMA(0, 0, At, B0); PG8_BAR; PG8_SCHED;
            PG8_LDB(B1, 1, 1); PG8_STAGEB(PG8_SB(1, 0), b3);
            PG8_BAR; PG8_WAIT_L(0); PG8_MMA(0, 1, At, B1); PG8_BAR;
            PG8_LDA(At, 1, 1); PG8_STAGE2(PG8_SA(1, 0), a3, o00, o01);
            PG8_BAR; PG8_WAIT_L(0); PG8_MMA(1, 0, At, B0); PG8_BAR; PG8_SCHED;
            PG8_STAGEB(PG8_SB(1, 1), b3 + hstep);
            PG8_WAIT_V(6); PG8_BAR; PG8_MMA(1, 1, At, B1); PG8_BAR;
        }
        E(acc, cur, wr, wc, fr, fq);
        if (!has_next) break;
#pragma unroll
        for (int a = 0; a < 2; ++a)
#pragma unroll
            for (int b = 0; b < 2; ++b)
#pragma unroll
                for (int m = 0; m < 4; ++m)
#pragma unroll
                    for (int n = 0; n < 2; ++n) acc[a][b][m][n] = (f32x4){0.f, 0.f, 0.f, 0.f};
        cur = nxt; cA = nA; cB = nB; c00 = n00; c01 = n01; c10 = n10; c11 = n11; ++ui;
    }
    PG8_WAIT_V(0);
    if (wr == 0) PG8_BAR;
    PG8_BAR;
#undef PG8_SA
#undef PG8_SB
#undef PG8_STAGE2
#undef PG8_STAGEB
#undef PG8_LDA
#undef PG8_LDB
#undef PG8_MMA
#undef PG8_WAIT_V
#undef PG8_WAIT_L
#undef PG8_BAR
#undef PG8_SCHED
}

struct DenseSched {
    const char* A; const char* Bt; int K, nM, nN, nwg, G, c;
    __device__ __forceinline__ void init(const void* A_, const void* Bt_, int M, int N, int K_, int G_, int c_) { A = (const char*)A_; Bt = (const char*)Bt_; K = K_; nM = M / BM; nN = N / BM; nwg = nM * nN; G = G_; c = c_; }
    __device__ __forceinline__ bool next(int i, Unit& u) const {
        const long L = (long)i * G + c; if (L >= nwg) return false;
        int wgid = (int)L; { const int q = nwg / 8, r = nwg % 8, xcd = wgid % 8, off = wgid / 8; wgid = (xcd < r ? xcd * (q + 1) : r * (q + 1) + (xcd - r) * q) + off; }
        const int nig = 8 * nN, gid = wgid / nig, fm = gid * 8, gsz = (nM - fm) < 8 ? (nM - fm) : 8;
        const int pm = fm + ((wgid % nig) % gsz), pn = (wgid % nig) / gsz;
        u.m0 = pm * BM; u.n0 = pn * BM; u.e = 0; u.cnt = 0;
        u.a = A + (size_t)u.m0 * K * 2; u.b = Bt + (size_t)u.n0 * K * 2; return true;
    }
    __device__ __forceinline__ unsigned arow(const Unit&, int r) const { return (unsigned)(r * K) * 2u; }
};

template <bool GATHER>
struct MoeSched {
    const char* A; const char* Bt; const int* list; volatile LAS int* tpre; volatile LAS int* cnt; int K, NPN, ntiles, G, c; size_t bstride;
    __device__ __forceinline__ bool next(int i, Unit& u) const {
        const long L = (long)i * G + c; if (L >= (long)ntiles * NPN) return false;
        const int mg = (int)(L / NPN), pn = (int)(L % NPN);
        int e = 0;
#pragma unroll 1
        for (int j = 1; j < NE; ++j) e = (tpre[j] <= mg) ? j : e;
        e = __builtin_amdgcn_readfirstlane(e);
        u.e = e; u.m0 = (mg - tpre[e]) * BM; u.cnt = cnt[e]; u.n0 = pn * BM;
        u.b = Bt + (size_t)e * bstride + (size_t)u.n0 * K * 2;
        if (GATHER) u.a = A; else u.a = A + (size_t)mg * BM * K * 2;
        return true;
    }
    __device__ __forceinline__ unsigned arow(const Unit& u, int r) const {
        if (GATHER) { int m = u.m0 + r; m = m < u.cnt ? m : u.m0; const int tok = list[(size_t)u.e * NT + m]; return (unsigned)(tok * K) * 2u; }
        return (unsigned)(r * K) * 2u;
    }
};
}

struct EpiProj {
    static constexpr bool PERM = true;
    bf16_t* out; const float* rstd;
    __device__ __forceinline__ void operator()(const f32x4 (&acc)[2][2][4][2], const pg8::Unit& u, int wr, int wc, int fr, int fq) const {
        float rs[2][4];
#pragma unroll
        for (int ai = 0; ai < 2; ++ai)
#pragma unroll
            for (int m = 0; m < 4; ++m) rs[ai][m] = rstd[u.m0 + 128 * ai + 64 * wr + 16 * m + fr];
        __builtin_amdgcn_sched_barrier(0);
#pragma unroll
        for (int ai = 0; ai < 2; ++ai)
#pragma unroll
            for (int m = 0; m < 4; ++m) {
                const int row = u.m0 + 128 * ai + 64 * wr + 16 * m + fr;
                bf16_t* rp = out + (size_t)row * NPAD + u.n0 + 32 * wc + 8 * fq;
#pragma unroll
                for (int bj = 0; bj < 2; ++bj) { const f32x4 v0 = acc[ai][bj][m][0] * rs[ai][m], v1 = acc[ai][bj][m][1] * rs[ai][m];
                    u32x4 w = {cvt_pk(v0[0], v0[1]), cvt_pk(v0[2], v0[3]), cvt_pk(v1[0], v1[1]), cvt_pk(v1[2], v1[3])}; *(u32x4*)(rp + 128 * bj) = w; }
            }
    }
};
struct EpiOut {
    static constexpr bool PERM = true;
    const float* xin; float* xm; bf16_t* xmb;
    __device__ __forceinline__ void operator()(const f32x4 (&acc)[2][2][4][2], const pg8::Unit& u, int wr, int wc, int fr, int fq) const {
#pragma unroll
        for (int ai = 0; ai < 2; ++ai) {
            f32x4 xv[4][2][2];
#pragma unroll
            for (int m = 0; m < 4; ++m) { const int row = u.m0 + 128 * ai + 64 * wr + 16 * m + fr; const size_t o = (size_t)row * DM + u.n0 + 32 * wc + 8 * fq;
#pragma unroll
                for (int bj = 0; bj < 2; ++bj)
#pragma unroll
                    for (int n = 0; n < 2; ++n) xv[m][bj][n] = *(const f32x4*)(xin + o + 128 * bj + 4 * n); }
            __builtin_amdgcn_sched_barrier(0);
#pragma unroll
            for (int m = 0; m < 4; ++m) { const int row = u.m0 + 128 * ai + 64 * wr + 16 * m + fr; const size_t o = (size_t)row * DM + u.n0 + 32 * wc + 8 * fq;
#pragma unroll
                for (int bj = 0; bj < 2; ++bj) { const size_t oo = o + 128 * bj; const f32x4 v0 = acc[ai][bj][m][0] + xv[m][bj][0], v1 = acc[ai][bj][m][1] + xv[m][bj][1];
                    *(f32x4*)(xm + oo) = v0; *(f32x4*)(xm + oo + 4) = v1;
                    u32x4 w = {cvt_pk(v0[0], v0[1]), cvt_pk(v0[2], v0[3]), cvt_pk(v1[0], v1[1]), cvt_pk(v1[2], v1[3])}; *(u32x4*)(xmb + oo) = w; } }
            __builtin_amdgcn_sched_barrier(0);
        }
    }
};
struct EpiUp {
    static constexpr bool PERM = true;
    bf16_t* H; const int* list; const float* listg; const float* rstd2; volatile LAS int* tpre;
    __device__ __forceinline__ void operator()(const f32x4 (&acc)[2][2][4][2], const pg8::Unit& u, int wr, int wc, int fr, int fq) const {
        const int rowbase = tpre[u.e] * 256;
        int tok[2][4]; float gv[2][4], rs[2][4];
#pragma unroll
        for (int ai = 0; ai < 2; ++ai)
#pragma unroll
            for (int m = 0; m < 4; ++m) { int mr = u.m0 + 128 * ai + 64 * wr + 16 * m + fr; mr = mr < u.cnt ? mr : u.m0; tok[ai][m] = list[(size_t)u.e * NT + mr]; gv[ai][m] = listg[(size_t)u.e * NT + mr]; }
        __builtin_amdgcn_sched_barrier(0);
#pragma unroll
        for (int ai = 0; ai < 2; ++ai)
#pragma unroll
            for (int m = 0; m < 4; ++m) rs[ai][m] = rstd2[tok[ai][m]];
        __builtin_amdgcn_sched_barrier(0);
#pragma unroll
        for (int ai = 0; ai < 2; ++ai)
#pragma unroll
            for (int m = 0; m < 4; ++m) {
                const int mr = u.m0 + 128 * ai + 64 * wr + 16 * m + fr;
                if (mr < u.cnt) {
                    bf16_t* rp = H + (size_t)(rowbase + mr) * FF + (u.n0 >> 1) + 32 * wc + 8 * fq;
                    float h[8];
#pragma unroll
                    for (int n = 0; n < 2; ++n) { const f32x4 g = acc[ai][0][m][n] * rs[ai][m], up = acc[ai][1][m][n] * rs[ai][m];
#pragma unroll
                        for (int j = 0; j < 4; ++j) { const float s = g[j] / (1.f + __expf(-g[j])); h[4 * n + j] = s * up[j] * gv[ai][m]; } }
                    u32x4 w = {cvt_pk(h[0], h[1]), cvt_pk(h[2], h[3]), cvt_pk(h[4], h[5]), cvt_pk(h[6], h[7])}; *(u32x4*)rp = w;
                }
            }
    }
};
struct EpiDown {
    static constexpr bool PERM = true;
    bf16_t* Y; volatile LAS int* tpre;
    __device__ __forceinline__ void operator()(const f32x4 (&acc)[2][2][4][2], const pg8::Unit& u, int wr, int wc, int fr, int fq) const {
        const int rowbase = tpre[u.e] * 256;
#pragma unroll
        for (int ai = 0; ai < 2; ++ai)
#pragma unroll
            for (int m = 0; m < 4; ++m) {
                const int mr = u.m0 + 128 * ai + 64 * wr + 16 * m + fr;
                if (mr < u.cnt) {
                    bf16_t* rp = Y + (size_t)(rowbase + mr) * DM + u.n0 + 32 * wc + 8 * fq;
#pragma unroll
                    for (int bj = 0; bj < 2; ++bj) { const f32x4 v0 = acc[ai][bj][m][0], v1 = acc[ai][bj][m][1];
                        u32x4 w = {cvt_pk(v0[0], v0[1]), cvt_pk(v0[2], v0[3]), cvt_pk(v1[0], v1[1]), cvt_pk(v1[2], v1[3])}; *(u32x4*)(rp + 128 * bj) = w; }
                }
            }
    }
};

struct CvtJob { const float* src; const float* gain; bf16_t* dst; int ld, nvalid, k0, n0; size_t dst_ld, dst_row0; };
__device__ __forceinline__ void cvt_decode(const Args& a, int job, CvtJob& J) {
    unsigned char* ws = a.ws;
    constexpr int J_W1 = NL * NE * 2 * 16 * 8, J_WD = NL * NE * 4 * 32, J_WIN = NL * 16 * 100;
    int j = job;
    if (j < J_W1) {
        const int nt = j & 7; j >>= 3; const int kt = j & 15; j >>= 4; const int which = j & 1; j >>= 1; const int e = j & 31; const int l = j >> 5;
        const int f0 = nt * 64;
        J.src = (which ? a.in[I_WUP] : a.in[I_WGATE]) + ((size_t)(l * NE + e)) * DM * FF; J.gain = a.in[I_N2G] + l * DM;
        J.dst = (bf16_t*)(ws + WS_W1) + ((size_t)(l * NE + e)) * 1024 * DM; J.ld = FF; J.nvalid = FF; J.k0 = kt * 128; J.n0 = f0; J.dst_ld = DM;
        J.dst_row0 = (size_t)((f0 >> 7) * 256 + which * 128 + (f0 & 127));
    } else if ((j -= J_W1) < J_WD) {
        const int nt = j & 31; j >>= 5; const int kt = j & 3; j >>= 2; const int e = j & 31; const int l = j >> 5;
        J.src = a.in[I_WDOWN] + ((size_t)(l * NE + e)) * FF * DM; J.gain = nullptr;
        J.dst = (bf16_t*)(ws + WS_WD) + ((size_t)(l * NE + e)) * DM * FF; J.ld = DM; J.nvalid = DM; J.k0 = kt * 128; J.n0 = nt * 64; J.dst_ld = FF; J.dst_row0 = (size_t)(nt * 64);
    } else if ((j -= J_WD) < J_WIN) {
        const int nt = j % 100; j /= 100; const int kt = j & 15; const int l = j >> 4;
        J.src = a.in[I_WIN] + (size_t)l * DM * IN_DIM; J.gain = a.in[I_N1G] + l * DM;
        J.dst = (bf16_t*)(ws + WS_WIN) + (size_t)l * NPAD * DM; J.ld = IN_DIM; J.nvalid = IN_DIM; J.k0 = kt * 128; J.n0 = nt * 64; J.dst_ld = DM; J.dst_row0 = (size_t)(nt * 64);
    } else {
        j -= J_WIN; const int nt = j & 31; j >>= 5; const int kt = j & 15; const int l = j >> 4;
        J.src = a.in[I_WOUT] + (size_t)l * DM * DM; J.gain = nullptr;
        J.dst = (bf16_t*)(ws + WS_WOUT) + (size_t)l * DM * DM; J.ld = DM; J.nvalid = DM; J.k0 = kt * 128; J.n0 = nt * 64; J.dst_ld = DM; J.dst_row0 = (size_t)(nt * 64);
    }
}
__device__ __forceinline__ void cvt_load(const CvtJob& J, int tid, f32x4 (&v)[4], float (&g)[4]) {
    const int kk = tid >> 4, nn = (tid & 15) * 4;
#pragma unroll
    for (int i = 0; i < 4; ++i) { const int k = J.k0 + kk + 32 * i;
        float z = 0.f; asm volatile("" : "+v"(z));
        v[i] = (f32x4){z, z, z, z};
        if (J.n0 + nn < J.nvalid) v[i] = *(const f32x4*)(J.src + (size_t)k * J.ld + J.n0 + nn);
        g[i] = J.gain ? J.gain[k] : 1.f; }
}
__device__ __forceinline__ void cvt_store(LAS unsigned char* lds, const CvtJob& J, int tid, const f32x4 (&v)[4], const float (&g)[4]) {
    LAS bf16_t* T = (LAS bf16_t*)lds;
    constexpr int P = 130;
    { const int kk = tid >> 4, nn = (tid & 15) * 4;
#pragma unroll
      for (int i = 0; i < 4; ++i) { const int k = kk + 32 * i; const f32x4 x = v[i] * g[i];
          const unsigned w0 = cvt_pk(x[0], x[1]), w1 = cvt_pk(x[2], x[3]);
          T[(nn + 0) * P + k] = (bf16_t)(w0 & 0xffffu); T[(nn + 1) * P + k] = (bf16_t)(w0 >> 16);
          T[(nn + 2) * P + k] = (bf16_t)(w1 & 0xffffu); T[(nn + 3) * P + k] = (bf16_t)(w1 >> 16); } }
    __syncthreads();
    { const int n = tid >> 3, kc = (tid & 7) * 16;
      const LAS unsigned* rp = (const LAS unsigned*)(T + n * P + kc);
      u32x4 a = {rp[0], rp[1], rp[2], rp[3]}, b = {rp[4], rp[5], rp[6], rp[7]};
      bf16_t* dp = J.dst + (J.dst_row0 + n) * J.dst_ld + J.k0 + kc;
      *(u32x4*)dp = a; *(u32x4*)(dp + 8) = b; }
    __syncthreads();
}

constexpr int DEF_LO = NE * 2 * 16 * 8, DEF_N = 6400, DEF_HI = DEF_LO + DEF_N;
constexpr int DEF_QUOTA = 32;
constexpr int DEF2_LO = NL * NE * 2 * 16 * 8 + NE * 4 * 32, DEF2_N = 0, DEF2_HI = DEF2_LO + DEF2_N;
__device__ __forceinline__ void cvt_deferred(const Args& a, LAS unsigned char* lds, int s_rank, int ns, const int DLO, const int DN) {
    const int tid = ltid();
    CvtJob J0, J1; f32x4 v0[4], v1[4]; float g0[4], g1[4];
#pragma unroll
    for (int i = 0; i < 4; ++i) { v0[i] = (f32x4){0.f, 0.f, 0.f, 0.f}; v1[i] = v0[i]; g0[i] = 0.f; g1[i] = 0.f; }
    int job = s_rank;
    if (job < DN) { cvt_decode(a, DLO + job, J0); cvt_load(J0, tid, v0, g0); }
    for (; job < DN; job += 2 * ns) {
        const bool h1 = (job + ns) < DN;
        if (h1) { cvt_decode(a, DLO + job + ns, J1); cvt_load(J1, tid, v1, g1); }
        cvt_store(lds, J0, tid, v0, g0);
        const bool h2 = (job + 2 * ns) < DN;
        if (h2) { cvt_decode(a, DLO + job + 2 * ns, J0); cvt_load(J0, tid, v0, g0); }
        if (h1) cvt_store(lds, J1, tid, v1, g1);
    }
}
__device__ __forceinline__ void p0_prologue(const Args& a, LAS unsigned char* lds) {
    unsigned char* ws = a.ws;
    const int G = gridDim.x, bx = blockIdx.x, tid = ltid();
    constexpr int J_ALL = NL * NE * 2 * 16 * 8 + NL * NE * 4 * 32 + NL * 16 * 100 + NL * 16 * 32;
    constexpr int J_RUN = J_ALL - DEF_N - DEF2_N;
#define PRO_ID(j) ((j) < DEF_LO ? (j) : ((j) + DEF_N < DEF2_LO ? (j) + DEF_N : (j) + DEF_N + DEF2_N))
    {
        CvtJob J0, J1; f32x4 v0[4], v1[4]; float g0[4], g1[4];
        int job = bx;
        if (job < J_RUN) { cvt_decode(a, PRO_ID(job), J0); cvt_load(J0, tid, v0, g0); }
        for (; job < J_RUN; job += 2 * G) {
            const bool h1 = (job + G) < J_RUN;
            if (h1) { cvt_decode(a, PRO_ID(job + G), J1); cvt_load(J1, tid, v1, g1); }
            cvt_store(lds, J0, tid, v0, g0);
            const bool h2 = (job + 2 * G) < J_RUN;
            if (h2) { cvt_decode(a, PRO_ID(job + 2 * G), J0); cvt_load(J0, tid, v0, g0); }
            if (h1) cvt_store(lds, J1, tid, v1, g1);
        }
    }
#undef PRO_ID
    for (int i = bx * NTHR + tid; i < NL * 36 * DM; i += G * NTHR) {
        const int k = i % DM; const int jj = (i / DM) % 36; const int l = i / (DM * 36);
        const float g = a.in[I_N2G][l * DM + k];
        const float w = jj < 4 ? a.in[I_WGRP][((size_t)l * DM + k) * 4 + jj] : a.in[I_WEXP][((size_t)l * DM + k) * 32 + (jj - 4)];
        ((float*)(ws + WS_WR))[((size_t)l * 64 + (jj < 4 ? 32 + jj : jj - 4)) * DM + k] = g * w;
    }
    { const int wave = tid >> 6, lane = tid & 63;
      for (int row = bx * 8 + wave; row < NT; row += G * 8) {
          const float* xp = a.in[I_X] + (size_t)row * DM; bf16_t* bp = (bf16_t*)(ws + WS_XB) + (size_t)row * DM; float ss = 0.f;
          f32x4 xv[8];
#pragma unroll
          for (int i = 0; i < 8; ++i) xv[i] = *(const f32x4*)(xp + i * 256 + lane * 4);
          __builtin_amdgcn_sched_barrier(0);
#pragma unroll
          for (int i = 0; i < 8; ++i) { const f32x4 v = xv[i]; ss += v[0] * v[0] + v[1] * v[1] + v[2] * v[2] + v[3] * v[3];
              u32x2 w = {cvt_pk(v[0], v[1]), cvt_pk(v[2], v[3])}; *(u32x2*)(bp + i * 256 + lane * 4) = w; }
          ss = wave_sum(ss);
          if (lane == 0) ((float*)(ws + WS_RSTD1))[row] = rsqrtf(ss * (1.f / DM) + EPS);
      } }
}

template <int HALFR>
__device__ __forceinline__ void rope_inplace(float* v, int pos) {
#pragma unroll
    for (int i = 0; i < HALFR; ++i) {
        const float inv = exp2f(-(float)(2 * i) / (float)(2 * HALFR) * 18.931568569324174f);
        const float ang = (float)pos * inv;
        float t = ang * 0.15915494309189535f; t -= rintf(t);
        const float s = __builtin_amdgcn_sinf(t), c = __builtin_amdgcn_cosf(t);
        const float x1 = v[i], x2 = v[i + HALFR];
        v[i] = x1 * c - x2 * s; v[i + HALFR] = x2 * c + x1 * s;
    }
}
__device__ __forceinline__ void load64(const bf16_t* p, float* v) {
#pragma unroll
    for (int i = 0; i < 8; ++i) { const u32x4 w = *(const u32x4*)(p + i * 8);
#pragma unroll
        for (int j = 0; j < 4; ++j) { v[i * 8 + 2 * j] = bflo(w[j]); v[i * 8 + 2 * j + 1] = bfhi(w[j]); } }
}
__device__ __forceinline__ void store64(bf16_t* p, const float* v) {
#pragma unroll
    for (int i = 0; i < 8; ++i) { u32x4 w;
#pragma unroll
        for (int j = 0; j < 4; ++j) w[j] = cvt_pk(v[i * 8 + 2 * j], v[i * 8 + 2 * j + 1]);
        *(u32x4*)(p + i * 8) = w; }
}

__device__ __forceinline__ void p2_prep(const Args& a, int l, LAS unsigned char* lds) {
    unsigned char* ws = a.ws;
    const int G = gridDim.x, bx = blockIdx.x, tid = ltid(), wave = tid >> 6, lane = tid & 63;
    const bf16_t* PROJ = (const bf16_t*)(ws + WS_PROJ);
    constexpr int NJOB = 49;
    for (int unit = bx; unit < 32 * NJOB; unit += G) {
        const int rb = unit / NJOB, job = unit % NJOB;
        const int b = rb >> 3, blk = rb & 7, s0 = blk * 256, tok0 = rb * 256;
        const bool is_v = (job >= 12 && job < 18) || (job >= 28 && job < 33) || job == 39;
        if (is_v) {
            int col0; bf16_t* dst;
            if (job < 18) { const int h = job - 12; col0 = OVA + h * 128; dst = (bf16_t*)(ws + WS_VAT) + ((size_t)(b * 6 + h) * 128) * SEQ; }
            else if (job < 33) { const int h = job - 28; col0 = OVB + h * 128; dst = (bf16_t*)(ws + WS_VBT) + ((size_t)(b * 5 + h) * 128) * SEQ; }
            else { col0 = OVC; dst = (bf16_t*)(ws + WS_VCT) + ((size_t)b * 128) * SEQ; }
            { const int c = tid & 15;
#pragma unroll
              for (int i = 0; i < 8; ++i) { const int t = (tid >> 4) + 32 * i;
                  const u32x4 w = *(const u32x4*)(PROJ + (size_t)(tok0 + t) * NPAD + col0 + c * 8);
                  *(LAS u32x4*)(lds + t * 256 + c * 16) = w; } }
            __syncthreads();
            {
              unsigned lo[16], hi[16];
#pragma unroll
              for (int i = 0; i < 16; ++i) {
                  const unsigned w0 = *(const LAS unsigned*)(lds + (wave * 32 + 2 * i) * 256 + lane * 4);
                  const unsigned w1 = *(const LAS unsigned*)(lds + (wave * 32 + 2 * i + 1) * 256 + lane * 4);
                  lo[i] = (w0 & 0xffffu) | (w1 << 16); hi[i] = (w0 >> 16) | (w1 & 0xffff0000u); }
              bf16_t* d0 = dst + (size_t)(2 * lane) * SEQ + s0 + wave * 32; bf16_t* d1 = d0 + SEQ;
#pragma unroll
              for (int i = 0; i < 4; ++i) { u32x4 x = {lo[4 * i], lo[4 * i + 1], lo[4 * i + 2], lo[4 * i + 3]}, y = {hi[4 * i], hi[4 * i + 1], hi[4 * i + 2], hi[4 * i + 3]};
                  *(u32x4*)(d0 + i * 8) = x; *(u32x4*)(d1 + i * 8) = y; } }
            __syncthreads();
        } else {
            const int t = tid >> 1, half = tid & 1, tok = tok0 + t, pos = s0 + t;
            float v[64];
            if (job < 12) {
                const bool isq = job < 6; const int h = isq ? job : job - 6;
                load64(PROJ + (size_t)tok * NPAD + (isq ? OQA : OKA) + h * 128 + half * 64, v);
                float ss = 0.f;
#pragma unroll
                for (int i = 0; i < 64; ++i) ss += v[i] * v[i];
                const float rs = rsqrtf(ss * (1.f / 64.f) + EPS);
                const float* g = a.in[isq ? I_AQN : I_AKN] + l * 64;
#pragma unroll
                for (int i = 0; i < 64; ++i) v[i] = v[i] * rs * g[i];
                rope_inplace<8>(v, pos);
                if (isq) {
#pragma unroll
                    for (int i = 0; i < 64; ++i) v[i] *= 0.125f * LOG2E;
                }
                store64((bf16_t*)(ws + (isq ? WS_QA : WS_KA)) + ((size_t)(b * 6 + h) * SEQ + pos) * 128 + half * 64, v);
            } else if (job < 40) {
                int col0, gi; bf16_t* dst; bool isq = false, iskb = false; int hh = 0;
                if (job < 23) { hh = job - 18; col0 = OQB + hh * 128; gi = I_BQN; dst = (bf16_t*)(ws + WS_QB) + ((size_t)(b * 5 + hh) * SEQ + pos) * 128; isq = true; }
                else if (job < 28) { hh = job - 23; col0 = OKB + hh * 128; gi = I_BKN; dst = (bf16_t*)(ws + WS_KB) + ((size_t)(b * 5 + hh) * SEQ + pos) * 128; iskb = true; }
                else if (job < 38) { hh = job - 33; col0 = OQC + hh * 128; gi = I_CQN; dst = (bf16_t*)(ws + WS_QC) + ((size_t)(b * 5 + hh) * SEQ + pos) * 128; isq = true; }
                else { col0 = OKC; gi = I_CKN; dst = (bf16_t*)(ws + WS_KC) + ((size_t)b * SEQ + pos) * 128; }
                load64(PROJ + (size_t)tok * NPAD + col0 + half * 64, v);
                float ss = 0.f;
#pragma unroll
                for (int i = 0; i < 64; ++i) ss += v[i] * v[i];
                ss += __shfl_xor(ss, 1, 64);
                const float rs = rsqrtf(ss * (1.f / 128.f) + EPS);
                const float* g = a.in[gi] + l * 128 + half * 64;
#pragma unroll
                for (int i = 0; i < 64; ++i) v[i] = v[i] * rs * g[i];
                if (half == 0) rope_inplace<16>(v, pos);
                if (iskb) {
                    LAS float* red = (LAS float*)lds;
#pragma unroll
                    for (int i = 0; i < 64; ++i) { float x = v[i];
                        x += __shfl_xor(x, 2, 64); x += __shfl_xor(x, 4, 64); x += __shfl_xor(x, 8, 64); x += __shfl_xor(x, 16, 64); x += __shfl_xor(x, 32, 64);
                        if (lane < 2) red[wave * 128 + half * 64 + i] = x; }
                    __syncthreads();
                    if (tid < 128) { float s = 0.f;
#pragma unroll
                        for (int w = 0; w < 8; ++w) s += red[w * 128 + tid];
                        ((float*)(ws + WS_KMEAN))[((size_t)(b * 5 + hh) * 8 + blk) * 128 + tid] = s * (1.f / 256.f); }
                    __syncthreads();
                }
                if (isq) {
#pragma unroll
                    for (int i = 0; i < 64; ++i) v[i] *= 0.08838834764831845f * LOG2E;
                }
                store64(dst + half * 64, v);
            } else if (job < 48) {
                const int h = (job - 40) * 2 + half;
                load64(PROJ + (size_t)tok * NPAD + OQI + h * 64, v);
                rope_inplace<8>(v, pos);
                store64((bf16_t*)(ws + WS_QI) + (size_t)tok * 1024 + h * 64, v);
            } else {
                if (half == 0) {
                    load64(PROJ + (size_t)tok * NPAD + OKI, v);
                    float ss = 0.f;
#pragma unroll
                    for (int i = 0; i < 64; ++i) ss += v[i] * v[i];
                    const float rs = rsqrtf(ss * (1.f / 64.f) + EPS);
                    const float* g = a.in[I_IKN] + l * 64;
#pragma unroll
                    for (int i = 0; i < 64; ++i) v[i] = v[i] * rs * g[i];
                    rope_inplace<8>(v, pos);
                    store64((bf16_t*)(ws + WS_KI) + (size_t)tok * 64, v);
                } else {
                    const bf16_t* p = PROJ + (size_t)tok * NPAD + OWI; float* wo = (float*)(ws + WS_WI) + (size_t)tok * 16;
                    const u32x4 w0 = *(const u32x4*)p, w1 = *(const u32x4*)(p + 8);
#pragma unroll
                    for (int j = 0; j < 4; ++j) { wo[2 * j] = bflo(w0[j]) * 0.03125f; wo[2 * j + 1] = bfhi(w0[j]) * 0.03125f; wo[8 + 2 * j] = bflo(w1[j]) * 0.03125f; wo[8 + 2 * j + 1] = bfhi(w1[j]) * 0.03125f; }
                }
            }
        }
    }
}

__device__ __forceinline__ unsigned f2key(float f) { const unsigned u = __float_as_uint(f); return (u & 0x80000000u) ? ~u : (u | 0x80000000u); }
__device__ __forceinline__ float key2f(unsigned k) { const unsigned u = (k & 0x80000000u) ? (k & 0x7fffffffu) : ~k; return __uint_as_float(u); }

constexpr int IX_P = 144, IX_BUF = 256 * IX_P;
__device__ __forceinline__ void idx_unit(const Args& a, int unit, LAS unsigned char* lds) {
    unsigned char* ws = a.ws;
    const int tid = ltid(), wave = tid >> 6, lane = tid & 63, l31 = lane & 31, hi = lane >> 5;
    const int qblk = 511 - unit;
    const int tokb = qblk * 16, tok0 = tokb + wave * 2;
    const int b = tok0 >> 11, sa = tok0 & 2047;
    const int myq = sa + hi;
    const int nchunk = (((tokb & 2047) + 15) >> 8) + 1;
    const bf16_t* QI = (const bf16_t*)(ws + WS_QI); const bf16_t* KI = (const bf16_t*)(ws + WS_KI) + (size_t)b * SEQ * 64; const float* WI = (const float*)(ws + WS_WI);
    bf16x8 qf[4];
    { const int qloc = l31 >> 4, head = l31 & 15; const bf16_t* qp = QI + (size_t)(tok0 + qloc) * 1024 + head * 64 + 8 * hi;
#pragma unroll
      for (int ks = 0; ks < 4; ++ks) qf[ks] = *(const bf16x8*)(qp + ks * 16); }
    float wq[16];
    { const f32x4 a0 = *(const f32x4*)(WI + (size_t)tok0 * 16 + 4 * hi), a1 = *(const f32x4*)(WI + (size_t)tok0 * 16 + 8 + 4 * hi);
      const f32x4 b0 = *(const f32x4*)(WI + (size_t)(tok0 + 1) * 16 + 4 * hi), b1 = *(const f32x4*)(WI + (size_t)(tok0 + 1) * 16 + 8 + 4 * hi);
#pragma unroll
      for (int j = 0; j < 4; ++j) { wq[j] = 0.5f * a0[j]; wq[4 + j] = 0.5f * a1[j]; wq[8 + j] = 0.5f * b0[j]; wq[12 + j] = 0.5f * b1[j]; } }
    u32x4 st[4];
    const u32x4* gsrc = (const u32x4*)KI + tid;
    int ldst[4];
#pragma unroll
    for (int i = 0; i < 4; ++i) { const int p = tid + 512 * i; ldst[i] = (p >> 3) * IX_P + (p & 7) * 16; }
#pragma unroll
    for (int i = 0; i < 4; ++i) st[i] = gsrc[512 * i];
#pragma unroll
    for (int i = 0; i < 4; ++i) *(LAS u32x4*)(lds + ldst[i]) = st[i];
    __syncthreads();
    const int rdo = l31 * IX_P + 16 * hi;
    float sc[64];
#pragma unroll
    for (int c = 0; c < 8; ++c) {
        if (c < nchunk) {
            const bool more = (c + 1) < nchunk;
            if (more) {
#pragma unroll
                for (int i = 0; i < 4; ++i) st[i] = gsrc[(c + 1) * 2048 + 512 * i]; }
            const LAS unsigned char* B = lds + (c & 1) * IX_BUF + rdo;
#pragma unroll
            for (int tp = 0; tp < 8; tp += 2) {
                bf16x8 kf[2][4];
#pragma unroll
                for (int u = 0; u < 2; ++u)
#pragma unroll
                    for (int ks = 0; ks < 4; ++ks) kf[u][ks] = *(const LAS bf16x8*)(B + (tp + u) * 32 * IX_P + ks * 32);
                __builtin_amdgcn_sched_barrier(0);
                f32x16 acc0 = {0.f, 0.f, 0.f, 0.f, 0.f, 0.f, 0.f, 0.f, 0.f, 0.f, 0.f, 0.f, 0.f, 0.f, 0.f, 0.f}, acc1 = acc0;
#pragma unroll
                for (int ks = 0; ks < 4; ++ks) { acc0 = __builtin_amdgcn_mfma_f32_32x32x16_bf16(qf[ks], kf[0][ks], acc0, 0, 0, 0); acc1 = __builtin_amdgcn_mfma_f32_32x32x16_bf16(qf[ks], kf[1][ks], acc1, 0, 0, 0); }
                __builtin_amdgcn_sched_barrier(0);
#pragma unroll
                for (int u = 0; u < 2; ++u) { const int tt = tp + u;
                    float p0 = 0.f, p1 = 0.f;
#pragma unroll
                    for (int r = 0; r < 8; ++r) { const float x0 = u ? acc1[r] : acc0[r], x1 = u ? acc1[8 + r] : acc0[8 + r];
                        p0 = fmaf(wq[r], x0, p0); p0 = fmaf(wq[r], __builtin_fabsf(x0), p0); p1 = fmaf(wq[8 + r], x1, p1); p1 = fmaf(wq[8 + r], __builtin_fabsf(x1), p1); }
                    auto sw = __builtin_amdgcn_permlane32_swap(__float_as_uint(p0), __float_as_uint(p1), false, false);
                    const float s = __uint_as_float(sw[0]) + __uint_as_float(sw[1]);
                    const int key = (c * 8 + tt) * 32 + l31;
                    sc[c * 8 + tt] = (key <= myq) ? s : -INFINITY; }
            }
            if (more) {
#pragma unroll
                for (int i = 0; i < 4; ++i) *(LAS u32x4*)(lds + ((c + 1) & 1) * IX_BUF + ldst[i]) = st[i]; }
            __syncthreads();
        } else {
#pragma unroll
            for (int tt = 0; tt < 8; ++tt) sc[c * 8 + tt] = -INFINITY;
        }
    }
    float thr = -3.0e38f;
    const bool need = (myq + 1) > 256;
    if (__any(need)) {
        float vmin = 3.0e38f, vmax = -3.0e38f;
#pragma unroll
        for (int t = 0; t < 64; ++t) { vmax = fmaxf(vmax, sc[t]); vmin = fminf(vmin, (sc[t] == -INFINITY) ? 3.0e38f : sc[t]); }
#pragma unroll
        for (int o = 1; o < 32; o <<= 1) { vmax = fmaxf(vmax, __shfl_xor(vmax, o, 64)); vmin = fminf(vmin, __shfl_xor(vmin, o, 64)); }
        float lo_v = vmin, hi_v = vmax; int c_lo = myq + 1, c_hi = 1;
        bool done = !need;
        for (int it = 0; it < 128; ++it) {
            const unsigned klo = f2key(lo_v), khi = f2key(hi_v);
            float t = lo_v + (hi_v - lo_v) * (((float)(c_lo - 256) + 0.5f) / (float)(c_lo - c_hi));
            if ((it % 3) == 2 || !(t > lo_v && t < hi_v)) t = key2f(klo + ((khi - klo) >> 1));
            if (c_lo == 256 || khi - klo <= 1u) done = true;
            if (__all(done)) break;
            unsigned n0 = 0u, n1 = 0u, n2 = 0u, n3 = 0u;
#pragma unroll
            for (int q = 0; q < 64; q += 4) { n0 += __float_as_uint(sc[q] - t) >> 31; n1 += __float_as_uint(sc[q + 1] - t) >> 31; n2 += __float_as_uint(sc[q + 2] - t) >> 31; n3 += __float_as_uint(sc[q + 3] - t) >> 31; }
            int c = 64 - (int)((n0 + n1) + (n2 + n3));
            c = half_sum_i32(c);
            if (!done) { if (c >= 256) { lo_v = t; c_lo = c; } else { hi_v = t; c_hi = c; } }
        }
        if (need) thr = lo_v;
    }
    unsigned mylo = 0u, myhi = 0u;
#pragma unroll
    for (int t = 0; t < 64; ++t) {
        const unsigned long long bal = __ballot(sc[t] >= thr);
        if (lane == t) { mylo = (unsigned)bal; myhi = (unsigned)(bal >> 32); }
    }
    unsigned* MASK = (unsigned*)(ws + WS_MASK);
    MASK[(size_t)tok0 * 64 + lane] = mylo;
    MASK[(size_t)(tok0 + 1) * 64 + lane] = myhi;
}

constexpr int AT_KP = 272, AT_VP = 144, AT_KB = 64 * AT_KP, AT_VB = 128 * AT_VP, AT_BUF = AT_KB + AT_VB;

__device__ __forceinline__ bf16x8 pack8(float a0, float a1, float a2, float a3, float a4, float a5, float a6, float a7) {
    u32x4 w = {cvt_pk(a0, a1), cvt_pk(a2, a3), cvt_pk(a4, a5), cvt_pk(a6, a7)}; return __builtin_bit_cast(bf16x8, w);
}

template <int KD, int MODE, int DBG = 0>
__device__ __forceinline__ void attn_core(LAS unsigned char* lds, const bf16_t* kg, const bf16_t* vtg, const int n_kt, const bf16_t* qrow, const int kcol0,
                                          const int qpos, const int wqmax, const unsigned selbits, const int own0, const unsigned* mrow, f32x16 (&o)[4], float& l_out) {
    const int tid = ltid(), lane = tid & 63, l31 = lane & 31, hi = lane >> 5;
    constexpr int NKS = KD / 16;
    bf16x8 qf[NKS];
#pragma unroll
    for (int ks = 0; ks < NKS; ++ks) qf[ks] = *(const bf16x8*)(qrow + kcol0 + ks * 16 + 8 * hi);
#pragma unroll
    for (int d = 0; d < 4; ++d)
#pragma unroll
        for (int r = 0; r < 16; ++r) o[d][r] = 0.f;
    float m = 0.f, l = 0.f; bool has = false;
    const int kc = tid & 15, kr = tid >> 4;
    const int vc = tid & 7, vd = tid >> 3;
    const bf16_t* kgp = kg + (size_t)kr * 128 + kc * 8;
    const bf16_t* vgp = vtg + (size_t)vd * SEQ + vc * 8;
    const int klo = kr * AT_KP + kc * 16, vlo = AT_KB + vd * AT_VP + vc * 16;
    const int kap = (l31 & 0x13) | ((l31 & 4) << 1) | ((l31 & 8) >> 1);
    const int kro = kap * AT_KP + (kcol0 + 8 * hi) * 2, vro = AT_KB + l31 * AT_VP + 16 * hi;
    u32x4 st0, st1, st2, st3;
    st0 = *(const u32x4*)(kgp); st1 = *(const u32x4*)(kgp + 32 * 128); st2 = *(const u32x4*)(vgp); st3 = *(const u32x4*)(vgp + 64 * SEQ);
    *(LAS u32x4*)(lds + klo) = st0; *(LAS u32x4*)(lds + klo + 32 * AT_KP) = st1; *(LAS u32x4*)(lds + vlo) = st2; *(LAS u32x4*)(lds + vlo + 64 * AT_VP) = st3;
    __syncthreads();
    u32x2 mw = {0u, 0u};
    if (MODE == 2) mw = *(const u32x2*)(mrow);
    for (int kt = 0; kt < n_kt; ++kt) {
        const bool more = (kt + 1) < n_kt;
        if (more && !(DBG & 1)) { const bf16_t* kp = kgp + (size_t)(kt + 1) * 64 * 128; const bf16_t* vp = vgp + (kt + 1) * 64;
            st0 = *(const u32x4*)(kp); st1 = *(const u32x4*)(kp + 32 * 128); st2 = *(const u32x4*)(vp); st3 = *(const u32x4*)(vp + 64 * SEQ); }
        const int key0 = kt * 64;
        bool act = key0 <= wqmax;
        const bool past = (MODE == 1) && (key0 < own0);
        const bool selq = ((selbits >> (key0 >> 8)) & 1u) != 0u;
        if (MODE == 1 && past) act = __ballot(selq) != 0ull;
        u32x2 mwn = {0u, 0u};
        if (MODE == 2 && more) mwn = *(const u32x2*)(mrow + 2 * (kt + 1));
        if (act) {
            const LAS unsigned char* B = lds + (kt & 1) * AT_BUF;
            f32x16 s0, s1;
#pragma unroll
            for (int r = 0; r < 16; ++r) { s0[r] = 0.f; s1[r] = 0.f; }
            {
                bf16x8 kf[2 * NKS];
#pragma unroll
                for (int ks = 0; ks < NKS; ++ks) { kf[2 * ks] = *(const LAS bf16x8*)(B + kro + ks * 32); kf[2 * ks + 1] = *(const LAS bf16x8*)(B + kro + 32 * AT_KP + ks * 32); }
                __builtin_amdgcn_sched_barrier(0);
#pragma unroll
                for (int ks = 0; ks < NKS; ++ks) {
                    s0 = __builtin_amdgcn_mfma_f32_32x32x16_bf16(kf[2 * ks], qf[ks], s0, 0, 0, 0);
                    s1 = __builtin_amdgcn_mfma_f32_32x32x16_bf16(kf[2 * ks + 1], qf[ks], s1, 0, 0, 0);
                }
                __builtin_amdgcn_sched_barrier(0);
            }
            bf16x8 vf[16];
#pragma unroll
            for (int kk = 0; kk < 4; ++kk)
#pragma unroll
                for (int d = 0; d < 4; ++d) vf[kk * 4 + d] = *(const LAS bf16x8*)(B + vro + d * 32 * AT_VP + kk * 32);
            __builtin_amdgcn_sched_barrier(0);
            const bool diag = (MODE != 2) && !past && (key0 + 63 > wqmax - 31);
            if (!(DBG & 2)) {
            if (diag) {
                const int d0 = qpos - key0 - 8 * hi;
#pragma unroll
                for (int r = 0; r < 16; ++r) { const int c = 16 * (r >> 3) + (r & 7);
                    s0[r] = (c <= d0) ? s0[r] : -3.0e38f; s1[r] = (c + 32 <= d0) ? s1[r] : -3.0e38f; }
            }
            float mx = fmaxf(s0[0], s1[0]);
#pragma unroll
            for (int r = 1; r < 16; ++r) mx = fmaxf(mx, fmaxf(s0[r], s1[r]));
            mx = pairmax(mx);
            const bool needm = (mx > -1.0e30f) && (!has || (mx - m) > 12.f);
            if (__any(needm)) {
                const float mn = needm ? (has ? fmaxf(m, mx) : mx) : m;
                const float alpha = has ? __builtin_amdgcn_exp2f(m - mn) : 1.f;
                m = mn; has = has || needm; l *= alpha;
#pragma unroll
                for (int d = 0; d < 4; ++d)
#pragma unroll
                    for (int r = 0; r < 16; ++r) o[d][r] *= alpha;
            }
#pragma unroll
            for (int r = 0; r < 16; ++r) { s0[r] = __builtin_amdgcn_exp2f(s0[r] - m); s1[r] = __builtin_amdgcn_exp2f(s1[r] - m); }
            if (MODE == 2) {
                const int w0 = (int)(mw[0] >> (8 * hi)), w1 = (int)(mw[1] >> (8 * hi));
#pragma unroll
                for (int r = 0; r < 16; ++r) { const int c = 16 * (r >> 3) + (r & 7);
                    s0[r] = __uint_as_float(__float_as_uint(s0[r]) & (unsigned)__builtin_amdgcn_sbfe(w0, c, 1));
                    s1[r] = __uint_as_float(__float_as_uint(s1[r]) & (unsigned)__builtin_amdgcn_sbfe(w1, c, 1)); }
            } else if (MODE == 1 && past) {
                const unsigned km = selq ? 0xffffffffu : 0u;
#pragma unroll
                for (int r = 0; r < 16; ++r) { s0[r] = __uint_as_float(__float_as_uint(s0[r]) & km); s1[r] = __uint_as_float(__float_as_uint(s1[r]) & km); }
            }
            float ps = 0.f;
#pragma unroll
            for (int r = 0; r < 16; ++r) ps += s0[r] + s1[r];
            l += ps;
            } else { l += 1.f; }
            bf16x8 pf[4];
            pf[0] = pack8(s0[0], s0[1], s0[2], s0[3], s0[4], s0[5], s0[6], s0[7]);
            pf[1] = pack8(s0[8], s0[9], s0[10], s0[11], s0[12], s0[13], s0[14], s0[15]);
            pf[2] = pack8(s1[0], s1[1], s1[2], s1[3], s1[4], s1[5], s1[6], s1[7]);
            pf[3] = pack8(s1[8], s1[9], s1[10], s1[11], s1[12], s1[13], s1[14], s1[15]);
            __builtin_amdgcn_sched_barrier(0);
#pragma unroll
            for (int kk = 0; kk < 4; ++kk)
#pragma unroll
                for (int d = 0; d < 4; ++d) o[d] = __builtin_amdgcn_mfma_f32_32x32x16_bf16(vf[kk * 4 + d], pf[kk], o[d], 0, 0, 0);
            __builtin_amdgcn_sched_barrier(0);
        }
        if (MODE == 2) mw = mwn;
        if (more && !(DBG & 1)) { LAS unsigned char* Bn = lds + ((kt + 1) & 1) * AT_BUF;
            *(LAS u32x4*)(Bn + klo) = st0; *(LAS u32x4*)(Bn + klo + 32 * AT_KP) = st1; *(LAS u32x4*)(Bn + vlo) = st2; *(LAS u32x4*)(Bn + vlo + 64 * AT_VP) = st3; }
        if (!(DBG & 16)) __syncthreads();
    }
    if (DBG & 16) __syncthreads();
    l_out = pairsum(l);
}

__device__ __forceinline__ void store_o(LAS unsigned char* img, bf16_t* out0, const f32x16 (&o)[4], float scale, int lane) {
    const int l31 = lane & 31, hi = lane >> 5;
#pragma unroll
    for (int d = 0; d < 4; ++d)
#pragma unroll
        for (int g = 0; g < 4; ++g) {
            u32x2 w = {cvt_pk(o[d][4 * g] * scale, o[d][4 * g + 1] * scale), cvt_pk(o[d][4 * g + 2] * scale, o[d][4 * g + 3] * scale)};
            *(LAS u32x2*)(img + l31 * 272 + (d * 32 + 8 * g + 4 * hi) * 2) = w;
        }
    const int r0 = lane >> 4, c = lane & 15;
    u32x4 v[8];
#pragma unroll
    for (int i = 0; i < 8; ++i) v[i] = *(const LAS u32x4*)(img + (r0 + 4 * i) * 272 + c * 16);
#pragma unroll
    for (int i = 0; i < 8; ++i) *(u32x4*)(out0 + (size_t)(r0 + 4 * i) * DM + c * 8) = v[i];
}

__device__ __forceinline__ void attnA_unit(const Args& a, int l, int unit, LAS unsigned char* lds) {
    unsigned char* ws = a.ws;
    const int tid = ltid(), wave = tid >> 6, lane = tid & 63, l31 = lane & 31, hi = lane >> 5;
    const int qt = 15 - unit / 24, bh = unit % 24, b = bh / 6, h = bh % 6, q0 = qt * 128;
    const int comp = wave >> 2, wq0 = q0 + (wave & 3) * 32, qpos = wq0 + l31;
    const bf16_t* kg = (const bf16_t*)(ws + WS_KA) + (size_t)(b * 6 + h) * SEQ * 128;
    const bf16_t* vtg = (const bf16_t*)(ws + WS_VAT) + (size_t)(b * 6 + h) * 128 * SEQ;
    const bf16_t* qrow = (const bf16_t*)(ws + WS_QA) + ((size_t)(b * 6 + h) * SEQ + qpos) * 128;
    f32x16 o[4]; float lsum;
    attn_core<64, 0>(lds, kg, vtg, (q0 + 128) / 64, qrow, comp * 64, qpos, wq0 + 31, 0u, 0, nullptr, o, lsum);
    const float inv = 1.f / lsum;
    LAS float* xp = (LAS float*)lds + (wave & 3) * 4096 + lane;
    if (comp == 1) {
#pragma unroll
        for (int d = 0; d < 4; ++d)
#pragma unroll
            for (int r = 0; r < 16; ++r) xp[(d * 16 + r) * 64] = o[d][r] * inv;
    }
    __syncthreads();
    if (comp == 0) {
        const float* lp = a.in[I_ALAM] + l * 256;
        const float s01 = wave_sum(lp[lane] * lp[64 + lane]), s23 = wave_sum(lp[128 + lane] * lp[192 + lane]);
        const float lam_init = 0.8f - 0.6f * __expf(-0.3f * (float)l);
        const float lam = __expf(s01) - __expf(s23) + lam_init;
        float ss = 0.f;
#pragma unroll
        for (int d = 0; d < 4; ++d) {
            asm volatile("" ::: "memory");
#pragma unroll
            for (int r = 0; r < 16; ++r) { const float v = o[d][r] * inv - lam * xp[(d * 16 + r) * 64]; o[d][r] = v; ss += v * v; }
        }
        ss = pairsum(ss);
        const float rs = rsqrtf(ss * (1.f / 128.f) + EPS) * (1.f - lam_init);
        const float* g = a.in[I_ASUB] + l * 128;
        { f32x4 gv[16];
#pragma unroll
          for (int d = 0; d < 4; ++d)
#pragma unroll
              for (int gq = 0; gq < 4; ++gq) gv[d * 4 + gq] = *(const f32x4*)(g + d * 32 + 8 * gq + 4 * hi);
          __builtin_amdgcn_sched_barrier(0);
#pragma unroll
          for (int d = 0; d < 4; ++d)
#pragma unroll
              for (int gq = 0; gq < 4; ++gq)
#pragma unroll
                  for (int j = 0; j < 4; ++j) o[d][4 * gq + j] *= gv[d * 4 + gq][j]; }
        store_o(lds + 65536 + (wave & 3) * 8704, (bf16_t*)(ws + WS_MIXO) + (size_t)(b * SEQ + wq0) * DM + h * 128, o, rs, lane);
    }
}

template <int DBG>
__device__ __forceinline__ void attnB_unit(const Args& a, int unit, LAS unsigned char* lds) {
    unsigned char* ws = a.ws;
    const int tid = ltid(), wave = tid >> 6, lane = tid & 63, l31 = lane & 31, hi = lane >> 5;
    const int jb = 7 - unit / 20, bh = unit % 20, b = bh / 5, h = bh % 5, q0 = jb * 256;
    const int wq0 = q0 + wave * 32, qpos = wq0 + l31;
    const bf16_t* kg = (const bf16_t*)(ws + WS_KB) + (size_t)(b * 5 + h) * SEQ * 128;
    const bf16_t* vtg = (const bf16_t*)(ws + WS_VBT) + (size_t)(b * 5 + h) * 128 * SEQ;
    const bf16_t* qrow = (const bf16_t*)(ws + WS_QB) + ((size_t)(b * 5 + h) * SEQ + qpos) * 128;
    unsigned sel = 0u;
    if (jb <= 3) sel = (1u << jb) - 1u;
    else {
        float qv[64];
#pragma unroll
        for (int ks = 0; ks < 8; ++ks) { const u32x4 w = *(const u32x4*)(qrow + ks * 16 + 8 * hi);
#pragma unroll
            for (int j = 0; j < 4; ++j) { qv[ks * 8 + 2 * j] = bflo(w[j]); qv[ks * 8 + 2 * j + 1] = bfhi(w[j]); } }
        LAS float* kml = (LAS float*)(lds + 2 * AT_BUF);
        { const float* km = (const float*)(ws + WS_KMEAN) + (size_t)(b * 5 + h) * 8 * 128; const float k0 = km[tid], k1 = km[tid + 512]; kml[tid] = k0; kml[tid + 512] = k1; }
        __syncthreads();
        float gt[7];
#pragma unroll
        for (int n = 0; n < 7; ++n) {
            float sgate = -INFINITY;
            if (n < jb) {
                f32x4 kv[16];
#pragma unroll
                for (int ks = 0; ks < 8; ++ks) { kv[2 * ks] = *(const LAS f32x4*)(kml + n * 128 + ks * 16 + 8 * hi); kv[2 * ks + 1] = *(const LAS f32x4*)(kml + n * 128 + ks * 16 + 8 * hi + 4); }
                __builtin_amdgcn_sched_barrier(0);
                float sacc = 0.f;
#pragma unroll
                for (int ks = 0; ks < 8; ++ks)
#pragma unroll
                    for (int j = 0; j < 4; ++j) { sacc = fmaf(qv[ks * 8 + j], kv[2 * ks][j], sacc); sacc = fmaf(qv[ks * 8 + 4 + j], kv[2 * ks + 1][j], sacc); }
                sgate = pairsum(sacc); }
            gt[n] = sgate;
        }
#pragma unroll
        for (int pick = 0; pick < 3; ++pick) { float best = -INFINITY; int bi = 0;
#pragma unroll
            for (int n = 0; n < 7; ++n) { const bool ok = (n < jb) && !((sel >> n) & 1u) && (gt[n] > best); best = ok ? gt[n] : best; bi = ok ? n : bi; }
            sel |= 1u << bi; }
    }
    f32x16 o[4]; float lsum;
    attn_core<128, 1, DBG>(lds, kg, vtg, (q0 + 256) / 64, qrow, 0, qpos, wq0 + 31, sel, q0, nullptr, o, lsum);
    store_o(lds + wave * 8704, (bf16_t*)(ws + (DBG ? WS_XM : WS_MIXO)) + (size_t)(b * SEQ + wq0) * DM + 768 + h * 128, o, 1.f / lsum, lane);
}

__device__ __forceinline__ void attnC_unit(const Args& a, int unit, LAS unsigned char* lds) {
    unsigned char* ws = a.ws;
    const int tid = ltid(), wave = tid >> 6, lane = tid & 63, l31 = lane & 31, hi = lane >> 5;
    const int jb = 7 - unit / 20, bh = unit % 20, b = bh / 5, h = bh % 5, q0 = jb * 256;
    const int wq0 = q0 + wave * 32, qpos = wq0 + l31;
    const bf16_t* kg = (const bf16_t*)(ws + WS_KC) + (size_t)b * SEQ * 128;
    const bf16_t* vtg = (const bf16_t*)(ws + WS_VCT) + (size_t)b * 128 * SEQ;
    const bf16_t* qrow = (const bf16_t*)(ws + WS_QC) + ((size_t)(b * 5 + h) * SEQ + qpos) * 128;
    const unsigned* mrow = (const unsigned*)(ws + WS_MASK) + (size_t)(b * SEQ + qpos) * 64;
    f32x16 o[4]; float lsum;
    attn_core<128, 2>(lds, kg, vtg, (q0 + 256) / 64, qrow, 0, qpos, wq0 + 31, 0u, 0, mrow, o, lsum);
    store_o(lds + wave * 8704, (bf16_t*)(ws + WS_MIXO) + (size_t)(b * SEQ + wq0) * DM + 1408 + h * 128, o, 1.f / lsum, lane);
}

__device__ __forceinline__ float sel8(const float* v, int i) {
    float r = v[0];
#pragma unroll
    for (int k = 1; k < 8; ++k) r = (i == k) ? v[k] : r;
    return r;
}
__device__ __forceinline__ void p6_router(const Args& a, int l, LAS unsigned char* lds) {
    unsigned char* ws = a.ws;
    const int G = gridDim.x, bx = blockIdx.x, tid = ltid(), wave = tid >> 6, lane = tid & 63, l31 = lane & 31, hi = lane >> 5;
    const float* XM = (const float*)(ws + WS_XM); const float* WR = (const float*)(ws + WS_WR) + (size_t)l * 64 * DM;
    unsigned* cnt = (unsigned*)(ws + WS_CTL) + CW_CNT + l * 32;
    int* LIST = (int*)(ws + WS_LIST); float* LISTG = (float*)(ws + WS_LISTG); int* TOKE = (int*)(ws + WS_TOKE); int* TOKP = (int*)(ws + WS_TOKP);
    LAS float* red = (LAS float*)lds;
    LAS float* ssred = (LAS float*)(lds + 65536);
    LAS float* lg = (LAS float*)(lds + 65536 + 1024);
    LAS int* lcnt = (LAS int*)(lds + 65536 + 1024 + 8192);
    for (int tb = bx; tb < NT / 32; tb += G) {
        const int tok0 = tb * 32;
        f32x16 acc0, acc1;
#pragma unroll
        for (int r = 0; r < 16; ++r) { acc0[r] = 0.f; acc1[r] = 0.f; }
        float ss = 0.f;
        const float* xp = XM + (size_t)(tok0 + l31) * DM + wave * 256 + 4 * hi;
        const float* w0 = WR + (size_t)l31 * DM + wave * 256 + 4 * hi;
        const float* w1 = WR + (size_t)(32 + l31) * DM + wave * 256 + 4 * hi;
        if (tid < 32) lcnt[tid] = 0;
#pragma unroll 4
        for (int it = 0; it < 32; ++it) {
            const f32x4 xv = *(const f32x4*)(xp + it * 8), b0 = *(const f32x4*)(w0 + it * 8), b1 = *(const f32x4*)(w1 + it * 8);
            ss += xv[0] * xv[0] + xv[1] * xv[1] + xv[2] * xv[2] + xv[3] * xv[3];
#pragma unroll
            for (int s = 0; s < 4; ++s) { acc0 = __builtin_amdgcn_mfma_f32_32x32x2f32(xv[s], b0[s], acc0, 0, 0, 0); acc1 = __builtin_amdgcn_mfma_f32_32x32x2f32(xv[s], b1[s], acc1, 0, 0, 0); }
        }
#pragma unroll
        for (int r = 0; r < 16; ++r) { const int trow = (r & 3) + 8 * (r >> 2) + 4 * hi;
            red[(wave * 32 + trow) * 64 + l31] = acc0[r]; red[(wave * 32 + trow) * 64 + 32 + l31] = acc1[r]; }
        ss = pairsum(ss);
        if (hi == 0) ssred[wave * 32 + l31] = ss;
        __syncthreads();
        { const int t = tid >> 4, c4 = (tid & 15) * 4;
          f32x4 sum = {0.f, 0.f, 0.f, 0.f}; float st = 0.f;
#pragma unroll
          for (int w = 0; w < 8; ++w) { sum += *(const LAS f32x4*)(red + (w * 32 + t) * 64 + c4); st += ssred[w * 32 + t]; }
          const float rs = rsqrtf(st * (1.f / DM) + EPS);
          if (c4 < 36) {
#pragma unroll
              for (int j = 0; j < 4; ++j) { const int c = c4 + j; const float bias = c < 32 ? a.in[I_BEXP][l * 32 + c] : a.in[I_BGRP][l * 4 + (c - 32)]; lg[t * 64 + c] = sum[j] * rs + bias; }
          }
          if (c4 == 60) lg[t * 64 + 63] = rs; }
        __syncthreads();
        int e0 = 0, e1 = 0, lp0 = 0, lp1 = 0; float g0 = 0.f, g1 = 0.f;
        if (tid < 32) {
            const LAS float* L = lg + tid * 64;
            int gi = 0; float gm = L[32];
            for (int j = 1; j < 4; ++j) { const float v = L[32 + j]; if (v > gm) { gm = v; gi = j; } }
            float gs = 0.f;
            for (int j = 0; j < 4; ++j) gs += __expf(L[32 + j] - gm);
            const float gw = 1.f / gs;
            float em = L[gi * 8];
            for (int k = 1; k < 8; ++k) em = fmaxf(em, L[gi * 8 + k]);
            float es = 0.f;
            for (int k = 0; k < 8; ++k) es += __expf(L[gi * 8 + k] - em);
            const float ies = 1.f / es;
            int i0 = 0; float v0 = -1.f;
            for (int k = 0; k < 8; ++k) { const float p = __expf(L[gi * 8 + k] - em) * ies; if (p > v0) { v0 = p; i0 = k; } }
            int i1 = 0; float v1 = -1.f;
            for (int k = 0; k < 8; ++k) { const float p = __expf(L[gi * 8 + k] - em) * ies; if (k != i0 && p > v1) { v1 = p; i1 = k; } }
            const float inv = 1.f / (v0 + v1);
            g0 = gw * v0 * inv; g1 = gw * v1 * inv; e0 = gi * 8 + i0; e1 = gi * 8 + i1;
            lp0 = atomicAdd((int*)(lcnt + e0), 1); lp1 = atomicAdd((int*)(lcnt + e1), 1);
        }
        __syncthreads();
        if (tid < 32) { const int c = lcnt[tid]; lcnt[32 + tid] = c > 0 ? (int)atomicAdd(cnt + tid, (unsigned)c) : 0; }
        __syncthreads();
        if (tid < 32) {
            const int tok = tok0 + tid, p0 = lcnt[32 + e0] + lp0, p1 = lcnt[32 + e1] + lp1;
            LIST[(size_t)e0 * NT + p0] = tok; LISTG[(size_t)e0 * NT + p0] = g0; LIST[(size_t)e1 * NT + p1] = tok; LISTG[(size_t)e1 * NT + p1] = g1;
            TOKE[tok * 2] = e0; TOKE[tok * 2 + 1] = e1; TOKP[tok * 2] = p0; TOKP[tok * 2 + 1] = p1;
            ((float*)(ws + WS_RSTD2))[tok] = lg[tid * 64 + 63];
        }
        __syncthreads();
    }
}

constexpr int SK_MAX = 0;
struct MoeTab { volatile LAS int* tpre; volatile LAS int* dcnt; volatile LAS int* skrows; volatile LAS int* skbase; volatile LAS int* ske; volatile LAS int* skn; };
__device__ __forceinline__ MoeTab moe_tab_ptrs(LAS unsigned char* lds) {
    MoeTab T; T.tpre = (volatile LAS int*)(lds + LDS_CTL + 64); T.dcnt = (volatile LAS int*)(lds + LDS_CTL + 256); T.skrows = (volatile LAS int*)(lds + LDS_CTL + 384);
    T.skbase = (volatile LAS int*)(lds + LDS_CTL + 512); T.ske = (volatile LAS int*)(lds + LDS_CTL + 640); T.skn = (volatile LAS int*)(lds + LDS_CTL + 768); return T;
}
__device__ __forceinline__ void moe_table(const Args& a, int l, const MoeTab& T) {
    const unsigned* cnt = (const unsigned*)(a.ws + WS_CTL) + CW_CNT + l * 32;
    const int tid = ltid();
    __syncthreads();
    if (tid < 32) T.dcnt[tid] = (int)ld_agent(cnt + tid);
    __syncthreads();
    if (tid == 0) { int acc = 0, nsk = 0;
#pragma unroll 1
        for (int e = 0; e < NE; ++e) { const int c = T.dcnt[e], f = c >> 8, rem = c & 255; const int sk = (rem > 0 && rem <= SK_MAX) ? rem : 0;
            T.tpre[e] = acc; acc += f + ((rem > SK_MAX) ? 1 : 0); T.dcnt[e] = sk ? (f << 8) : c; T.skrows[e] = sk; if (sk) { T.ske[nsk] = e; ++nsk; } }
        T.tpre[NE] = acc; *T.skn = nsk;
        int base = acc * 256;
#pragma unroll 1
        for (int i = 0; i < nsk; ++i) { T.skbase[T.ske[i]] = base; base += 64; } }
    __syncthreads();
}
__device__ __forceinline__ size_t moe_row(const MoeTab& T, int e, int pos) {
    const int d = T.dcnt[e]; return pos < d ? (size_t)T.tpre[e] * 256 + pos : (size_t)T.skbase[e] + (pos - d);
}

template <int NR, int NC, int U = 4>
__device__ __forceinline__ void wave_gemm(const bf16_t* const (&ap)[NR], const bf16_t* const (&bp)[NC], const int nr, const int nsteps, f32x4 (&acc)[NR][NC]) {
#pragma unroll
    for (int i = 0; i < NR; ++i)
#pragma unroll
        for (int j = 0; j < NC; ++j) acc[i][j] = (f32x4){0.f, 0.f, 0.f, 0.f};
#pragma unroll 1
    for (int s0 = 0; s0 < nsteps; s0 += U) {
        bf16x8 af[U][NR], bf[U][NC];
#pragma unroll
        for (int u = 0; u < U; ++u) {
#pragma unroll
            for (int i = 0; i < NR; ++i) if (i < nr) af[u][i] = *(const bf16x8*)(ap[i] + (s0 + u) * 32);
#pragma unroll
            for (int j = 0; j < NC; ++j) bf[u][j] = *(const bf16x8*)(bp[j] + (s0 + u) * 32);
        }
        __builtin_amdgcn_sched_barrier(0);
#pragma unroll
        for (int u = 0; u < U; ++u)
#pragma unroll
            for (int i = 0; i < NR; ++i) if (i < nr)
#pragma unroll
                for (int j = 0; j < NC; ++j) acc[i][j] = __builtin_amdgcn_mfma_f32_16x16x32_bf16(bf[u][j], af[u][i], acc[i][j], 0, 0, 0);
    }
}

__device__ __forceinline__ void skinny_kiwi(const Args& a, int l, LAS unsigned char* lds) {
    unsigned char* ws = a.ws;
    const int G = gridDim.x, bx = blockIdx.x, tid = ltid(), wave = tid >> 6, lane = tid & 63, fr = lane & 15, fq = lane >> 4, rg = wave >> 2, kq = wave & 3;
    const bf16_t* XB = (const bf16_t*)(ws + WS_XB); const bf16_t* W = (const bf16_t*)(ws + WS_WIN) + (size_t)l * NPAD * DM; bf16_t* PROJ = (bf16_t*)(ws + WS_PROJ);
    LAS f32x4* red = (LAS f32x4*)lds;
    for (int rb = bx; rb < NT / 32; rb += G) {
        const int row = rb * 32 + rg * 16 + fr;
        const bf16_t* ap[1] = {XB + (size_t)row * DM + kq * 512 + 8 * fq};
        const bf16_t* bp[5];
#pragma unroll
        for (int j = 0; j < 5; ++j) bp[j] = W + (size_t)(6144 + 16 * j + fr) * DM + kq * 512 + 8 * fq;
        f32x4 acc[1][5];
        wave_gemm<1, 5>(ap, bp, 1, 16, acc);
        if (kq > 0) {
#pragma unroll
            for (int j = 0; j < 5; ++j) red[((rg * 3 + kq - 1) * 5 + j) * 64 + lane] = acc[0][j]; }
        __syncthreads();
        if (kq == 0) { const float rs = ((const float*)(ws + WS_RSTD1))[row];
#pragma unroll
            for (int j = 0; j < 5; ++j) { f32x4 v = acc[0][j];
#pragma unroll
                for (int k = 0; k < 3; ++k) v += red[((rg * 3 + k) * 5 + j) * 64 + lane];
                v = v * rs; u32x2 w = {cvt_pk(v[0], v[1]), cvt_pk(v[2], v[3])}; *(u32x2*)(PROJ + (size_t)row * NPAD + 6144 + 16 * j + 4 * fq) = w; } }
        __syncthreads();
    }
}

__device__ __forceinline__ void skinny_up(const Args& a, int l, LAS unsigned char* lds, const MoeTab& T) {
    unsigned char* ws = a.ws;
    const int G = gridDim.x, bx = blockIdx.x, tid = ltid(), wave = tid >> 6, lane = tid & 63, fr = lane & 15, fq = lane >> 4;
    const bf16_t* XMB = (const bf16_t*)(ws + WS_XMB); const int* LIST = (const int*)(ws + WS_LIST); const float* LISTG = (const float*)(ws + WS_LISTG);
    bf16_t* H = (bf16_t*)(ws + WS_H);
    const int ntask = (*T.skn) * 16;
    for (int bt = bx; bt < ntask; bt += G) {
        const int e = T.ske[bt >> 4], rows = T.skrows[e], p0 = T.dcnt[e];
        const int wt = (bt & 15) * 8 + wave, rg = wt >> 5, f0 = (wt & 31) * 16;
        if (rg * 16 < rows) {
            const bf16_t* W = (const bf16_t*)(ws + WS_W1) + ((size_t)(l * NE + e)) * 1024 * DM;
            int r = 16 * rg + fr; const bool rv = r < rows; r = rv ? r : rows - 1;
            const int tok = LIST[(size_t)e * NT + p0 + r];
            const bf16_t* ap[1] = {XMB + (size_t)tok * DM + 8 * fq};
            const bf16_t* bp[2];
            bp[0] = W + (size_t)((f0 >> 7) * 256 + (f0 & 127) + fr) * DM + 8 * fq; bp[1] = bp[0] + (size_t)128 * DM;
            f32x4 acc[1][2];
            wave_gemm<1, 2, 8>(ap, bp, 1, 64, acc);
            if (rv) { const float rs = ((const float*)(ws + WS_RSTD2))[tok], gv = LISTG[(size_t)e * NT + p0 + r]; const f32x4 g = acc[0][0] * rs, up = acc[0][1] * rs; float h[4];
#pragma unroll
                for (int q = 0; q < 4; ++q) { const float sg = g[q] / (1.f + __expf(-g[q])); h[q] = sg * up[q] * gv; }
                u32x2 w = {cvt_pk(h[0], h[1]), cvt_pk(h[2], h[3])}; *(u32x2*)(H + ((size_t)T.skbase[e] + r) * FF + f0 + 4 * fq) = w; }
        }
    }
}

__device__ __forceinline__ void skinny_down(const Args& a, int l, const MoeTab& T) {
    unsigned char* ws = a.ws;
    const int G = gridDim.x, bx = blockIdx.x, tid = ltid(), wave = tid >> 6, lane = tid & 63, fr = lane & 15, fq = lane >> 4;
    const bf16_t* H = (const bf16_t*)(ws + WS_H); bf16_t* Y = (bf16_t*)(ws + WS_Y);
    const int ntask = (*T.skn) * 8;
    for (int bt = bx; bt < ntask; bt += G) {
        const int e = T.ske[bt >> 3], rows = T.skrows[e], nr = (rows + 15) >> 4, n0 = (bt & 7) * 256 + wave * 32;
        const size_t rb = (size_t)T.skbase[e];
        const bf16_t* W = (const bf16_t*)(ws + WS_WD) + ((size_t)(l * NE + e)) * DM * FF;
        const bf16_t* ap[4];
#pragma unroll
        for (int i = 0; i < 4; ++i) { int r = 16 * i + fr; r = r < rows ? r : rows - 1; ap[i] = H + (rb + r) * FF + 8 * fq; }
        const bf16_t* bp[2] = {W + (size_t)(n0 + fr) * FF + 8 * fq, W + (size_t)(n0 + 16 + fr) * FF + 8 * fq};
        f32x4 acc[4][2];
        wave_gemm<4, 2>(ap, bp, nr, 16, acc);
#pragma unroll
        for (int i = 0; i < 4; ++i) { const int r = 16 * i + fr;
            if (r < rows) {
#pragma unroll
                for (int j = 0; j < 2; ++j) { const f32x4 v = acc[i][j]; u32x2 w = {cvt_pk(v[0], v[1]), cvt_pk(v[2], v[3])}; *(u32x2*)(Y + (rb + r) * DM + n0 + 16 * j + 4 * fq) = w; } } }
    }
}

__device__ __forceinline__ void p9_combine(const Args& a, int l, const MoeTab& T) {
    unsigned char* ws = a.ws;
    const int G = gridDim.x, bx = blockIdx.x, tid = ltid(), wave = tid >> 6, lane = tid & 63;
    const float* XM = (const float*)(ws + WS_XM); const bf16_t* Y = (const bf16_t*)(ws + WS_Y);
    const int* TOKE = (const int*)(ws + WS_TOKE); const int* TOKP = (const int*)(ws + WS_TOKP);
    float* xo = (l == NL - 1) ? a.out : (float*)(ws + WS_X1);
    bf16_t* XB = (bf16_t*)(ws + WS_XB); float* RSTD1 = (float*)(ws + WS_RSTD1);
    for (int row = bx * 8 + wave; row < NT; row += G * 8) {
        const int e0 = TOKE[row * 2], e1 = TOKE[row * 2 + 1];
        const size_t r0 = moe_row(T, e0, TOKP[row * 2]), r1 = moe_row(T, e1, TOKP[row * 2 + 1]);
        float ss = 0.f;
        f32x4 xv[8]; u32x2 ya[8], yb[8];
#pragma unroll
        for (int i = 0; i < 8; ++i) { const int c = i * 256 + lane * 4;
            xv[i] = *(const f32x4*)(XM + (size_t)row * DM + c); ya[i] = *(const u32x2*)(Y + r0 * DM + c); yb[i] = *(const u32x2*)(Y + r1 * DM + c); }
        __builtin_amdgcn_sched_barrier(0);
#pragma unroll
        for (int i = 0; i < 8; ++i) { const int c = i * 256 + lane * 4;
            f32x4 v = xv[i]; const u32x2 y0 = ya[i], y1 = yb[i];
            v[0] = (v[0] + bflo(y0[0])) + bflo(y1[0]); v[1] = (v[1] + bfhi(y0[0])) + bfhi(y1[0]); v[2] = (v[2] + bflo(y0[1])) + bflo(y1[1]); v[3] = (v[3] + bfhi(y0[1])) + bfhi(y1[1]);
            *(f32x4*)(xo + (size_t)row * DM + c) = v;
            ss += v[0] * v[0] + v[1] * v[1] + v[2] * v[2] + v[3] * v[3];
            u32x2 w = {cvt_pk(v[0], v[1]), cvt_pk(v[2], v[3])}; *(u32x2*)(XB + (size_t)row * DM + c) = w; }
        ss = wave_sum(ss);
        if (lane == 0) RSTD1[row] = rsqrtf(ss * (1.f / DM) + EPS);
    }
}

constexpr int N_PHASES = 1 + 9 * NL;
typedef const Args __attribute__((address_space(4)))* ArgsP;
#define PHASE_FN static __device__ __forceinline__ void
__device__ __forceinline__ Args ld_args(ArgsP ap) {
    Args a;
#pragma unroll
    for (int i = 0; i < 21; ++i) a.in[i] = ap->in[i];
    a.out = ap->out; a.ws = ap->ws; a.ph_lo = ap->ph_lo; a.ph_hi = ap->ph_hi; return a;
}

PHASE_FN ph_prologue(ArgsP ap, LAS unsigned char* lds) { asm volatile("" : "+s"(ap)); const Args a = ld_args(ap); p0_prologue(a, lds); }
PHASE_FN ph_inproj(ArgsP ap, LAS unsigned char* lds, int l) {
    asm volatile("" : "+s"(ap)); const Args a = ld_args(ap); unsigned char* ws = a.ws;
    pg8::DenseSched S; S.init(ws + WS_XB, ws + WS_WIN + (size_t)l * NPAD * DM * 2, NT, 6144, DM, gridDim.x, blockIdx.x);
    EpiProj E{(bf16_t*)(ws + WS_PROJ), (const float*)(ws + WS_RSTD1)};
    pg8::gemm_phase(lds, DM, S, E);
    skinny_kiwi(a, l, lds);
    if (REPEAT_PH == 11) { skinny_kiwi(a, l, lds); skinny_kiwi(a, l, lds); }
}
PHASE_FN ph_prep(ArgsP ap, LAS unsigned char* lds, int l) { asm volatile("" : "+s"(ap)); const Args a = ld_args(ap); p2_prep(a, l, lds); }
PHASE_FN ph_idx(ArgsP ap, LAS unsigned char* lds, int l, int rep) {
    asm volatile("" : "+s"(ap)); const Args a = ld_args(ap); unsigned* qh = (unsigned*)(a.ws + WS_CTL) + CW_Q + l * 8 * 64; volatile LAS int* slot = (volatile LAS int*)(lds + LDS_CTL + 32);
    for (;;) { const int u = next_unit(qh + (0 + 4 * rep) * 64, slot); if (u >= 512) break; idx_unit(a, u, lds); }
}
PHASE_FN ph_attnA(ArgsP ap, LAS unsigned char* lds, int l, int rep) {
    asm volatile("" : "+s"(ap)); const Args a = ld_args(ap); unsigned* qh = (unsigned*)(a.ws + WS_CTL) + CW_Q + l * 8 * 64; volatile LAS int* slot = (volatile LAS int*)(lds + LDS_CTL + 32);
    for (;;) { const int u = next_unit(qh + (1 + 4 * rep) * 64, slot); if (u >= 384) break; attnA_unit(a, l, u, lds); }
}
template <int DBG>
PHASE_FN ph_attnB(ArgsP ap, LAS unsigned char* lds, int l, int rep) {
    asm volatile("" : "+s"(ap)); const Args a = ld_args(ap); unsigned* qh = (unsigned*)(a.ws + WS_CTL) + CW_Q + l * 8 * 64; volatile LAS int* slot = (volatile LAS int*)(lds + LDS_CTL + 32);
    for (;;) { const int u = next_unit(qh + (2 + 4 * rep) * 64, slot); if (u >= 160) break; attnB_unit<DBG>(a, u, lds); }
}
PHASE_FN ph_attnC(ArgsP ap, LAS unsigned char* lds, int l, int rep) {
    asm volatile("" : "+s"(ap)); const Args a = ld_args(ap); unsigned* qh = (unsigned*)(a.ws + WS_CTL) + CW_Q + l * 8 * 64; volatile LAS int* slot = (volatile LAS int*)(lds + LDS_CTL + 32);
    for (;;) { const int u = next_unit(qh + (3 + 4 * rep) * 64, slot); if (u >= 160) break; attnC_unit(a, u, lds); }
}
PHASE_FN ph_outproj(ArgsP ap, LAS unsigned char* lds, int l) {
    asm volatile("" : "+s"(ap)); const Args a = ld_args(ap); unsigned char* ws = a.ws;
    pg8::DenseSched S; S.init(ws + WS_MIXO, ws + WS_WOUT + (size_t)l * DM * DM * 2, NT, DM, DM, gridDim.x, blockIdx.x);
    EpiOut E{l == 0 ? a.in[I_X] : (const float*)(ws + WS_X1), (float*)(ws + WS_XM), (bf16_t*)(ws + WS_XMB)};
    pg8::gemm_phase(lds, DM, S, E);
}
PHASE_FN ph_router(ArgsP ap, LAS unsigned char* lds, int l) { asm volatile("" : "+s"(ap)); const Args a = ld_args(ap); p6_router(a, l, lds); }
PHASE_FN ph_moe_up(ArgsP ap, LAS unsigned char* lds, int l) {
    asm volatile("" : "+s"(ap)); const Args a = ld_args(ap); unsigned char* ws = a.ws;
    const MoeTab T = moe_tab_ptrs(lds);
    const int G = gridDim.x, bx = blockIdx.x; const int vcu = (G % 8 == 0) ? (bx % 8) * (G / 8) + bx / 8 : bx;
    moe_table(a, l, T);
    pg8::MoeSched<true> S{(const char*)(ws + WS_XMB), (const char*)(ws + WS_W1 + (size_t)l * NE * 1024 * DM * 2), (const int*)(ws + WS_LIST), T.tpre, T.dcnt, DM, 4, T.tpre[NE], G, vcu, (size_t)1024 * DM * 2};
    EpiUp E{(bf16_t*)(ws + WS_H), (const int*)(ws + WS_LIST), (const float*)(ws + WS_LISTG), (const float*)(ws + WS_RSTD2), T.tpre};
    pg8::gemm_phase(lds, DM, S, E);
    skinny_up(a, l, lds, T);
    if (REPEAT_PH == 71) { skinny_up(a, l, lds, T); skinny_up(a, l, lds, T); }
}
PHASE_FN ph_moe_down(ArgsP ap, LAS unsigned char* lds, int l) {
    asm volatile("" : "+s"(ap)); const Args a = ld_args(ap); unsigned char* ws = a.ws;
    const MoeTab T = moe_tab_ptrs(lds);
    const int G = gridDim.x, bx = blockIdx.x; const int vcu = (G % 8 == 0) ? (bx % 8) * (G / 8) + bx / 8 : bx;
    moe_table(a, l, T);
    pg8::MoeSched<false> S{(const char*)(ws + WS_H), (const char*)(ws + WS_WD + (size_t)l * NE * DM * FF * 2), nullptr, T.tpre, T.dcnt, FF, 8, T.tpre[NE], G, vcu, (size_t)DM * FF * 2};
    EpiDown E{(bf16_t*)(ws + WS_Y), T.tpre};
    pg8::gemm_phase(lds, FF, S, E);
    skinny_down(a, l, T);
    if (REPEAT_PH == 81) { skinny_down(a, l, T); skinny_down(a, l, T); }
}
PHASE_FN ph_deferred(ArgsP ap, LAS unsigned char* lds, int which) {
    asm volatile("" : "+s"(ap)); const Args a = ld_args(ap);
    const MoeTab T = moe_tab_ptrs(lds);
    const int G = gridDim.x, bx = blockIdx.x; const int vcu = (G % 8 == 0) ? (bx % 8) * (G / 8) + bx / 8 : bx;
    const int nunits = T.tpre[NE] * (which ? 8 : 4), e = nunits % G;
    const int DLO = which ? DEF2_LO : DEF_LO, DN = which ? DEF2_N : DEF_N;
    const int ns = (e == 0) ? G : G - e; int p1 = ns * DEF_QUOTA; p1 = p1 < DN ? p1 : DN;
    if (e == 0) cvt_deferred(a, lds, vcu, G, DLO, p1);
    else if (vcu >= e) cvt_deferred(a, lds, vcu - e, ns, DLO, p1);
    if (p1 < DN) cvt_deferred(a, lds, vcu, G, DLO + p1, DN - p1);
}
PHASE_FN ph_combine(ArgsP ap, LAS unsigned char* lds, int l) {
    asm volatile("" : "+s"(ap)); const Args a = ld_args(ap);
    const MoeTab T = moe_tab_ptrs(lds);
    moe_table(a, l, T);
    p9_combine(a, l, T);
}

__global__ void __launch_bounds__(NTHR, 2) mk_fwd(Args a_unused) {
    extern __shared__ __attribute__((aligned(16))) unsigned char lds_raw[];
    LAS unsigned char* lds = (LAS unsigned char*)lds_raw;
    volatile LAS unsigned* lctl = (volatile LAS unsigned*)(lds + LDS_CTL);
    ArgsP ap = (ArgsP)__builtin_amdgcn_kernarg_segment_ptr();
    const int tid = ltid();
    if (tid < 128) lctl[tid] = 0u;
    __syncthreads();
    unsigned* ctl = (unsigned*)(ap->ws + WS_CTL);
    const int lo = ap->ph_lo, hi = ap->ph_hi;
    XcdBarrier bar; bar.bar = ctl + CW_BAR; bar.x = 0; bar.st = lctl;
    if (hi - lo > 1) bar = xcd_barrier_post(ctl + CW_BAR, lctl);
#define IN(k) (lo <= (k) && (k) < hi)
#define SEAM(k) do { if (IN(k) && IN((k) + 1)) xcd_barrier(bar); } while (0)
#ifndef REPEAT_PH
#define REPEAT_PH -1
#endif
#ifndef REPEAT_N
#define REPEAT_N 2
#endif
#define NREP(k) ((REPEAT_PH == (k)) ? REPEAT_N : 1)
#define RSEAM(k, r, n) do { if ((r) + 1 < (n)) xcd_barrier(bar); else SEAM(k); } while (0)
    if (IN(0)) { for (int r = 0; r < NREP(0); ++r) { ph_prologue(ap, lds); RSEAM(0, r, NREP(0)); } }
    for (int l = 0; l < NL; ++l) {
        const int pb = 1 + 9 * l;
        if (IN(pb + 0)) { for (int r = 0; r < NREP(1); ++r) { ph_inproj(ap, lds, l); RSEAM(pb + 0, r, NREP(1)); } }
        if (IN(pb + 1)) { for (int r = 0; r < NREP(2); ++r) { ph_prep(ap, lds, l); RSEAM(pb + 1, r, NREP(2)); } }
        if (IN(pb + 2)) { for (int r = 0; r < NREP(3); ++r) { ph_idx(ap, lds, l, r); ph_attnA(ap, lds, l, r); RSEAM(pb + 2, r, NREP(3)); }
            if (REPEAT_PH == 31) { xcd_barrier(bar); ph_idx(ap, lds, l, 1); }
            if (REPEAT_PH == 32) { xcd_barrier(bar); ph_attnA(ap, lds, l, 1); } }
        if (IN(pb + 3)) { for (int r = 0; r < NREP(4); ++r) { ph_attnB<0>(ap, lds, l, r); ph_attnC(ap, lds, l, r); RSEAM(pb + 3, r, NREP(4)); }
            if (REPEAT_PH == 41) { xcd_barrier(bar); ph_attnB<DBG_VAR>(ap, lds, l, 1); xcd_barrier(bar); }
            if (REPEAT_PH == 42) { xcd_barrier(bar); ph_attnC(ap, lds, l, 1); } }
        if (IN(pb + 4)) { for (int r = 0; r < NREP(5); ++r) { ph_outproj(ap, lds, l); RSEAM(pb + 4, r, NREP(5)); } }
        if (IN(pb + 5)) { ph_router(ap, lds, l); SEAM(pb + 5); }
        if (IN(pb + 6)) { for (int r = 0; r < NREP(7); ++r) { ph_moe_up(ap, lds, l); if (l == 0 && r == 0) ph_deferred(ap, lds, 0); RSEAM(pb + 6, r, NREP(7)); } }
        if (IN(pb + 7)) { for (int r = 0; r < NREP(8); ++r) { ph_moe_down(ap, lds, l); RSEAM(pb + 7, r, NREP(8)); } }
        if (IN(pb + 8)) { for (int r = 0; r < NREP(9); ++r) { ph_combine(ap, lds, l); RSEAM(pb + 8, r, NREP(9)); } }
    }
#undef IN
#undef SEAM
}

extern "C" void kernel_launch(void* const* d_in, const int* in_sizes, int n_in, void* d_out, int out_size, void* d_ws, size_t ws_size, hipStream_t stream) {
    static int grid = 0;
    if (grid == 0) {
        if (n_in != 21 || out_size != NT * DM || ws_size < WS_END) { fprintf(stderr, "kernel_launch: unexpected problem (n_in %d, out %d, ws %zu < %zu)\n", n_in, out_size, ws_size, (size_t)WS_END); grid = -1; return; }
        int dev = 0, cus = 0, per_cu = 0;
        if (hipGetDevice(&dev) != hipSuccess || hipDeviceGetAttribute(&cus, hipDeviceAttributeMultiprocessorCount, dev) != hipSuccess) { grid = -1; return; }
        if (hipFuncSetAttribute((const void*)mk_fwd, hipFuncAttributeMaxDynamicSharedMemorySize, LDS_BYTES) != hipSuccess) { fprintf(stderr, "kernel_launch: hipFuncSetAttribute failed\n"); grid = -1; return; }
        if (hipOccupancyMaxActiveBlocksPerMultiprocessor(&per_cu, (const void*)mk_fwd, NTHR, LDS_BYTES) != hipSuccess || per_cu < 1) { fprintf(stderr, "kernel_launch: occupancy query says %d\n", per_cu); }
        (void)hipGetLastError();
        grid = cus;
    }
    if (grid < 0) return;
    (void)hipMemsetAsync((char*)d_ws + WS_CTL, 0, CTL_BYTES, stream);
    Args a{};
    for (int i = 0; i < 21; ++i) a.in[i] = (const float*)d_in[i];
    a.out = (float*)d_out; a.ws = (unsigned char*)d_ws;
#if MK_ONE_LAUNCH
    a.ph_lo = 0; a.ph_hi = N_PHASES;
    hipLaunchKernelGGL(mk_fwd, dim3(grid), dim3(NTHR), LDS_BYTES, stream, a);
#else
    for (int p = 0; p < N_PHASES; ++p) { a.ph_lo = p; a.ph_hi = p + 1; hipLaunchKernelGGL(mk_fwd, dim3(grid), dim3(NTHR), LDS_BYTES, stream, a); }
#endif
}
```

```cpp
#include <hip/hip_runtime.h>
#include <cstdio>
#include <cstdint>

#ifndef DBG_VAR
#define DBG_VAR 0
#endif
#ifndef REPEAT_PH
#define REPEAT_PH -1
#endif
#ifndef MK_ONE_LAUNCH
#define MK_ONE_LAUNCH 1
#endif

#define LAS __attribute__((address_space(3)))
typedef unsigned short bf16_t;
typedef short bf16x8 __attribute__((ext_vector_type(8)));
typedef float f32x4 __attribute__((ext_vector_type(4)));
typedef float f32x16 __attribute__((ext_vector_type(16)));
typedef unsigned u32x4 __attribute__((ext_vector_type(4)));
typedef unsigned u32x2 __attribute__((ext_vector_type(2)));

constexpr int NB = 4, SEQ = 2048, DM = 2048, NT = NB * SEQ, NL = 2;
constexpr int IN_DIM = 6224, NPAD = 6400;
constexpr int OQA = 0, OKA = 768, OVA = 1536, OQB = 2304, OKB = 2944, OVB = 3584, OQC = 4224, OKC = 4864, OVC = 4992, OQI = 5120, OKI = 6144, OWI = 6208;
constexpr int NE = 32, FF = 512;
constexpr int HROWS = 24576;
constexpr float EPS = 1e-6f;
constexpr float LOG2E = 1.4426950408889634f;
constexpr int NTHR = 512;

constexpr size_t WS_CTL = 0;
constexpr size_t CTL_BYTES = 65536;
constexpr size_t WS_WIN = WS_CTL + CTL_BYTES;
constexpr size_t WS_WOUT = WS_WIN + (size_t)NL * NPAD * DM * 2;
constexpr size_t WS_W1 = WS_WOUT + (size_t)NL * DM * DM * 2;
constexpr size_t WS_WD = WS_W1 + (size_t)NL * NE * 1024 * DM * 2;
constexpr size_t WS_WR = WS_WD + (size_t)NL * NE * DM * FF * 2;
constexpr size_t WS_XB = WS_WR + (size_t)NL * 64 * DM * 4;
constexpr size_t WS_RSTD1 = WS_XB + (size_t)NT * DM * 2;
constexpr size_t WS_PROJ = WS_RSTD1 + (size_t)NT * 4;
constexpr size_t WS_Y = WS_PROJ;
constexpr size_t WS_QA = WS_PROJ + (size_t)NT * NPAD * 2;
constexpr size_t WS_KA = WS_QA + (size_t)NT * 768 * 2;
constexpr size_t WS_VAT = WS_KA + (size_t)NT * 768 * 2;
constexpr size_t WS_QB = WS_VAT + (size_t)NT * 768 * 2;
constexpr size_t WS_KB = WS_QB + (size_t)NT * 640 * 2;
constexpr size_t WS_VBT = WS_KB + (size_t)NT * 640 * 2;
constexpr size_t WS_KMEAN = WS_VBT + (size_t)NT * 640 * 2;
constexpr size_t WS_QC = WS_KMEAN + (size_t)NB * 5 * 8 * 128 * 4;
constexpr size_t WS_KC = WS_QC + (size_t)NT * 640 * 2;
constexpr size_t WS_VCT = WS_KC + (size_t)NT * 128 * 2;
constexpr size_t WS_QI = WS_VCT + (size_t)NT * 128 * 2;
constexpr size_t WS_KI = WS_QI + (size_t)NT * 1024 * 2;
constexpr size_t WS_WI = WS_KI + (size_t)NT * 64 * 2;
constexpr size_t WS_MASK = WS_WI + (size_t)NT * 16 * 4;
constexpr size_t WS_MIXO = WS_MASK + (size_t)NT * 64 * 4;
constexpr size_t WS_XM = WS_MIXO + (size_t)NT * DM * 2;
constexpr size_t WS_XMB = WS_XM + (size_t)NT * DM * 4;
constexpr size_t WS_TOKE = WS_XMB + (size_t)NT * DM * 2;
constexpr size_t WS_TOKP = WS_TOKE + (size_t)NT * 2 * 4;
constexpr size_t WS_RSTD2 = WS_TOKP + (size_t)NT * 2 * 4;
constexpr size_t WS_LIST = WS_RSTD2 + (size_t)NT * 4;
constexpr size_t WS_LISTG = WS_LIST + (size_t)NE * NT * 4;
constexpr size_t WS_H = WS_LISTG + (size_t)NE * NT * 4;
constexpr size_t WS_X1 = WS_H + (size_t)HROWS * FF * 2;
constexpr size_t WS_END = WS_X1 + (size_t)NT * DM * 4;
static_assert((size_t)HROWS * DM * 2 <= (size_t)NT * NPAD * 2, "Y must fit in PROJ");

constexpr int CW_BAR = 0;
constexpr int CW_CNT = 4096;
constexpr int CW_Q = 4096 + 64;

constexpr int LDS_STAGE = 131072;
constexpr int LDS_CTL = LDS_STAGE;
constexpr int LDS_BYTES = 147456;

__device__ __forceinline__ float bf2f(bf16_t b) { return __uint_as_float(((unsigned)b) << 16); }
__device__ __forceinline__ float bflo(unsigned w) { return __uint_as_float(w << 16); }
__device__ __forceinline__ float bfhi(unsigned w) { return __uint_as_float(w & 0xffff0000u); }
typedef __bf16 bf16x2_t __attribute__((ext_vector_type(2)));
__device__ __forceinline__ unsigned cvt_pk(float lo, float hi) { bf16x2_t v = {(__bf16)lo, (__bf16)hi}; return __builtin_bit_cast(unsigned, v); }
__device__ __forceinline__ float pairmax(float x) { auto r = __builtin_amdgcn_permlane32_swap(__float_as_uint(x), __float_as_uint(x), false, false); return fmaxf(__uint_as_float(r[0]), __uint_as_float(r[1])); }
__device__ __forceinline__ float pairsum(float x) { auto r = __builtin_amdgcn_permlane32_swap(__float_as_uint(x), __float_as_uint(x), false, false); return __uint_as_float(r[0]) + __uint_as_float(r[1]); }
__device__ __forceinline__ float wave_sum(float x) {
#pragma unroll
    for (int o = 32; o > 0; o >>= 1) x += __shfl_xor(x, o, 64);
    return x;
}
__device__ __forceinline__ int ltid() { int t = (int)threadIdx.x; asm volatile("" : "+v"(t)); return t; }
__device__ __forceinline__ int half_sum_i32(int v) {
    v += __builtin_amdgcn_update_dpp(0, v, 0xB1, 0xF, 0xF, true);
    v += __builtin_amdgcn_update_dpp(0, v, 0x4E, 0xF, 0xF, true);
    v += __builtin_amdgcn_update_dpp(0, v, 0x141, 0xF, 0xF, true);
    v += __builtin_amdgcn_update_dpp(0, v, 0x140, 0xF, 0xF, true);
    v += __shfl_xor(v, 16, 64);
    return v;
}
__device__ __forceinline__ unsigned ld_agent(const unsigned* p) { return __hip_atomic_load(p, __ATOMIC_RELAXED, __HIP_MEMORY_SCOPE_AGENT); }

#define XB_TMO      128
#define XB_XCNT(j)  (256  + 64 * (j))
#define XB_XSUB(j)  (1280 + 64 * (j))
#define XB_XGEN(j)  (2304 + 64 * (j))
#define XB_TOP      3328
#define XB_TOPGEN   3392
#define XCD_BAR_WORDS 3456
#define XB_SPIN_CAP (1u << 22)

__device__ __forceinline__ unsigned xb_ld(unsigned* p)              { return __hip_atomic_load(p, __ATOMIC_RELAXED, __HIP_MEMORY_SCOPE_AGENT); }
__device__ __forceinline__ unsigned xb_add(unsigned* p, unsigned v) { return __hip_atomic_fetch_add(p, v, __ATOMIC_RELAXED, __HIP_MEMORY_SCOPE_AGENT); }
__device__ __forceinline__ unsigned xb_xcc_id() { return (unsigned)__builtin_amdgcn_s_getreg((3 << 11) | 20) & 0xFu; }
#define XB_SPIN(cond, bar) do { unsigned _sp = 0; while (cond) { __builtin_amdgcn_s_sleep(1); \
    if ((++_sp & 255u) == 0u) { if (xb_ld(&(bar)[XB_TMO])) break; if (_sp > XB_SPIN_CAP) { atomicAdd(&(bar)[XB_TMO], 1u); break; } } } } while (0)

struct XcdBarrier { unsigned* bar; unsigned x; volatile LAS unsigned* st; };

__device__ __forceinline__ XcdBarrier xcd_barrier_post(unsigned* bar, volatile LAS unsigned* st) {
    XcdBarrier b; b.bar = bar; b.x = xb_xcc_id(); b.st = st;
    if (threadIdx.x == 0) (void)xb_add(&bar[XB_XCNT(b.x)], 1u);
    return b;
}
__device__ __forceinline__ void xcd_barrier_complete(unsigned* bar, unsigned x, unsigned& nloc, unsigned& nx) {
    const unsigned G = gridDim.x * gridDim.y * gridDim.z;
    unsigned sum, cnt, mine, sp = 0u;
    for (;;) {
        sum = 0u; cnt = 0u; mine = 0u;
#pragma unroll
        for (unsigned j = 0; j < 16; ++j) { const unsigned c = xb_ld(&bar[XB_XCNT(j)]); sum += c; cnt += (c > 0u) ? 1u : 0u; mine = (j == x) ? c : mine; }
        if (sum == G) break;
        __builtin_amdgcn_s_sleep(1);
        if ((++sp & 255u) == 0u) { if (xb_ld(&bar[XB_TMO])) break; if (sp > XB_SPIN_CAP) { atomicAdd(&bar[XB_TMO], 1u); break; } }
    }
    nloc = mine > 0u ? mine : 1u; nx = cnt > 0u ? cnt : 1u;
}
__device__ __forceinline__ void xcd_barrier(const XcdBarrier& b) {
    asm volatile("s_waitcnt vmcnt(0)" ::: "memory");
    __syncthreads();
    if (threadIdx.x == 0) {
        unsigned* bar = b.bar;
        __builtin_amdgcn_s_waitcnt(0);
        unsigned nloc = b.st[0], nx = b.st[1];
        if (nloc == 0u) { xcd_barrier_complete(bar, b.x, nloc, nx); b.st[0] = nloc; b.st[1] = nx; }
        const unsigned old = xb_add(&bar[XB_XSUB(b.x)], 1u);
        const unsigned gen = old / nloc;
        if (old + 1u == (gen + 1u) * nloc) {
            __builtin_amdgcn_fence(__ATOMIC_RELEASE, "agent");
            asm volatile("s_waitcnt vmcnt(0)" ::: "memory");
            const unsigned og = xb_add(&bar[XB_TOP], 1u);
            const unsigned tg = og / nx;
            if (og + 1u == (tg + 1u) * nx) xb_add(&bar[XB_TOPGEN], 1u);
            else XB_SPIN(xb_ld(&bar[XB_TOPGEN]) == tg, bar);
            __builtin_amdgcn_fence(__ATOMIC_ACQUIRE, "agent");
            xb_add(&bar[XB_XGEN(b.x)], 1u);
            asm volatile("s_waitcnt vmcnt(0)" ::: "memory");
        } else {
            XB_SPIN(xb_ld(&bar[XB_XGEN(b.x)]) == gen, bar);
            __builtin_amdgcn_fence(__ATOMIC_ACQUIRE, "agent");
            asm volatile("s_waitcnt vmcnt(0)" ::: "memory");
        }
    }
    __syncthreads();
}

struct Args { const float* in[21]; float* out; unsigned char* ws; int ph_lo, ph_hi; };
enum { I_X = 0, I_N1G, I_WIN, I_AQN, I_AKN, I_ALAM, I_ASUB, I_BQN, I_BKN, I_CQN, I_CKN, I_IKN, I_WOUT, I_N2G, I_WGRP, I_BGRP, I_WEXP, I_BEXP, I_WGATE, I_WUP, I_WDOWN };

__device__ __forceinline__ int next_unit(unsigned* ctr, volatile LAS int* slot) {
    __syncthreads();
    if (threadIdx.x == 0) *slot = (int)atomicAdd(ctr, 1u);
    __syncthreads();
    return *slot;
}

namespace pg8 {
constexpr int BM = 256, BK = 64, HALF = 128, HTB = HALF * BK * 2, STAGE_BYTES = 8 * HTB;
__device__ __forceinline__ int lds_byte(int r, int c) { const int st = (r >> 4) * 2 + (c >> 5), rr = r & 15, cc = c & 31, ob = rr * 64 + cc * 2; return st * 1024 + (ob ^ (((ob >> 9) & 1) << 5)); }
__device__ __forceinline__ void stage_rc(int b, int& R, int& C) { const int st = b / 1024, sb = b % 1024, swz = sb ^ (((sb >> 9) & 1) << 5); R = (st >> 1) * 16 + swz / 64; C = (st & 1) * 32 + (swz % 64) / 2; }

__device__ __forceinline__ int perm32(int rho) { const int n = rho >> 4, i = rho & 15; return 8 * (i >> 2) + 4 * n + (i & 3); }
struct Unit { const char* a; const char* b; int m0, n0, e, cnt; };

template <class Epi, class Sched>
__device__ __forceinline__ void gemm_phase(LAS unsigned char* lds, const int K, const Sched& S, const Epi& E) {
    const int tid = ltid(), wid = __builtin_amdgcn_readfirstlane(tid >> 6), lane = tid & 63, wr = wid >> 2, wc = wid & 3, fr = lane & 15, fq = lane >> 4;
    const int nt = K / BK;
    int Rst[2], Cst[2]; unsigned voffB[2];
#pragma unroll
    for (int i = 0; i < 2; ++i) { int R, C; stage_rc(tid * 16 + i * 8192, R, C); Rst[i] = R; Cst[i] = C; const int Rb = Epi::PERM ? ((R & ~31) + perm32(R & 31)) : R; voffB[i] = (unsigned)(Rb * K + C) * 2u; }
    const size_t kstep = (size_t)(BK * 2);
    const size_t hstep = (size_t)HALF * K * 2;
    const unsigned ldsw = (unsigned)wid * 1024u;
    const int aoff = lds_byte(wr * 64 + fr, fq * 8), boff = lds_byte(wc * 32 + fr, fq * 8);
#define PG8_SA(b, h) (((b) * 2 + (h)) * HTB)
#define PG8_SB(b, h) ((4 + (b) * 2 + (h)) * HTB)
#define PG8_STAGE2(bufoff, gbase, o0, o1) do { \
        __builtin_amdgcn_global_load_lds((const unsigned*)((const char*)(gbase) + (o0)), (LAS unsigned*)(lds + (bufoff) + ldsw), 16, 0, 0); \
        __builtin_amdgcn_global_load_lds((const unsigned*)((const char*)(gbase) + (o1)), (LAS unsigned*)(lds + (bufoff) + ldsw + 8192), 16, 0, 0); } while (0)
#define PG8_STAGEB(bufoff, gbase) PG8_STAGE2(bufoff, gbase, voffB[0], voffB[1])
#define PG8_LDA(dst, b, h) do { _Pragma("unroll") for (int m = 0; m < 4; ++m) _Pragma("unroll") for (int k = 0; k < 2; ++k) dst[m][k] = *(const LAS bf16x8*)(lds + PG8_SA(b, h) + aoff + m * 2048 + k * 1024); } while (0)
#define PG8_LDB(dst, b, h) do { _Pragma("unroll") for (int n = 0; n < 2; ++n) _Pragma("unroll") for (int k = 0; k < 2; ++k) dst[n][k] = *(const LAS bf16x8*)(lds + PG8_SB(b, h) + boff + n * 2048 + k * 1024); } while (0)
#define PG8_MMA(ai, bj, At, Bt) do { __builtin_amdgcn_s_setprio(1); _Pragma("unroll") for (int m = 0; m < 4; ++m) _Pragma("unroll") for (int n = 0; n < 2; ++n) _Pragma("unroll") for (int k = 0; k < 2; ++k) \
        acc[ai][bj][m][n] = __builtin_amdgcn_mfma_f32_16x16x32_bf16(Bt[n][k], At[m][k], acc[ai][bj][m][n], 0, 0, 0); __builtin_amdgcn_s_setprio(0); } while (0)
#define PG8_WAIT_V(n) asm volatile("s_waitcnt vmcnt(" #n ")" ::: "memory")
#define PG8_WAIT_L(n) asm volatile("s_waitcnt lgkmcnt(" #n ")" ::: "memory")
#define PG8_BAR __builtin_amdgcn_s_barrier()
#define PG8_SCHED __builtin_amdgcn_sched_barrier(0)
    Unit cur, nxt; int ui = 0;
    if (!S.next(0, cur)) return;
    f32x4 acc[2][2][4][2];
#pragma unroll
    for (int a = 0; a < 2; ++a)
#pragma unroll
        for (int b = 0; b < 2; ++b)
#pragma unroll
            for (int m = 0; m < 4; ++m)
#pragma unroll
                for (int n = 0; n < 2; ++n) acc[a][b][m][n] = (f32x4){0.f, 0.f, 0.f, 0.f};
    bf16x8 At[4][2], B0[2][2], B1[2][2];
    unsigned c00, c01, c10, c11, n00, n01, n10, n11;
    c00 = S.arow(cur, Rst[0]) + Cst[0] * 2; c01 = S.arow(cur, Rst[1]) + Cst[1] * 2; c10 = S.arow(cur, 128 + Rst[0]) + Cst[0] * 2; c11 = S.arow(cur, 128 + Rst[1]) + Cst[1] * 2;
    const char* cA = cur.a; const char* cB = cur.b;
    PG8_STAGEB(PG8_SB(0, 0), cB); PG8_STAGE2(PG8_SA(0, 0), cA, c00, c01); PG8_STAGEB(PG8_SB(0, 1), cB + hstep); PG8_STAGE2(PG8_SA(0, 1), cA, c10, c11);
    if (wr == 1) PG8_BAR;
    PG8_WAIT_V(4); PG8_BAR;
    PG8_STAGEB(PG8_SB(1, 0), cB + kstep); PG8_STAGE2(PG8_SA(1, 0), cA + kstep, c00, c01); PG8_STAGEB(PG8_SB(1, 1), cB + hstep + kstep);
    PG8_WAIT_V(6); PG8_BAR;
    for (;;) {
        const bool has_next = S.next(ui + 1, nxt);
        const char* nA = cA; const char* nB = cB; n00 = c00; n01 = c01; n10 = c10; n11 = c11;
        if (has_next) { nA = nxt.a; nB = nxt.b;
            n00 = S.arow(nxt, Rst[0]) + Cst[0] * 2; n01 = S.arow(nxt, Rst[1]) + Cst[1] * 2; n10 = S.arow(nxt, 128 + Rst[0]) + Cst[0] * 2; n11 = S.arow(nxt, 128 + Rst[1]) + Cst[1] * 2; }
        for (int t = 0; t < nt; t += 2) {
            const bool last = (t == nt - 2);
            const char* a1 = cA + (size_t)(t + 1) * kstep;
            const char* a2 = last ? nA : cA + (size_t)(t + 2) * kstep; const char* b2 = last ? nB : cB + (size_t)(t + 2) * kstep;
            const char* a3 = a2 + kstep; const char* b3 = b2 + kstep;
            const unsigned o00 = last ? n00 : c00, o01 = last ? n01 : c01, o10 = last ? n10 : c10, o11 = last ? n11 : c11;
            PG8_LDB(B0, 0, 0); PG8_SCHED; PG8_LDA(At, 0, 0); PG8_STAGE2(PG8_SA(1, 1), a1, c10, c11);
            PG8_WAIT_L(8); PG8_BAR; PG8_WAIT_L(0); PG8_MMA(0, 0, At, B0); PG8_BAR; PG8_SCHED;
            PG8_LDB(B1, 0, 1); PG8_STAGEB(PG8_SB(0, 0), b2);
            PG8_BAR; PG8_WAIT_L(0); PG8_MMA(0, 1, At, B1); PG8_BAR;
            PG8_LDA(At, 0, 1); PG8_STAGE2(PG8_SA(0, 0), a2, o00, o01);
            PG8_BAR; PG8_WAIT_L(0); PG8_MMA(1, 0, At, B0); PG8_BAR; PG8_SCHED;
            PG8_STAGEB(PG8_SB(0, 1), b2 + hstep);
            PG8_WAIT_V(6); PG8_BAR; PG8_MMA(1, 1, At, B1); PG8_BAR;
            PG8_LDB(B0, 1, 0); PG8_SCHED; PG8_LDA(At, 1, 0); PG8_STAGE2(PG8_SA(0, 1), a2, o10, o11);
            PG8_WAIT_L(8); PG8_BAR; PG8_WAIT_L(0); PG8_MMA(0, 0, At, B0); PG8_BAR; PG8_SCHED;
            PG8_LDB(B1, 1, 1); PG8_STAGEB(PG8_SB(1, 0), b3);
            PG8_BAR; PG8_WAIT_L(0); PG8_MMA(0, 1, At, B1); PG8_BAR;
            PG8_LDA(At, 1, 1); PG8_STAGE2(PG8_SA(1, 0), a3, o00, o01);
            PG8_BAR; PG8_WAIT_L(0); PG8_MMA(1, 0, At, B0); PG8_BAR; PG8_SCHED;
            PG8_STAGEB(PG8_SB(1, 1), b3 + hstep);
            PG8_WAIT_V(6); PG8_BAR; PG8_MMA(1, 1, At, B1); PG8_BAR;
        }
        E(acc, cur, wr, wc, fr, fq);
        if (!has_next) break;
#pragma unroll
        for (int a = 0; a < 2; ++a)
#pragma unroll
            for (int b = 0; b < 2; ++b)
#pragma unroll
                for (int m = 0; m < 4; ++m)
#pragma unroll
                    for (int n = 0; n < 2; ++n) acc[a][b][m][n] = (f32x4){0.f, 0.f, 0.f, 0.f};
        cur = nxt; cA = nA; cB = nB; c00 = n00; c01 = n01; c10 = n10; c11 = n11; ++ui;
    }
    PG8_WAIT_V(0);
    if (wr == 0) PG8_BAR;
    PG8_BAR;
#undef PG8_SA
#undef PG8_SB
#undef PG8_STAGE2
#undef PG8_STAGEB
#undef PG8_LDA
#undef PG8_LDB
#undef PG8_MMA
#undef PG8_WAIT_V
#undef PG8_WAIT_L
#undef PG8_BAR
#undef PG8_SCHED
}

struct DenseSched {
    const char* A; const char* Bt; int K, nM, nN, nwg, G, c;
    __device__ __forceinline__ void init(const void* A_, const void* Bt_, int M, int N, int K_, int G_, int c_) { A = (const char*)A_; Bt = (const char*)Bt_; K = K_; nM = M / BM; nN = N / BM; nwg = nM * nN; G = G_; c = c_; }
    __device__ __forceinline__ bool next(int i, Unit& u) const {
        const long L = (long)i * G + c; if (L >= nwg) return false;
        int wgid = (int)L; { const int q = nwg / 8, r = nwg % 8, xcd = wgid % 8, off = wgid / 8; wgid = (xcd < r ? xcd * (q + 1) : r * (q + 1) + (xcd - r) * q) + off; }
        const int nig = 8 * nN, gid = wgid / nig, fm = gid * 8, gsz = (nM - fm) < 8 ? (nM - fm) : 8;
        const int pm = fm + ((wgid % nig) % gsz), pn = (wgid % nig) / gsz;
        u.m0 = pm * BM; u.n0 = pn * BM; u.e = 0; u.cnt = 0;
        u.a = A + (size_t)u.m0 * K * 2; u.b = Bt + (size_t)u.n0 * K * 2; return true;
    }
    __device__ __forceinline__ unsigned arow(const Unit&, int r) const { return (unsigned)(r * K) * 2u; }
};

template <bool GATHER>
struct MoeSched {
    const char* A; const char* Bt; const int* list; volatile LAS int* tpre; volatile LAS int* cnt; int K, NPN, ntiles, G, c; size_t bstride;
    __device__ __forceinline__ bool next(int i, Unit& u) const {
        const long L = (long)i * G + c; if (L >= (long)ntiles * NPN) return false;
        const int mg = (int)(L / NPN), pn = (int)(L % NPN);
        int e = 0;
#pragma unroll 1
        for (int j = 1; j < NE; ++j) e = (tpre[j] <= mg) ? j : e;
        e = __builtin_amdgcn_readfirstlane(e);
        u.e = e; u.m0 = (mg - tpre[e]) * BM; u.cnt = cnt[e]; u.n0 = pn * BM;
        u.b = Bt + (size_t)e * bstride + (size_t)u.n0 * K * 2;
        if (GATHER) u.a = A; else u.a = A + (size_t)mg * BM * K * 2;
        return true;
    }
    __device__ __forceinline__ unsigned arow(const Unit& u, int r) const {
        if (GATHER) { int m = u.m0 + r; m = m < u.cnt ? m : u.m0; const int tok = list[(size_t)u.e * NT + m]; return (unsigned)(tok * K) * 2u; }
        return (unsigned)(r * K) * 2u;
    }
};
}

struct EpiProj {
    static constexpr bool PERM = true;
    bf16_t* out; const float* rstd;
    __device__ __forceinline__ void operator()(const f32x4 (&acc)[2][2][4][2], const pg8::Unit& u, int wr, int wc, int fr, int fq) const {
        float rs[2][4];
#pragma unroll
        for (int ai = 0; ai < 2; ++ai)
#pragma unroll
            for (int m = 0; m < 4; ++m) rs[ai][m] = rstd[u.m0 + 128 * ai + 64 * wr + 16 * m + fr];
        __builtin_amdgcn_sched_barrier(0);
#pragma unroll
        for (int ai = 0; ai < 2; ++ai)
#pragma unroll
            for (int m = 0; m < 4; ++m) {
                const int row = u.m0 + 128 * ai + 64 * wr + 16 * m + fr;
                bf16_t* rp = out + (size_t)row * NPAD + u.n0 + 32 * wc + 8 * fq;
#pragma unroll
                for (int bj = 0; bj < 2; ++bj) { const f32x4 v0 = acc[ai][bj][m][0] * rs[ai][m], v1 = acc[ai][bj][m][1] * rs[ai][m];
                    u32x4 w = {cvt_pk(v0[0], v0[1]), cvt_pk(v0[2], v0[3]), cvt_pk(v1[0], v1[1]), cvt_pk(v1[2], v1[3])}; *(u32x4*)(rp + 128 * bj) = w; }
            }
    }
};
struct EpiOut {
    static constexpr bool PERM = true;
    const float* xin; float* xm; bf16_t* xmb;
    __device__ __forceinline__ void operator()(const f32x4 (&acc)[2][2][4][2], const pg8::Unit& u, int wr, int wc, int fr, int fq) const {
#pragma unroll
        for (int ai = 0; ai < 2; ++ai) {
            f32x4 xv[4][2][2];
#pragma unroll
            for (int m = 0; m < 4; ++m) { const int row = u.m0 + 128 * ai + 64 * wr + 16 * m + fr; const size_t o = (size_t)row * DM + u.n0 + 32 * wc + 8 * fq;
#pragma unroll
                for (int bj = 0; bj < 2; ++bj)
#pragma unroll
                    for (int n = 0; n < 2; ++n) xv[m][bj][n] = *(const f32x4*)(xin + o + 128 * bj + 4 * n); }
            __builtin_amdgcn_sched_barrier(0);
#pragma unroll
            for (int m = 0; m < 4; ++m) { const int row = u.m0 + 128 * ai + 64 * wr + 16 * m + fr; const size_t o = (size_t)row * DM + u.n0 + 32 * wc + 8 * fq;
#pragma unroll
                for (int bj = 0; bj < 2; ++bj) { const size_t oo = o + 128 * bj; const f32x4 v0 = acc[ai][bj][m][0] + xv[m][bj][0], v1 = acc[ai][bj][m][1] + xv[m][bj][1];
                    *(f32x4*)(xm + oo) = v0; *(f32x4*)(xm + oo + 4) = v1;
                    u32x4 w = {cvt_pk(v0[0], v0[1]), cvt_pk(v0[2], v0[3]), cvt_pk(v1[0], v1[1]), cvt_pk(v1[2], v1[3])}; *(u32x4*)(xmb + oo) = w; } }
            __builtin_amdgcn_sched_barrier(0);
        }
    }
};
struct EpiUp {
    static constexpr bool PERM = true;
    bf16_t* H; const int* list; const float* listg; const float* rstd2; volatile LAS int* tpre;
    __device__ __forceinline__ void operator()(const f32x4 (&acc)[2][2][4][2], const pg8::Unit& u, int wr, int wc, int fr, int fq) const {
        const int rowbase = tpre[u.e] * 256;
        int tok[2][4]; float gv[2][4], rs[2][4];
#pragma unroll
        for (int ai = 0; ai < 2; ++ai)
#pragma unroll
            for (int m = 0; m < 4; ++m) { int mr = u.m0 + 128 * ai + 64 * wr + 16 * m + fr; mr = mr < u.cnt ? mr : u.m0; tok[ai][m] = list[(size_t)u.e * NT + mr]; gv[ai][m] = listg[(size_t)u.e * NT + mr]; }
        __builtin_amdgcn_sched_barrier(0);
#pragma unroll
        for (int ai = 0; ai < 2; ++ai)
#pragma unroll
            for (int m = 0; m < 4; ++m) rs[ai][m] = rstd2[tok[ai][m]];
        __builtin_amdgcn_sched_barrier(0);
#pragma unroll
        for (int ai = 0; ai < 2; ++ai)
#pragma unroll
            for (int m = 0; m < 4; ++m) {
                const int mr = u.m0 + 128 * ai + 64 * wr + 16 * m + fr;
                if (mr < u.cnt) {
                    bf16_t* rp = H + (size_t)(rowbase + mr) * FF + (u.n0 >> 1) + 32 * wc + 8 * fq;
                    float h[8];
#pragma unroll
                    for (int n = 0; n < 2; ++n) { const f32x4 g = acc[ai][0][m][n] * rs[ai][m], up = acc[ai][1][m][n] * rs[ai][m];
#pragma unroll
                        for (int j = 0; j < 4; ++j) { const float s = g[j] / (1.f + __expf(-g[j])); h[4 * n + j] = s * up[j] * gv[ai][m]; } }
                    u32x4 w = {cvt_pk(h[0], h[1]), cvt_pk(h[2], h[3]), cvt_pk(h[4], h[5]), cvt_pk(h[6], h[7])}; *(u32x4*)rp = w;
                }
            }
    }
};
struct EpiDown {
    static constexpr bool PERM = true;
    bf16_t* Y; volatile LAS int* tpre;
    __device__ __forceinline__ void operator()(const f32x4 (&acc)[2][2][4][2], const pg8::Unit& u, int wr, int wc, int fr, int fq) const {
        const int rowbase = tpre[u.e] * 256;
#pragma unroll
        for (int ai = 0; ai < 2; ++ai)
#pragma unroll
            for (int m = 0; m < 4; ++m) {
                const int mr = u.m0 + 128 * ai + 64 * wr + 16 * m + fr;
                if (mr < u.cnt) {
                    bf16_t* rp = Y + (size_t)(rowbase + mr) * DM + u.n0 + 32 * wc + 8 * fq;
#pragma unroll
                    for (int bj = 0; bj < 2; ++bj) { const f32x4 v0 = acc[ai][bj][m][0], v1 = acc[ai][bj][m][1];
                        u32x4 w = {cvt_pk(v0[0], v0[1]), cvt_pk(v0[2], v0[3]), cvt_pk(v1[0], v1[1]), cvt_pk(v1[2], v1[3])}; *(u32x4*)(rp + 128 * bj) = w; }
                }
            }
    }
};

struct CvtJob { const float* src; const float* gain; bf16_t* dst; int ld, nvalid, k0, n0; size_t dst_ld, dst_row0; };
__device__ __forceinline__ void cvt_decode(const Args& a, int job, CvtJob& J) {
    unsigned char* ws = a.ws;
    constexpr int J_W1 = NL * NE * 2 * 16 * 8, J_WD = NL * NE * 4 * 32, J_WIN = NL * 16 * 100;
    int j = job;
    if (j < J_W1) {
        const int nt = j & 7; j >>= 3; const int kt = j & 15; j >>= 4; const int which = j & 1; j >>= 1; const int e = j & 31; const int l = j >> 5;
        const int f0 = nt * 64;
        J.src = (which ? a.in[I_WUP] : a.in[I_WGATE]) + ((size_t)(l * NE + e)) * DM * FF; J.gain = a.in[I_N2G] + l * DM;
        J.dst = (bf16_t*)(ws + WS_W1) + ((size_t)(l * NE + e)) * 1024 * DM; J.ld = FF; J.nvalid = FF; J.k0 = kt * 128; J.n0 = f0; J.dst_ld = DM;
        J.dst_row0 = (size_t)((f0 >> 7) * 256 + which * 128 + (f0 & 127));
    } else if ((j -= J_W1) < J_WD) {
        const int nt = j & 31; j >>= 5; const int kt = j & 3; j >>= 2; const int e = j & 31; const int l = j >> 5;
        J.src = a.in[I_WDOWN] + ((size_t)(l * NE + e)) * FF * DM; J.gain = nullptr;
        J.dst = (bf16_t*)(ws + WS_WD) + ((size_t)(l * NE + e)) * DM * FF; J.ld = DM; J.nvalid = DM; J.k0 = kt * 128; J.n0 = nt * 64; J.dst_ld = FF; J.dst_row0 = (size_t)(nt * 64);
    } else if ((j -= J_WD) < J_WIN) {
        const int nt = j % 100; j /= 100; const int kt = j & 15; const int l = j >> 4;
        J.src = a.in[I_WIN] + (size_t)l * DM * IN_DIM; J.gain = a.in[I_N1G] + l * DM;
        J.dst = (bf16_t*)(ws + WS_WIN) + (size_t)l * NPAD * DM; J.ld = IN_DIM; J.nvalid = IN_DIM; J.k0 = kt * 128; J.n0 = nt * 64; J.dst_ld = DM; J.dst_row0 = (size_t)(nt * 64);
    } else {
        j -= J_WIN; const int nt = j & 31; j >>= 5; const int kt = j & 15; const int l = j >> 4;
        J.src = a.in[I_WOUT] + (size_t)l * DM * DM; J.gain = nullptr;
        J.dst = (bf16_t*)(ws + WS_WOUT) + (size_t)l * DM * DM; J.ld = DM; J.nvalid = DM; J.k0 = kt * 128; J.n0 = nt * 64; J.dst_ld = DM; J.dst_row0 = (size_t)(nt * 64);
    }
}
__device__ __forceinline__ void cvt_load(const CvtJob& J, int tid, f32x4 (&v)[4], float (&g)[4]) {
    const int kk = tid >> 4, nn = (tid & 15) * 4;
#pragma unroll
    for (int i = 0; i < 4; ++i) { const int k = J.k0 + kk + 32 * i;
        float z = 0.f; asm volatile("" : "+v"(z));
        v[i] = (f32x4){z, z, z, z};
        if (J.n0 + nn < J.nvalid) v[i] = *(const f32x4*)(J.src + (size_t)k * J.ld + J.n0 + nn);
        g[i] = J.gain ? J.gain[k] : 1.f; }
}
__device__ __forceinline__ void cvt_store(LAS unsigned char* lds, const CvtJob& J, int tid, const f32x4 (&v)[4], const float (&g)[4]) {
    LAS bf16_t* T = (LAS bf16_t*)lds;
    constexpr int P = 130;
    { const int kk = tid >> 4, nn = (tid & 15) * 4;
#pragma unroll
      for (int i = 0; i < 4; ++i) { const int k = kk + 32 * i; const f32x4 x = v[i] * g[i];
          const unsigned w0 = cvt_pk(x[0], x[1]), w1 = cvt_pk(x[2], x[3]);
          T[(nn + 0) * P + k] = (bf16_t)(w0 & 0xffffu); T[(nn + 1) * P + k] = (bf16_t)(w0 >> 16);
          T[(nn + 2) * P + k] = (bf16_t)(w1 & 0xffffu); T[(nn + 3) * P + k] = (bf16_t)(w1 >> 16); } }
    __syncthreads();
    { const int n = tid >> 3, kc = (tid & 7) * 16;
      const LAS unsigned* rp = (const LAS unsigned*)(T + n * P + kc);
      u32x4 a = {rp[0], rp[1], rp[2], rp[3]}, b = {rp[4], rp[5], rp[6], rp[7]};
      bf16_t* dp = J.dst + (J.dst_row0 + n) * J.dst_ld + J.k0 + kc;
      *(u32x4*)dp = a; *(u32x4*)(dp + 8) = b; }
    __syncthreads();
}

constexpr int DEF_LO = NE * 2 * 16 * 8, DEF_N = 6400, DEF_HI = DEF_LO + DEF_N;
constexpr int DEF_QUOTA = 32;
constexpr int DEF2_LO = NL * NE * 2 * 16 * 8 + NE * 4 * 32, DEF2_N = 0, DEF2_HI = DEF2_LO + DEF2_N;
__device__ __forceinline__ void cvt_deferred(const Args& a, LAS unsigned char* lds, int s_rank, int ns, const int DLO, const int DN) {
    const int tid = ltid();
    CvtJob J0, J1; f32x4 v0[4], v1[4]; float g0[4], g1[4];
#pragma unroll
    for (int i = 0; i < 4; ++i) { v0[i] = (f32x4){0.f, 0.f, 0.f, 0.f}; v1[i] = v0[i]; g0[i] = 0.f; g1[i] = 0.f; }
    int job = s_rank;
    if (job < DN) { cvt_decode(a, DLO + job, J0); cvt_load(J0, tid, v0, g0); }
    for (; job < DN; job += 2 * ns) {
        const bool h1 = (job + ns) < DN;
        if (h1) { cvt_decode(a, DLO + job + ns, J1); cvt_load(J1, tid, v1, g1); }
        cvt_store(lds, J0, tid, v0, g0);
        const bool h2 = (job + 2 * ns) < DN;
        if (h2) { cvt_decode(a, DLO + job + 2 * ns, J0); cvt_load(J0, tid, v0, g0); }
        if (h1) cvt_store(lds, J1, tid, v1, g1);
    }
}
__device__ __forceinline__ void p0_prologue(const Args& a, LAS unsigned char* lds) {
    unsigned char* ws = a.ws;
    const int G = gridDim.x, bx = blockIdx.x, tid = ltid();
    constexpr int J_ALL = NL * NE * 2 * 16 * 8 + NL * NE * 4 * 32 + NL * 16 * 100 + NL * 16 * 32;
    constexpr int J_RUN = J_ALL - DEF_N - DEF2_N;
#define PRO_ID(j) ((j) < DEF_LO ? (j) : ((j) + DEF_N < DEF2_LO ? (j) + DEF_N : (j) + DEF_N + DEF2_N))
    {
        CvtJob J0, J1; f32x4 v0[4], v1[4]; float g0[4], g1[4];
        int job = bx;
        if (job < J_RUN) { cvt_decode(a, PRO_ID(job), J0); cvt_load(J0, tid, v0, g0); }
        for (; job < J_RUN; job += 2 * G) {
            const bool h1 = (job + G) < J_RUN;
            if (h1) { cvt_decode(a, PRO_ID(job + G), J1); cvt_load(J1, tid, v1, g1); }
            cvt_store(lds, J0, tid, v0, g0);
            const bool h2 = (job + 2 * G) < J_RUN;
            if (h2) { cvt_decode(a, PRO_ID(job + 2 * G), J0); cvt_load(J0, tid, v0, g0); }
            if (h1) cvt_store(lds, J1, tid, v1, g1);
        }
    }
#undef PRO_ID
    for (int i = bx * NTHR + tid; i < NL * 36 * DM; i += G * NTHR) {
        const int k = i % DM; const int jj = (i / DM) % 36; const int l = i / (DM * 36);
        const float g = a.in[I_N2G][l * DM + k];
        const float w = jj < 4 ? a.in[I_WGRP][((size_t)l * DM + k) * 4 + jj] : a.in[I_WEXP][((size_t)l * DM + k) * 32 + (jj - 4)];
        ((float*)(ws + WS_WR))[((size_t)l * 64 + (jj < 4 ? 32 + jj : jj - 4)) * DM + k] = g * w;
    }
    { const int wave = tid >> 6, lane = tid & 63;
      for (int row = bx * 8 + wave; row < NT; row += G * 8) {
          const float* xp = a.in[I_X] + (size_t)row * DM; bf16_t* bp = (bf16_t*)(ws + WS_XB) + (size_t)row * DM; float ss = 0.f;
          f32x4 xv[8];
#pragma unroll
          for (int i = 0; i < 8; ++i) xv[i] = *(const f32x4*)(xp + i * 256 + lane * 4);
          __builtin_amdgcn_sched_barrier(0);
#pragma unroll
          for (int i = 0; i < 8; ++i) { const f32x4 v = xv[i]; ss += v[0] * v[0] + v[1] * v[1] + v[2] * v[2] + v[3] * v[3];
              u32x2 w = {cvt_pk(v[0], v[1]), cvt_pk(v[2], v[3])}; *(u32x2*)(bp + i * 256 + lane * 4) = w; }
          ss = wave_sum(ss);
          if (lane == 0) ((float*)(ws + WS_RSTD1))[row] = rsqrtf(ss * (1.f / DM) + EPS);
      } }
}

template <int HALFR>
__device__ __forceinline__ void rope_inplace(float* v, int pos) {
#pragma unroll
    for (int i = 0; i < HALFR; ++i) {
        const float inv = exp2f(-(float)(2 * i) / (float)(2 * HALFR) * 18.931568569324174f);
        const float ang = (float)pos * inv;
        float t = ang * 0.15915494309189535f; t -= rintf(t);
        const float s = __builtin_amdgcn_sinf(t), c = __builtin_amdgcn_cosf(t);
        const float x1 = v[i], x2 = v[i + HALFR];
        v[i] = x1 * c - x2 * s; v[i + HALFR] = x2 * c + x1 * s;
    }
}
__device__ __forceinline__ void load64(const bf16_t* p, float* v) {
#pragma unroll
    for (int i = 0; i < 8; ++i) { const u32x4 w = *(const u32x4*)(p + i * 8);
#pragma unroll
        for (int j = 0; j < 4; ++j) { v[i * 8 + 2 * j] = bflo(w[j]); v[i * 8 + 2 * j + 1] = bfhi(w[j]); } }
}
__device__ __forceinline__ void store64(bf16_t* p, const float* v) {
#pragma unroll
    for (int i = 0; i < 8; ++i) { u32x4 w;
#pragma unroll
        for (int j = 0; j < 4; ++j) w[j] = cvt_pk(v[i * 8 + 2 * j], v[i * 8 + 2 * j + 1]);
        *(u32x4*)(p + i * 8) = w; }
}

__device__ __forceinline__ void p2_prep(const Args& a, int l, LAS unsigned char* lds) {
    unsigned char* ws = a.ws;
    const int G = gridDim.x, bx = blockIdx.x, tid = ltid(), wave = tid >> 6, lane = tid & 63;
    const bf16_t* PROJ = (const bf16_t*)(ws + WS_PROJ);
    constexpr int NJOB = 49;
    for (int unit = bx; unit < 32 * NJOB; unit += G) {
        const int rb = unit / NJOB, job = unit % NJOB;
        const int b = rb >> 3, blk = rb & 7, s0 = blk * 256, tok0 = rb * 256;
        const bool is_v = (job >= 12 && job < 18) || (job >= 28 && job < 33) || job == 39;
        if (is_v) {
            int col0; bf16_t* dst;
            if (job < 18) { const int h = job - 12; col0 = OVA + h * 128; dst = (bf16_t*)(ws + WS_VAT) + ((size_t)(b * 6 + h) * 128) * SEQ; }
            else if (job < 33) { const int h = job - 28; col0 = OVB + h * 128; dst = (bf16_t*)(ws + WS_VBT) + ((size_t)(b * 5 + h) * 128) * SEQ; }
            else { col0 = OVC; dst = (bf16_t*)(ws + WS_VCT) + ((size_t)b * 128) * SEQ; }
            { const int c = tid & 15;
#pragma unroll
              for (int i = 0; i < 8; ++i) { const int t = (tid >> 4) + 32 * i;
                  const u32x4 w = *(const u32x4*)(PROJ + (size_t)(tok0 + t) * NPAD + col0 + c * 8);
                  *(LAS u32x4*)(lds + t * 256 + c * 16) = w; } }
            __syncthreads();
            {
              unsigned lo[16], hi[16];
#pragma unroll
              for (int i = 0; i < 16; ++i) {
                  const unsigned w0 = *(const LAS unsigned*)(lds + (wave * 32 + 2 * i) * 256 + lane * 4);
                  const unsigned w1 = *(const LAS unsigned*)(lds + (wave * 32 + 2 * i + 1) * 256 + lane * 4);
                  lo[i] = (w0 & 0xffffu) | (w1 << 16); hi[i] = (w0 >> 16) | (w1 & 0xffff0000u); }
              bf16_t* d0 = dst + (size_t)(2 * lane) * SEQ + s0 + wave * 32; bf16_t* d1 = d0 + SEQ;
#pragma unroll
              for (int i = 0; i < 4; ++i) { u32x4 x = {lo[4 * i], lo[4 * i + 1], lo[4 * i + 2], lo[4 * i + 3]}, y = {hi[4 * i], hi[4 * i + 1], hi[4 * i + 2], hi[4 * i + 3]};
                  *(u32x4*)(d0 + i * 8) = x; *(u32x4*)(d1 + i * 8) = y; } }
            __syncthreads();
        } else {
            const int t = tid >> 1, half = tid & 1, tok = tok0 + t, pos = s0 + t;
            float v[64];
            if (job < 12) {
                const bool isq = job < 6; const int h = isq ? job : job - 6;
                load64(PROJ + (size_t)tok * NPAD + (isq ? OQA : OKA) + h * 128 + half * 64, v);
                float ss = 0.f;
#pragma unroll
                for (int i = 0; i < 64; ++i) ss += v[i] * v[i];
                const float rs = rsqrtf(ss * (1.f / 64.f) + EPS);
                const float* g = a.in[isq ? I_AQN : I_AKN] + l * 64;
#pragma unroll
                for (int i = 0; i < 64; ++i) v[i] = v[i] * rs * g[i];
                rope_inplace<8>(v, pos);
                if (isq) {
#pragma unroll
                    for (int i = 0; i < 64; ++i) v[i] *= 0.125f * LOG2E;
                }
                store64((bf16_t*)(ws + (isq ? WS_QA : WS_KA)) + ((size_t)(b * 6 + h) * SEQ + pos) * 128 + half * 64, v);
            } else if (job < 40) {
                int col0, gi; bf16_t* dst; bool isq = false, iskb = false; int hh = 0;
                if (job < 23) { hh = job - 18; col0 = OQB + hh * 128; gi = I_BQN; dst = (bf16_t*)(ws + WS_QB) + ((size_t)(b * 5 + hh) * SEQ + pos) * 128; isq = true; }
                else if (job < 28) { hh = job - 23; col0 = OKB + hh * 128; gi = I_BKN; dst = (bf16_t*)(ws + WS_KB) + ((size_t)(b * 5 + hh) * SEQ + pos) * 128; iskb = true; }
                else if (job < 38) { hh = job - 33; col0 = OQC + hh * 128; gi = I_CQN; dst = (bf16_t*)(ws + WS_QC) + ((size_t)(b * 5 + hh) * SEQ + pos) * 128; isq = true; }
                else { col0 = OKC; gi = I_CKN; dst = (bf16_t*)(ws + WS_KC) + ((size_t)b * SEQ + pos) * 128; }
                load64(PROJ + (size_t)tok * NPAD + col0 + half * 64, v);
                float ss = 0.f;
#pragma unroll
                for (int i = 0; i < 64; ++i) ss += v[i] * v[i];
                ss += __shfl_xor(ss, 1, 64);
                const float rs = rsqrtf(ss * (1.f / 128.f) + EPS);
                const float* g = a.in[gi] + l * 128 + half * 64;
#pragma unroll
                for (int i = 0; i < 64; ++i) v[i] = v[i] * rs * g[i];
                if (half == 0) rope_inplace<16>(v, pos);
                if (iskb) {
                    LAS float* red = (LAS float*)lds;
#pragma unroll
                    for (int i = 0; i < 64; ++i) { float x = v[i];
                        x += __int_as_float(__builtin_amdgcn_update_dpp(0, __float_as_int(x), 0x4E, 0xF, 0xF, true));
                        x += __int_as_float(__builtin_amdgcn_update_dpp(0, __float_as_int(x), 0x124, 0xF, 0xF, true));
                        x += __int_as_float(__builtin_amdgcn_update_dpp(0, __float_as_int(x), 0x128, 0xF, 0xF, true));
                        if ((lane & 15) < 2) red[(wave * 4 + (lane >> 4)) * 128 + half * 64 + i] = x; }
                    __syncthreads();
                    if (tid < 128) { float s = 0.f;
#pragma unroll
                        for (int w = 0; w < 32; ++w) s += red[w * 128 + tid];
                        ((float*)(ws + WS_KMEAN))[((size_t)(b * 5 + hh) * 8 + blk) * 128 + tid] = s * (1.f / 256.f); }
                    __syncthreads();
                }
                if (isq) {
#pragma unroll
                    for (int i = 0; i < 64; ++i) v[i] *= 0.08838834764831845f * LOG2E;
                }
                store64(dst + half * 64, v);
            } else if (job < 48) {
                const int h = (job - 40) * 2 + half;
                load64(PROJ + (size_t)tok * NPAD + OQI + h * 64, v);
                rope_inplace<8>(v, pos);
                store64((bf16_t*)(ws + WS_QI) + (size_t)tok * 1024 + h * 64, v);
            } else {
                if (half == 0) {
                    load64(PROJ + (size_t)tok * NPAD + OKI, v);
                    float ss = 0.f;
#pragma unroll
                    for (int i = 0; i < 64; ++i) ss += v[i] * v[i];
                    const float rs = rsqrtf(ss * (1.f / 64.f) + EPS);
                    const float* g = a.in[I_IKN] + l * 64;
#pragma unroll
                    for (int i = 0; i < 64; ++i) v[i] = v[i] * rs * g[i];
                    rope_inplace<8>(v, pos);
                    store64((bf16_t*)(ws + WS_KI) + (size_t)tok * 64, v);
                } else {
                    const bf16_t* p = PROJ + (size_t)tok * NPAD + OWI; float* wo = (float*)(ws + WS_WI) + (size_t)tok * 16;
                    const u32x4 w0 = *(const u32x4*)p, w1 = *(const u32x4*)(p + 8);
#pragma unroll
                    for (int j = 0; j < 4; ++j) { wo[2 * j] = bflo(w0[j]) * 0.03125f; wo[2 * j + 1] = bfhi(w0[j]) * 0.03125f; wo[8 + 2 * j] = bflo(w1[j]) * 0.03125f; wo[8 + 2 * j + 1] = bfhi(w1[j]) * 0.03125f; }
                }
            }
        }
    }
}

__device__ __forceinline__ unsigned f2key(float f) { const unsigned u = __float_as_uint(f); return (u & 0x80000000u) ? ~u : (u | 0x80000000u); }
__device__ __forceinline__ float key2f(unsigned k) { const unsigned u = (k & 0x80000000u) ? (k & 0x7fffffffu) : ~k; return __uint_as_float(u); }

constexpr int IX_P = 144, IX_BUF = 256 * IX_P;
__device__ __forceinline__ void idx_unit(const Args& a, int unit, LAS unsigned char* lds) {
    unsigned char* ws = a.ws;
    const int tid = ltid(), wave = tid >> 6, lane = tid & 63, l31 = lane & 31, hi = lane >> 5;
    const int qblk = 511 - unit;
    const int tokb = qblk * 16, tok0 = tokb + wave * 2;
    const int b = tok0 >> 11, sa = tok0 & 2047;
    const int myq = sa + hi;
    const int nchunk = (((tokb & 2047) + 15) >> 8) + 1;
    const bf16_t* QI = (const bf16_t*)(ws + WS_QI); const bf16_t* KI = (const bf16_t*)(ws + WS_KI) + (size_t)b * SEQ * 64; const float* WI = (const float*)(ws + WS_WI);
    bf16x8 qf[4];
    { const int qloc = l31 >> 4, head = l31 & 15; const bf16_t* qp = QI + (size_t)(tok0 + qloc) * 1024 + head * 64 + 8 * hi;
#pragma unroll
      for (int ks = 0; ks < 4; ++ks) qf[ks] = *(const bf16x8*)(qp + ks * 16); }
    float wq[16];
    { const f32x4 a0 = *(const f32x4*)(WI + (size_t)tok0 * 16 + 4 * hi), a1 = *(const f32x4*)(WI + (size_t)tok0 * 16 + 8 + 4 * hi);
      const f32x4 b0 = *(const f32x4*)(WI + (size_t)(tok0 + 1) * 16 + 4 * hi), b1 = *(const f32x4*)(WI + (size_t)(tok0 + 1) * 16 + 8 + 4 * hi);
#pragma unroll
      for (int j = 0; j < 4; ++j) { wq[j] = 0.5f * a0[j]; wq[4 + j] = 0.5f * a1[j]; wq[8 + j] = 0.5f * b0[j]; wq[12 + j] = 0.5f * b1[j]; } }
    u32x4 st[4];
    const u32x4* gsrc = (const u32x4*)KI + tid;
    int ldst[4];
#pragma unroll
    for (int i = 0; i < 4; ++i) { const int p = tid + 512 * i; ldst[i] = (p >> 3) * IX_P + (p & 7) * 16; }
#pragma unroll
    for (int i = 0; i < 4; ++i) st[i] = gsrc[512 * i];
#pragma unroll
    for (int i = 0; i < 4; ++i) *(LAS u32x4*)(lds + ldst[i]) = st[i];
    __syncthreads();
    const int rdo = l31 * IX_P + 16 * hi;
    float sc[64];
#pragma unroll
    for (int c = 0; c < 8; ++c) {
        if (c < nchunk) {
            const bool more = (c + 1) < nchunk;
            if (more) {
#pragma unroll
                for (int i = 0; i < 4; ++i) st[i] = gsrc[(c + 1) * 2048 + 512 * i]; }
            const LAS unsigned char* B = lds + (c & 1) * IX_BUF + rdo;
#pragma unroll
            for (int tp = 0; tp < 8; tp += 2) {
                bf16x8 kf[2][4];
#pragma unroll
                for (int u = 0; u < 2; ++u)
#pragma unroll
                    for (int ks = 0; ks < 4; ++ks) kf[u][ks] = *(const LAS bf16x8*)(B + (tp + u) * 32 * IX_P + ks * 32);
                __builtin_amdgcn_sched_barrier(0);
                f32x16 acc0 = {0.f, 0.f, 0.f, 0.f, 0.f, 0.f, 0.f, 0.f, 0.f, 0.f, 0.f, 0.f, 0.f, 0.f, 0.f, 0.f}, acc1 = acc0;
#pragma unroll
                for (int ks = 0; ks < 4; ++ks) { acc0 = __builtin_amdgcn_mfma_f32_32x32x16_bf16(qf[ks], kf[0][ks], acc0, 0, 0, 0); acc1 = __builtin_amdgcn_mfma_f32_32x32x16_bf16(qf[ks], kf[1][ks], acc1, 0, 0, 0); }
                __builtin_amdgcn_sched_barrier(0);
#pragma unroll
                for (int u = 0; u < 2; ++u) { const int tt = tp + u;
                    float p0 = 0.f, p1 = 0.f;
#pragma unroll
                    for (int r = 0; r < 8; ++r) { const float x0 = u ? acc1[r] : acc0[r], x1 = u ? acc1[8 + r] : acc0[8 + r];
                        p0 = fmaf(wq[r], x0, p0); p0 = fmaf(wq[r], __builtin_fabsf(x0), p0); p1 = fmaf(wq[8 + r], x1, p1); p1 = fmaf(wq[8 + r], __builtin_fabsf(x1), p1); }
                    auto sw = __builtin_amdgcn_permlane32_swap(__float_as_uint(p0), __float_as_uint(p1), false, false);
                    const float s = __uint_as_float(sw[0]) + __uint_as_float(sw[1]);
                    const int key = (c * 8 + tt) * 32 + l31;
                    sc[c * 8 + tt] = (key <= myq) ? s : -INFINITY; }
            }
            if (more) {
#pragma unroll
                for (int i = 0; i < 4; ++i) *(LAS u32x4*)(lds + ((c + 1) & 1) * IX_BUF + ldst[i]) = st[i]; }
            __syncthreads();
        } else {
#pragma unroll
            for (int tt = 0; tt < 8; ++tt) sc[c * 8 + tt] = -INFINITY;
        }
    }
    float thr = -3.0e38f;
    const bool need = (myq + 1) > 256;
    if (__any(need)) {
        float vmin = 3.0e38f, vmax = -3.0e38f;
#pragma unroll
        for (int t = 0; t < 64; ++t) { vmax = fmaxf(vmax, sc[t]); vmin = fminf(vmin, (sc[t] == -INFINITY) ? 3.0e38f : sc[t]); }
#pragma unroll
        for (int o = 1; o < 32; o <<= 1) { vmax = fmaxf(vmax, __shfl_xor(vmax, o, 64)); vmin = fminf(vmin, __shfl_xor(vmin, o, 64)); }
        float lo_v = vmin, hi_v = vmax; int c_lo = myq + 1, c_hi = 1;
        bool done = !need;
        for (int it = 0; it < 128; ++it) {
            const unsigned klo = f2key(lo_v), khi = f2key(hi_v);
            float t = lo_v + (hi_v - lo_v) * (((float)(c_lo - 256) + 0.5f) / (float)(c_lo - c_hi));
            if ((it % 3) == 2 || !(t > lo_v && t < hi_v)) t = key2f(klo + ((khi - klo) >> 1));
            if (c_lo == 256 || khi - klo <= 1u) done = true;
            if (__all(done)) break;
            unsigned n0 = 0u, n1 = 0u, n2 = 0u, n3 = 0u;
#pragma unroll
            for (int q = 0; q < 64; q += 4) { n0 += __float_as_uint(sc[q] - t) >> 31; n1 += __float_as_uint(sc[q + 1] - t) >> 31; n2 += __float_as_uint(sc[q + 2] - t) >> 31; n3 += __float_as_uint(sc[q + 3] - t) >> 31; }
            int c = 64 - (int)((n0 + n1) + (n2 + n3));
            c = half_sum_i32(c);
            if (!done) { if (c >= 256) { lo_v = t; c_lo = c; } else { hi_v = t; c_hi = c; } }
        }
        if (need) thr = lo_v;
    }
    unsigned mylo = 0u, myhi = 0u;
#pragma unroll
    for (int t = 0; t < 64; ++t) {
        const unsigned long long bal = __ballot(sc[t] >= thr);
        if (lane == t) { mylo = (unsigned)bal; myhi = (unsigned)(bal >> 32); }
    }
    unsigned* MASK = (unsigned*)(ws + WS_MASK);
    MASK[(size_t)tok0 * 64 + lane] = mylo;
    MASK[(size_t)(tok0 + 1) * 64 + lane] = myhi;
}

constexpr int AT_KP = 272, AT_VP = 144, AT_KB = 64 * AT_KP, AT_VB = 128 * AT_VP, AT_BUF = AT_KB + AT_VB;

__device__ __forceinline__ bf16x8 pack8(float a0, float a1, float a2, float a3, float a4, float a5, float a6, float a7) {
    u32x4 w = {cvt_pk(a0, a1), cvt_pk(a2, a3), cvt_pk(a4, a5), cvt_pk(a6, a7)}; return __builtin_bit_cast(bf16x8, w);
}

template <int KD, int MODE, int DBG = 0>
__device__ __forceinline__ void attn_core(LAS unsigned char* lds, const bf16_t* kg, const bf16_t* vtg, const int n_kt, const bf16_t* qrow, const int kcol0,
                                          const int qpos, const int wqmax, const unsigned selbits, const int own0, const unsigned* mrow, f32x16 (&o)[4], float& l_out) {
    const int tid = ltid(), lane = tid & 63, l31 = lane & 31, hi = lane >> 5;
    constexpr int NKS = KD / 16;
    bf16x8 qf[NKS];
#pragma unroll
    for (int ks = 0; ks < NKS; ++ks) qf[ks] = *(const bf16x8*)(qrow + kcol0 + ks * 16 + 8 * hi);
#pragma unroll
    for (int d = 0; d < 4; ++d)
#pragma unroll
        for (int r = 0; r < 16; ++r) o[d][r] = 0.f;
    float m = 0.f, l = 0.f; bool has = false;
    const int kc = tid & 15, kr = tid >> 4;
    const int vc = tid & 7, vd = tid >> 3;
    const bf16_t* kgp = kg + (size_t)kr * 128 + kc * 8;
    const bf16_t* vgp = vtg + (size_t)vd * SEQ + vc * 8;
    const int klo = kr * AT_KP + kc * 16, vlo = AT_KB + vd * AT_VP + vc * 16;
    const int kap = (l31 & 0x13) | ((l31 & 4) << 1) | ((l31 & 8) >> 1);
    const int kro = kap * AT_KP + (kcol0 + 8 * hi) * 2, vro = AT_KB + l31 * AT_VP + 16 * hi;
    u32x4 st0, st1, st2, st3;
    st0 = *(const u32x4*)(kgp); st1 = *(const u32x4*)(kgp + 32 * 128); st2 = *(const u32x4*)(vgp); st3 = *(const u32x4*)(vgp + 64 * SEQ);
    *(LAS u32x4*)(lds + klo) = st0; *(LAS u32x4*)(lds + klo + 32 * AT_KP) = st1; *(LAS u32x4*)(lds + vlo) = st2; *(LAS u32x4*)(lds + vlo + 64 * AT_VP) = st3;
    __syncthreads();
    u32x2 mw = {0u, 0u};
    if (MODE == 2) mw = *(const u32x2*)(mrow);
    for (int kt = 0; kt < n_kt; ++kt) {
        const bool more = (kt + 1) < n_kt;
        if (more && !(DBG & 1)) { const bf16_t* kp = kgp + (size_t)(kt + 1) * 64 * 128; const bf16_t* vp = vgp + (kt + 1) * 64;
            st0 = *(const u32x4*)(kp); st1 = *(const u32x4*)(kp + 32 * 128); st2 = *(const u32x4*)(vp); st3 = *(const u32x4*)(vp + 64 * SEQ); }
        const int key0 = kt * 64;
        bool act = key0 <= wqmax;
        const bool past = (MODE == 1) && (key0 < own0);
        const bool selq = ((selbits >> (key0 >> 8)) & 1u) != 0u;
        if (MODE == 1 && past) act = __ballot(selq) != 0ull;
        u32x2 mwn = {0u, 0u};
        if (MODE == 2 && more) mwn = *(const u32x2*)(mrow + 2 * (kt + 1));
        if (act) {
            const LAS unsigned char* B = lds + (kt & 1) * AT_BUF;
            f32x16 s0, s1;
#pragma unroll
            for (int r = 0; r < 16; ++r) { s0[r] = 0.f; s1[r] = 0.f; }
            {
                bf16x8 kf[2 * NKS];
#pragma unroll
                for (int ks = 0; ks < NKS; ++ks) { kf[2 * ks] = *(const LAS bf16x8*)(B + kro + ks * 32); kf[2 * ks + 1] = *(const LAS bf16x8*)(B + kro + 32 * AT_KP + ks * 32); }
                __builtin_amdgcn_sched_barrier(0);
#pragma unroll
                for (int ks = 0; ks < NKS; ++ks) {
                    s0 = __builtin_amdgcn_mfma_f32_32x32x16_bf16(kf[2 * ks], qf[ks], s0, 0, 0, 0);
                    s1 = __builtin_amdgcn_mfma_f32_32x32x16_bf16(kf[2 * ks + 1], qf[ks], s1, 0, 0, 0);
                }
                __builtin_amdgcn_sched_barrier(0);
            }
            bf16x8 vf[16];
#pragma unroll
            for (int kk = 0; kk < 4; ++kk)
#pragma unroll
                for (int d = 0; d < 4; ++d) vf[kk * 4 + d] = *(const LAS bf16x8*)(B + vro + d * 32 * AT_VP + kk * 32);
            __builtin_amdgcn_sched_barrier(0);
            const bool diag = (MODE != 2) && !past && (key0 + 63 > wqmax - 31);
            if (!(DBG & 2)) {
            if (diag) {
                const int d0 = qpos - key0 - 8 * hi;
#pragma unroll
                for (int r = 0; r < 16; ++r) { const int c = 16 * (r >> 3) + (r & 7);
                    s0[r] = (c <= d0) ? s0[r] : -3.0e38f; s1[r] = (c + 32 <= d0) ? s1[r] : -3.0e38f; }
            }
            float mx = fmaxf(s0[0], s1[0]);
#pragma unroll
            for (int r = 1; r < 16; ++r) mx = fmaxf(mx, fmaxf(s0[r], s1[r]));
            mx = pairmax(mx);
            const bool needm = (mx > -1.0e30f) && (!has || (mx - m) > 12.f);
            if (__any(needm)) {
                const float mn = needm ? (has ? fmaxf(m, mx) : mx) : m;
                const float alpha = has ? __builtin_amdgcn_exp2f(m - mn) : 1.f;
                m = mn; has = has || needm; l *= alpha;
#pragma unroll
                for (int d = 0; d < 4; ++d)
#pragma unroll
                    for (int r = 0; r < 16; ++r) o[d][r] *= alpha;
            }
#pragma unroll
            for (int r = 0; r < 16; ++r) { s0[r] = __builtin_amdgcn_exp2f(s0[r] - m); s1[r] = __builtin_amdgcn_exp2f(s1[r] - m); }
            if (MODE == 2) {
                const int w0 = (int)(mw[0] >> (8 * hi)), w1 = (int)(mw[1] >> (8 * hi));
#pragma unroll
                for (int r = 0; r < 16; ++r) { const int c = 16 * (r >> 3) + (r & 7);
                    s0[r] = __uint_as_float(__float_as_uint(s0[r]) & (unsigned)__builtin_amdgcn_sbfe(w0, c, 1));
                    s1[r] = __uint_as_float(__float_as_uint(s1[r]) & (unsigned)__builtin_amdgcn_sbfe(w1, c, 1)); }
            } else if (MODE == 1 && past) {
                const unsigned km = selq ? 0xffffffffu : 0u;
#pragma unroll
                for (int r = 0; r < 16; ++r) { s0[r] = __uint_as_float(__float_as_uint(s0[r]) & km); s1[r] = __uint_as_float(__float_as_uint(s1[r]) & km); }
            }
            float ps = 0.f;
#pragma unroll
            for (int r = 0; r < 16; ++r) ps += s0[r] + s1[r];
            l += ps;
            } else { l += 1.f; }
            bf16x8 pf[4];
            pf[0] = pack8(s0[0], s0[1], s0[2], s0[3], s0[4], s0[5], s0[6], s0[7]);
            pf[1] = pack8(s0[8], s0[9], s0[10], s0[11], s0[12], s0[13], s0[14], s0[15]);
            pf[2] = pack8(s1[0], s1[1], s1[2], s1[3], s1[4], s1[5], s1[6], s1[7]);
            pf[3] = pack8(s1[8], s1[9], s1[10], s1[11], s1[12], s1[13], s1[14], s1[15]);
            __builtin_amdgcn_sched_barrier(0);
#pragma unroll
            for (int kk = 0; kk < 4; ++kk)
#pragma unroll
                for (int d = 0; d < 4; ++d) o[d] = __builtin_amdgcn_mfma_f32_32x32x16_bf16(vf[kk * 4 + d], pf[kk], o[d], 0, 0, 0);
            __builtin_amdgcn_sched_barrier(0);
        }
        if (MODE == 2) mw = mwn;
        if (more && !(DBG & 1)) { LAS unsigned char* Bn = lds + ((kt + 1) & 1) * AT_BUF;
            *(LAS u32x4*)(Bn + klo) = st0; *(LAS u32x4*)(Bn + klo + 32 * AT_KP) = st1; *(LAS u32x4*)(Bn + vlo) = st2; *(LAS u32x4*)(Bn + vlo + 64 * AT_VP) = st3; }
        if (!(DBG & 16)) __syncthreads();
    }
    if (DBG & 16) __syncthreads();
    l_out = pairsum(l);
}

__device__ __forceinline__ void store_o(LAS unsigned char* img, bf16_t* out0, const f32x16 (&o)[4], float scale, int lane) {
    const int l31 = lane & 31, hi = lane >> 5;
#pragma unroll
    for (int d = 0; d < 4; ++d)
#pragma unroll
        for (int g = 0; g < 4; ++g) {
            u32x2 w = {cvt_pk(o[d][4 * g] * scale, o[d][4 * g + 1] * scale), cvt_pk(o[d][4 * g + 2] * scale, o[d][4 * g + 3] * scale)};
            *(LAS u32x2*)(img + l31 * 272 + (d * 32 + 8 * g + 4 * hi) * 2) = w;
        }
    const int r0 = lane >> 4, c = lane & 15;
    u32x4 v[8];
#pragma unroll
    for (int i = 0; i < 8; ++i) v[i] = *(const LAS u32x4*)(img + (r0 + 4 * i) * 272 + c * 16);
#pragma unroll
    for (int i = 0; i < 8; ++i) *(u32x4*)(out0 + (size_t)(r0 + 4 * i) * DM + c * 8) = v[i];
}

__device__ __forceinline__ void attnA_unit(const Args& a, int l, int unit, LAS unsigned char* lds) {
    unsigned char* ws = a.ws;
    const int tid = ltid(), wave = tid >> 6, lane = tid & 63, l31 = lane & 31, hi = lane >> 5;
    const int qt = 15 - unit / 24, bh = unit % 24, b = bh / 6, h = bh % 6, q0 = qt * 128;
    const int comp = wave >> 2, wq0 = q0 + (wave & 3) * 32, qpos = wq0 + l31;
    const bf16_t* kg = (const bf16_t*)(ws + WS_KA) + (size_t)(b * 6 + h) * SEQ * 128;
    const bf16_t* vtg = (const bf16_t*)(ws + WS_VAT) + (size_t)(b * 6 + h) * 128 * SEQ;
    const bf16_t* qrow = (const bf16_t*)(ws + WS_QA) + ((size_t)(b * 6 + h) * SEQ + qpos) * 128;
    f32x16 o[4]; float lsum;
    attn_core<64, 0>(lds, kg, vtg, (q0 + 128) / 64, qrow, comp * 64, qpos, wq0 + 31, 0u, 0, nullptr, o, lsum);
    const float inv = 1.f / lsum;
    LAS float* xp = (LAS float*)lds + (wave & 3) * 4096 + lane;
    if (comp == 1) {
#pragma unroll
        for (int d = 0; d < 4; ++d)
#pragma unroll
            for (int r = 0; r < 16; ++r) xp[(d * 16 + r) * 64] = o[d][r] * inv;
    }
    __syncthreads();
    if (comp == 0) {
        const float* lp = a.in[I_ALAM] + l * 256;
        const float s01 = wave_sum(lp[lane] * lp[64 + lane]), s23 = wave_sum(lp[128 + lane] * lp[192 + lane]);
        const float lam_init = 0.8f - 0.6f * __expf(-0.3f * (float)l);
        const float lam = __expf(s01) - __expf(s23) + lam_init;
        float ss = 0.f;
#pragma unroll
        for (int d = 0; d < 4; ++d) {
            asm volatile("" ::: "memory");
#pragma unroll
            for (int r = 0; r < 16; ++r) { const float v = o[d][r] * inv - lam * xp[(d * 16 + r) * 64]; o[d][r] = v; ss += v * v; }
        }
        ss = pairsum(ss);
        const float rs = rsqrtf(ss * (1.f / 128.f) + EPS) * (1.f - lam_init);
        const float* g = a.in[I_ASUB] + l * 128;
        { f32x4 gv[16];
#pragma unroll
          for (int d = 0; d < 4; ++d)
#pragma unroll
              for (int gq = 0; gq < 4; ++gq) gv[d * 4 + gq] = *(const f32x4*)(g + d * 32 + 8 * gq + 4 * hi);
          __builtin_amdgcn_sched_barrier(0);
#pragma unroll
          for (int d = 0; d < 4; ++d)
#pragma unroll
              for (int gq = 0; gq < 4; ++gq)
#pragma unroll
                  for (int j = 0; j < 4; ++j) o[d][4 * gq + j] *= gv[d * 4 + gq][j]; }
        store_o(lds + 65536 + (wave & 3) * 8704, (bf16_t*)(ws + WS_MIXO) + (size_t)(b * SEQ + wq0) * DM + h * 128, o, rs, lane);
    }
}

template <int DBG>
__device__ __forceinline__ void attnB_unit(const Args& a, int unit, LAS unsigned char* lds) {
    unsigned char* ws = a.ws;
    const int tid = ltid(), wave = tid >> 6, lane = tid & 63, l31 = lane & 31, hi = lane >> 5;
    const int jb = 7 - unit / 20, bh = unit % 20, b = bh / 5, h = bh % 5, q0 = jb * 256;
    const int wq0 = q0 + wave * 32, qpos = wq0 + l31;
    const bf16_t* kg = (const bf16_t*)(ws + WS_KB) + (size_t)(b * 5 + h) * SEQ * 128;
    const bf16_t* vtg = (const bf16_t*)(ws + WS_VBT) + (size_t)(b * 5 + h) * 128 * SEQ;
    const bf16_t* qrow = (const bf16_t*)(ws + WS_QB) + ((size_t)(b * 5 + h) * SEQ + qpos) * 128;
    unsigned sel = 0u;
    if (jb <= 3) sel = (1u << jb) - 1u;
    else {
        float qv[64];
#pragma unroll
        for (int ks = 0; ks < 8; ++ks) { const u32x4 w = *(const u32x4*)(qrow + ks * 16 + 8 * hi);
#pragma unroll
            for (int j = 0; j < 4; ++j) { qv[ks * 8 + 2 * j] = bflo(w[j]); qv[ks * 8 + 2 * j + 1] = bfhi(w[j]); } }
        LAS float* kml = (LAS float*)(lds + 2 * AT_BUF);
        { const float* km = (const float*)(ws + WS_KMEAN) + (size_t)(b * 5 + h) * 8 * 128; const float k0 = km[tid], k1 = km[tid + 512]; kml[tid] = k0; kml[tid + 512] = k1; }
        __syncthreads();
        float gt[7];
#pragma unroll
        for (int n = 0; n < 7; ++n) {
            float sgate = -INFINITY;
            if (n < jb) {
                f32x4 kv[16];
#pragma unroll
                for (int ks = 0; ks < 8; ++ks) { kv[2 * ks] = *(const LAS f32x4*)(kml + n * 128 + ks * 16 + 8 * hi); kv[2 * ks + 1] = *(const LAS f32x4*)(kml + n * 128 + ks * 16 + 8 * hi + 4); }
                __builtin_amdgcn_sched_barrier(0);
                float sacc = 0.f;
#pragma unroll
                for (int ks = 0; ks < 8; ++ks)
#pragma unroll
                    for (int j = 0; j < 4; ++j) { sacc = fmaf(qv[ks * 8 + j], kv[2 * ks][j], sacc); sacc = fmaf(qv[ks * 8 + 4 + j], kv[2 * ks + 1][j], sacc); }
                sgate = pairsum(sacc); }
            gt[n] = sgate;
        }
#pragma unroll
        for (int pick = 0; pick < 3; ++pick) { float best = -INFINITY; int bi = 0;
#pragma unroll
            for (int n = 0; n < 7; ++n) { const bool ok = (n < jb) && !((sel >> n) & 1u) && (gt[n] > best); best = ok ? gt[n] : best; bi = ok ? n : bi; }
            sel |= 1u << bi; }
    }
    f32x16 o[4]; float lsum;
    attn_core<128, 1, DBG>(lds, kg, vtg, (q0 + 256) / 64, qrow, 0, qpos, wq0 + 31, sel, q0, nullptr, o, lsum);
    store_o(lds + wave * 8704, (bf16_t*)(ws + (DBG ? WS_XM : WS_MIXO)) + (size_t)(b * SEQ + wq0) * DM + 768 + h * 128, o, 1.f / lsum, lane);
}

__device__ __forceinline__ void attnC_unit(const Args& a, int unit, LAS unsigned char* lds) {
    unsigned char* ws = a.ws;
    const int tid = ltid(), wave = tid >> 6, lane = tid & 63, l31 = lane & 31, hi = lane >> 5;
    const int jb = 7 - unit / 20, bh = unit % 20, b = bh / 5, h = bh % 5, q0 = jb * 256;
    const int wq0 = q0 + wave * 32, qpos = wq0 + l31;
    const bf16_t* kg = (const bf16_t*)(ws + WS_KC) + (size_t)b * SEQ * 128;
    const bf16_t* vtg = (const bf16_t*)(ws + WS_VCT) + (size_t)b * 128 * SEQ;
    const bf16_t* qrow = (const bf16_t*)(ws + WS_QC) + ((size_t)(b * 5 + h) * SEQ + qpos) * 128;
    const unsigned* mrow = (const unsigned*)(ws + WS_MASK) + (size_t)(b * SEQ + qpos) * 64;
    f32x16 o[4]; float lsum;
    attn_core<128, 2>(lds, kg, vtg, (q0 + 256) / 64, qrow, 0, qpos, wq0 + 31, 0u, 0, mrow, o, lsum);
    store_o(lds + wave * 8704, (bf16_t*)(ws + WS_MIXO) + (size_t)(b * SEQ + wq0) * DM + 1408 + h * 128, o, 1.f / lsum, lane);
}

__device__ __forceinline__ float sel8(const float* v, int i) {
    float r = v[0];
#pragma unroll
    for (int k = 1; k < 8; ++k) r = (i == k) ? v[k] : r;
    return r;
}
__device__ __forceinline__ void p6_router(const Args& a, int l, LAS unsigned char* lds) {
    unsigned char* ws = a.ws;
    const int G = gridDim.x, bx = blockIdx.x, tid = ltid(), wave = tid >> 6, lane = tid & 63, l31 = lane & 31, hi = lane >> 5;
    const float* XM = (const float*)(ws + WS_XM); const float* WR = (const float*)(ws + WS_WR) + (size_t)l * 64 * DM;
    unsigned* cnt = (unsigned*)(ws + WS_CTL) + CW_CNT + l * 32;
    int* LIST = (int*)(ws + WS_LIST); float* LISTG = (float*)(ws + WS_LISTG); int* TOKE = (int*)(ws + WS_TOKE); int* TOKP = (int*)(ws + WS_TOKP);
    LAS float* red = (LAS float*)lds;
    LAS float* ssred = (LAS float*)(lds + 65536);
    LAS float* lg = (LAS float*)(lds + 65536 + 1024);
    LAS int* lcnt = (LAS int*)(lds + 65536 + 1024 + 8192);
    for (int tb = bx; tb < NT / 32; tb += G) {
        const int tok0 = tb * 32;
        f32x16 acc0, acc1;
#pragma unroll
        for (int r = 0; r < 16; ++r) { acc0[r] = 0.f; acc1[r] = 0.f; }
        float ss = 0.f;
        const float* xp = XM + (size_t)(tok0 + l31) * DM + wave * 256 + 4 * hi;
        const float* w0 = WR + (size_t)l31 * DM + wave * 256 + 4 * hi;
        const float* w1 = WR + (size_t)(32 + l31) * DM + wave * 256 + 4 * hi;
        if (tid < 32) lcnt[tid] = 0;
#pragma unroll 4
        for (int it = 0; it < 32; ++it) {
            const f32x4 xv = *(const f32x4*)(xp + it * 8), b0 = *(const f32x4*)(w0 + it * 8), b1 = *(const f32x4*)(w1 + it * 8);
            ss += xv[0] * xv[0] + xv[1] * xv[1] + xv[2] * xv[2] + xv[3] * xv[3];
#pragma unroll
            for (int s = 0; s < 4; ++s) { acc0 = __builtin_amdgcn_mfma_f32_32x32x2f32(xv[s], b0[s], acc0, 0, 0, 0); acc1 = __builtin_amdgcn_mfma_f32_32x32x2f32(xv[s], b1[s], acc1, 0, 0, 0); }
        }
#pragma unroll
        for (int r = 0; r < 16; ++r) { const int trow = (r & 3) + 8 * (r >> 2) + 4 * hi;
            red[(wave * 32 + trow) * 64 + l31] = acc0[r]; red[(wave * 32 + trow) * 64 + 32 + l31] = acc1[r]; }
        ss = pairsum(ss);
        if (hi == 0) ssred[wave * 32 + l31] = ss;
        __syncthreads();
        { const int t = tid >> 4, c4 = (tid & 15) * 4;
          f32x4 sum = {0.f, 0.f, 0.f, 0.f}; float st = 0.f;
#pragma unroll
          for (int w = 0; w < 8; ++w) { sum += *(const LAS f32x4*)(red + (w * 32 + t) * 64 + c4); st += ssred[w * 32 + t]; }
          const float rs = rsqrtf(st * (1.f / DM) + EPS);
          if (c4 < 36) {
#pragma unroll
              for (int j = 0; j < 4; ++j) { const int c = c4 + j; const float bias = c < 32 ? a.in[I_BEXP][l * 32 + c] : a.in[I_BGRP][l * 4 + (c - 32)]; lg[t * 64 + c] = sum[j] * rs + bias; }
          }
          if (c4 == 60) lg[t * 64 + 63] = rs; }
        __syncthreads();
        int e0 = 0, e1 = 0, lp0 = 0, lp1 = 0; float g0 = 0.f, g1 = 0.f;
        if (tid < 32) {
            const LAS float* L = lg + tid * 64;
            int gi = 0; float gm = L[32];
            for (int j = 1; j < 4; ++j) { const float v = L[32 + j]; if (v > gm) { gm = v; gi = j; } }
            float gs = 0.f;
            for (int j = 0; j < 4; ++j) gs += __expf(L[32 + j] - gm);
            const float gw = 1.f / gs;
            float em = L[gi * 8];
            for (int k = 1; k < 8; ++k) em = fmaxf(em, L[gi * 8 + k]);
            float es = 0.f;
            for (int k = 0; k < 8; ++k) es += __expf(L[gi * 8 + k] - em);
            const float ies = 1.f / es;
            int i0 = 0; float v0 = -1.f;
            for (int k = 0; k < 8; ++k) { const float p = __expf(L[gi * 8 + k] - em) * ies; if (p > v0) { v0 = p; i0 = k; } }
            int i1 = 0; float v1 = -1.f;
            for (int k = 0; k < 8; ++k) { const float p = __expf(L[gi * 8 + k] - em) * ies; if (k != i0 && p > v1) { v1 = p; i1 = k; } }
            const float inv = 1.f / (v0 + v1);
            g0 = gw * v0 * inv; g1 = gw * v1 * inv; e0 = gi * 8 + i0; e1 = gi * 8 + i1;
            lp0 = atomicAdd((int*)(lcnt + e0), 1); lp1 = atomicAdd((int*)(lcnt + e1), 1);
        }
        __syncthreads();
        if (tid < 32) { const int c = lcnt[tid]; lcnt[32 + tid] = c > 0 ? (int)atomicAdd(cnt + tid, (unsigned)c) : 0; }
        __syncthreads();
        if (tid < 32) {
            const int tok = tok0 + tid, p0 = lcnt[32 + e0] + lp0, p1 = lcnt[32 + e1] + lp1;
            LIST[(size_t)e0 * NT + p0] = tok; LISTG[(size_t)e0 * NT + p0] = g0; LIST[(size_t)e1 * NT + p1] = tok; LISTG[(size_t)e1 * NT + p1] = g1;
            TOKE[tok * 2] = e0; TOKE[tok * 2 + 1] = e1; TOKP[tok * 2] = p0; TOKP[tok * 2 + 1] = p1;
            ((float*)(ws + WS_RSTD2))[tok] = lg[tid * 64 + 63];
        }
        __syncthreads();
    }
}

constexpr int SK_MAX = 0;
struct MoeTab { volatile LAS int* tpre; volatile LAS int* dcnt; volatile LAS int* skrows; volatile LAS int* skbase; volatile LAS int* ske; volatile LAS int* skn; };
__device__ __forceinline__ MoeTab moe_tab_ptrs(LAS unsigned char* lds) {
    MoeTab T; T.tpre = (volatile LAS int*)(lds + LDS_CTL + 64); T.dcnt = (volatile LAS int*)(lds + LDS_CTL + 256); T.skrows = (volatile LAS int*)(lds + LDS_CTL + 384);
    T.skbase = (volatile LAS int*)(lds + LDS_CTL + 512); T.ske = (volatile LAS int*)(lds + LDS_CTL + 640); T.skn = (volatile LAS int*)(lds + LDS_CTL + 768); return T;
}
__device__ __forceinline__ void moe_table(const Args& a, int l, const MoeTab& T) {
    const unsigned* cnt = (const unsigned*)(a.ws + WS_CTL) + CW_CNT + l * 32;
    const int tid = ltid();
    __syncthreads();
    if (tid < 32) T.dcnt[tid] = (int)ld_agent(cnt + tid);
    __syncthreads();
    if (tid == 0) { int acc = 0, nsk = 0;
#pragma unroll 1
        for (int e = 0; e < NE; ++e) { const int c = T.dcnt[e], f = c >> 8, rem = c & 255; const int sk = (rem > 0 && rem <= SK_MAX) ? rem : 0;
            T.tpre[e] = acc; acc += f + ((rem > SK_MAX) ? 1 : 0); T.dcnt[e] = sk ? (f << 8) : c; T.skrows[e] = sk; if (sk) { T.ske[nsk] = e; ++nsk; } }
        T.tpre[NE] = acc; *T.skn = nsk;
        int base = acc * 256;
#pragma unroll 1
        for (int i = 0; i < nsk; ++i) { T.skbase[T.ske[i]] = base; base += 64; } }
    __syncthreads();
}
__device__ __forceinline__ size_t moe_row(const MoeTab& T, int e, int pos) {
    const int d = T.dcnt[e]; return pos < d ? (size_t)T.tpre[e] * 256 + pos : (size_t)T.skbase[e] + (pos - d);
}

template <int NR, int NC, int U = 4>
__device__ __forceinline__ void wave_gemm(const bf16_t* const (&ap)[NR], const bf16_t* const (&bp)[NC], const int nr, const int nsteps, f32x4 (&acc)[NR][NC]) {
#pragma unroll
    for (int i = 0; i < NR; ++i)
#pragma unroll
        for (int j = 0; j < NC; ++j) acc[i][j] = (f32x4){0.f, 0.f, 0.f, 0.f};
#pragma unroll 1
    for (int s0 = 0; s0 < nsteps; s0 += U) {
        bf16x8 af[U][NR], bf[U][NC];
#pragma unroll
        for (int u = 0; u < U; ++u) {
#pragma unroll
            for (int i = 0; i < NR; ++i) if (i < nr) af[u][i] = *(const bf16x8*)(ap[i] + (s0 + u) * 32);
#pragma unroll
            for (int j = 0; j < NC; ++j) bf[u][j] = *(const bf16x8*)(bp[j] + (s0 + u) * 32);
        }
        __builtin_amdgcn_sched_barrier(0);
#pragma unroll
        for (int u = 0; u < U; ++u)
#pragma unroll
            for (int i = 0; i < NR; ++i) if (i < nr)
#pragma unroll
                for (int j = 0; j < NC; ++j) acc[i][j] = __builtin_amdgcn_mfma_f32_16x16x32_bf16(bf[u][j], af[u][i], acc[i][j], 0, 0, 0);
    }
}

__device__ __forceinline__ void skinny_kiwi(const Args& a, int l, LAS unsigned char* lds) {
    unsigned char* ws = a.ws;
    const int G = gridDim.x, bx = blockIdx.x, tid = ltid(), wave = tid >> 6, lane = tid & 63, fr = lane & 15, fq = lane >> 4, rg = wave >> 2, kq = wave & 3;
    const bf16_t* XB = (const bf16_t*)(ws + WS_XB); const bf16_t* W = (const bf16_t*)(ws + WS_WIN) + (size_t)l * NPAD * DM; bf16_t* PROJ = (bf16_t*)(ws + WS_PROJ);
    LAS f32x4* red = (LAS f32x4*)lds;
    for (int rb = bx; rb < NT / 32; rb += G) {
        const int row = rb * 32 + rg * 16 + fr;
        const bf16_t* ap[1] = {XB + (size_t)row * DM + kq * 512 + 8 * fq};
        const bf16_t* bp[5];
#pragma unroll
        for (int j = 0; j < 5; ++j) bp[j] = W + (size_t)(6144 + 16 * j + fr) * DM + kq * 512 + 8 * fq;
        f32x4 acc[1][5];
        wave_gemm<1, 5>(ap, bp, 1, 16, acc);
        if (kq > 0) {
#pragma unroll
            for (int j = 0; j < 5; ++j) red[((rg * 3 + kq - 1) * 5 + j) * 64 + lane] = acc[0][j]; }
        __syncthreads();
        if (kq == 0) { const float rs = ((const float*)(ws + WS_RSTD1))[row];
#pragma unroll
            for (int j = 0; j < 5; ++j) { f32x4 v = acc[0][j];
#pragma unroll
                for (int k = 0; k < 3; ++k) v += red[((rg * 3 + k) * 5 + j) * 64 + lane];
                v = v * rs; u32x2 w = {cvt_pk(v[0], v[1]), cvt_pk(v[2], v[3])}; *(u32x2*)(PROJ + (size_t)row * NPAD + 6144 + 16 * j + 4 * fq) = w; } }
        __syncthreads();
    }
}

__device__ __forceinline__ void skinny_up(const Args& a, int l, LAS unsigned char* lds, const MoeTab& T) {
    unsigned char* ws = a.ws;
    const int G = gridDim.x, bx = blockIdx.x, tid = ltid(), wave = tid >> 6, lane = tid & 63, fr = lane & 15, fq = lane >> 4;
    const bf16_t* XMB = (const bf16_t*)(ws + WS_XMB); const int* LIST = (const int*)(ws + WS_LIST); const float* LISTG = (const float*)(ws + WS_LISTG);
    bf16_t* H = (bf16_t*)(ws + WS_H);
    const int ntask = (*T.skn) * 16;
    for (int bt = bx; bt < ntask; bt += G) {
        const int e = T.ske[bt >> 4], rows = T.skrows[e], p0 = T.dcnt[e];
        const int wt = (bt & 15) * 8 + wave, rg = wt >> 5, f0 = (wt & 31) * 16;
        if (rg * 16 < rows) {
            const bf16_t* W = (const bf16_t*)(ws + WS_W1) + ((size_t)(l * NE + e)) * 1024 * DM;
            int r = 16 * rg + fr; const bool rv = r < rows; r = rv ? r : rows - 1;
            const int tok = LIST[(size_t)e * NT + p0 + r];
            const bf16_t* ap[1] = {XMB + (size_t)tok * DM + 8 * fq};
            const bf16_t* bp[2];
            bp[0] = W + (size_t)((f0 >> 7) * 256 + (f0 & 127) + fr) * DM + 8 * fq; bp[1] = bp[0] + (size_t)128 * DM;
            f32x4 acc[1][2];
            wave_gemm<1, 2, 8>(ap, bp, 1, 64, acc);
            if (rv) { const float rs = ((const float*)(ws + WS_RSTD2))[tok], gv = LISTG[(size_t)e * NT + p0 + r]; const f32x4 g = acc[0][0] * rs, up = acc[0][1] * rs; float h[4];
#pragma unroll
                for (int q = 0; q < 4; ++q) { const float sg = g[q] / (1.f + __expf(-g[q])); h[q] = sg * up[q] * gv; }
                u32x2 w = {cvt_pk(h[0], h[1]), cvt_pk(h[2], h[3])}; *(u32x2*)(H + ((size_t)T.skbase[e] + r) * FF + f0 + 4 * fq) = w; }
        }
    }
}

__device__ __forceinline__ void skinny_down(const Args& a, int l, const MoeTab& T) {
    unsigned char* ws = a.ws;
    const int G = gridDim.x, bx = blockIdx.x, tid = ltid(), wave = tid >> 6, lane = tid & 63, fr = lane & 15, fq = lane >> 4;
    const bf16_t* H = (const bf16_t*)(ws + WS_H); bf16_t* Y = (bf16_t*)(ws + WS_Y);
    const int ntask = (*T.skn) * 8;
    for (int bt = bx; bt < ntask; bt += G) {
        const int e = T.ske[bt >> 3], rows = T.skrows[e], nr = (rows + 15) >> 4, n0 = (bt & 7) * 256 + wave * 32;
        const size_t rb = (size_t)T.skbase[e];
        const bf16_t* W = (const bf16_t*)(ws + WS_WD) + ((size_t)(l * NE + e)) * DM * FF;
        const bf16_t* ap[4];
#pragma unroll
        for (int i = 0; i < 4; ++i) { int r = 16 * i + fr; r = r < rows ? r : rows - 1; ap[i] = H + (rb + r) * FF + 8 * fq; }
        const bf16_t* bp[2] = {W + (size_t)(n0 + fr) * FF + 8 * fq, W + (size_t)(n0 + 16 + fr) * FF + 8 * fq};
        f32x4 acc[4][2];
        wave_gemm<4, 2>(ap, bp, nr, 16, acc);
#pragma unroll
        for (int i = 0; i < 4; ++i) { const int r = 16 * i + fr;
            if (r < rows) {
#pragma unroll
                for (int j = 0; j < 2; ++j) { const f32x4 v = acc[i][j]; u32x2 w = {cvt_pk(v[0], v[1]), cvt_pk(v[2], v[3])}; *(u32x2*)(Y + (rb + r) * DM + n0 + 16 * j + 4 * fq) = w; } } }
    }
}

__device__ __forceinline__ void p9_combine(const Args& a, int l, const MoeTab& T) {
    unsigned char* ws = a.ws;
    const int G = gridDim.x, bx = blockIdx.x, tid = ltid(), wave = tid >> 6, lane = tid & 63;
    const float* XM = (const float*)(ws + WS_XM); const bf16_t* Y = (const bf16_t*)(ws + WS_Y);
    const int* TOKE = (const int*)(ws + WS_TOKE); const int* TOKP = (const int*)(ws + WS_TOKP);
    float* xo = (l == NL - 1) ? a.out : (float*)(ws + WS_X1);
    bf16_t* XB = (bf16_t*)(ws + WS_XB); float* RSTD1 = (float*)(ws + WS_RSTD1);
    for (int row = bx * 8 + wave; row < NT; row += G * 8) {
        const int e0 = TOKE[row * 2], e1 = TOKE[row * 2 + 1];
        const size_t r0 = moe_row(T, e0, TOKP[row * 2]), r1 = moe_row(T, e1, TOKP[row * 2 + 1]);
        float ss = 0.f;
        f32x4 xv[8]; u32x2 ya[8], yb[8];
#pragma unroll
        for (int i = 0; i < 8; ++i) { const int c = i * 256 + lane * 4;
            xv[i] = *(const f32x4*)(XM + (size_t)row * DM + c); ya[i] = *(const u32x2*)(Y + r0 * DM + c); yb[i] = *(const u32x2*)(Y + r1 * DM + c); }
        __builtin_amdgcn_sched_barrier(0);
#pragma unroll
        for (int i = 0; i < 8; ++i) { const int c = i * 256 + lane * 4;
            f32x4 v = xv[i]; const u32x2 y0 = ya[i], y1 = yb[i];
            v[0] = (v[0] + bflo(y0[0])) + bflo(y1[0]); v[1] = (v[1] + bfhi(y0[0])) + bfhi(y1[0]); v[2] = (v[2] + bflo(y0[1])) + bflo(y1[1]); v[3] = (v[3] + bfhi(y0[1])) + bfhi(y1[1]);
            *(f32x4*)(xo + (size_t)row * DM + c) = v;
            ss += v[0] * v[0] + v[1] * v[1] + v[2] * v[2] + v[3] * v[3];
            u32x2 w = {cvt_pk(v[0], v[1]), cvt_pk(v[2], v[3])}; *(u32x2*)(XB + (size_t)row * DM + c) = w; }
        ss = wave_sum(ss);
        if (lane == 0) RSTD1[row] = rsqrtf(ss * (1.f / DM) + EPS);
    }
}

constexpr int N_PHASES = 1 + 9 * NL;
typedef const Args __attribute__((address_space(4)))* ArgsP;
#define PHASE_FN static __device__ __forceinline__ void
__device__ __forceinline__ Args ld_args(ArgsP ap) {
    Args a;
#pragma unroll
    for (int i = 0; i < 21; ++i) a.in[i] = ap->in[i];
    a.out = ap->out; a.ws = ap->ws; a.ph_lo = ap->ph_lo; a.ph_hi = ap->ph_hi; return a;
}

PHASE_FN ph_prologue(ArgsP ap, LAS unsigned char* lds) { asm volatile("" : "+s"(ap)); const Args a = ld_args(ap); p0_prologue(a, lds); }
PHASE_FN ph_inproj(ArgsP ap, LAS unsigned char* lds, int l) {
    asm volatile("" : "+s"(ap)); const Args a = ld_args(ap); unsigned char* ws = a.ws;
    pg8::DenseSched S; S.init(ws + WS_XB, ws + WS_WIN + (size_t)l * NPAD * DM * 2, NT, 6144, DM, gridDim.x, blockIdx.x);
    EpiProj E{(bf16_t*)(ws + WS_PROJ), (const float*)(ws + WS_RSTD1)};
    pg8::gemm_phase(lds, DM, S, E);
    skinny_kiwi(a, l, lds);
    if (REPEAT_PH == 11) { skinny_kiwi(a, l, lds); skinny_kiwi(a, l, lds); }
}
PHASE_FN ph_prep(ArgsP ap, LAS unsigned char* lds, int l) { asm volatile("" : "+s"(ap)); const Args a = ld_args(ap); p2_prep(a, l, lds); }
PHASE_FN ph_idx(ArgsP ap, LAS unsigned char* lds, int l, int rep) {
    asm volatile("" : "+s"(ap)); const Args a = ld_args(ap); unsigned* qh = (unsigned*)(a.ws + WS_CTL) + CW_Q + l * 8 * 64; volatile LAS int* slot = (volatile LAS int*)(lds + LDS_CTL + 32);
    for (;;) { const int u = next_unit(qh + (0 + 4 * rep) * 64, slot); if (u >= 512) break; idx_unit(a, u, lds); }
}
PHASE_FN ph_attnA(ArgsP ap, LAS unsigned char* lds, int l, int rep) {
    asm volatile("" : "+s"(ap)); const Args a = ld_args(ap); unsigned* qh = (unsigned*)(a.ws + WS_CTL) + CW_Q + l * 8 * 64; volatile LAS int* slot = (volatile LAS int*)(lds + LDS_CTL + 32);
    for (;;) { const int u = next_unit(qh + (1 + 4 * rep) * 64, slot); if (u >= 384) break; attnA_unit(a, l, u, lds); }
}
template <int DBG>
PHASE_FN ph_attnB(ArgsP ap, LAS unsigned char* lds, int l, int rep) {
    asm volatile("" : "+s"(ap)); const Args a = ld_args(ap); unsigned* qh = (unsigned*)(a.ws + WS_CTL) + CW_Q + l * 8 * 64; volatile LAS int* slot = (volatile LAS int*)(lds + LDS_CTL + 32);
    for (;;) { const int u = next_unit(qh + (2 + 4 * rep) * 64, slot); if (u >= 160) break; attnB_unit<DBG>(a, u, lds); }
}
PHASE_FN ph_attnC(ArgsP ap, LAS unsigned char* lds, int l, int rep) {
    asm volatile("" : "+s"(ap)); const Args a = ld_args(ap); unsigned* qh = (unsigned*)(a.ws + WS_CTL) + CW_Q + l * 8 * 64; volatile LAS int* slot = (volatile LAS int*)(lds + LDS_CTL + 32);
    for (;;) { const int u = next_unit(qh + (3 + 4 * rep) * 64, slot); if (u >= 160) break; attnC_unit(a, u, lds); }
}
PHASE_FN ph_outproj(ArgsP ap, LAS unsigned char* lds, int l) {
    asm volatile("" : "+s"(ap)); const Args a = ld_args(ap); unsigned char* ws = a.ws;
    pg8::DenseSched S; S.init(ws + WS_MIXO, ws + WS_WOUT + (size_t)l * DM * DM * 2, NT, DM, DM, gridDim.x, blockIdx.x);
    EpiOut E{l == 0 ? a.in[I_X] : (const float*)(ws + WS_X1), (float*)(ws + WS_XM), (bf16_t*)(ws + WS_XMB)};
    pg8::gemm_phase(lds, DM, S, E);
}
PHASE_FN ph_router(ArgsP ap, LAS unsigned char* lds, int l) { asm volatile("" : "+s"(ap)); const Args a = ld_args(ap); p6_router(a, l, lds); }
PHASE_FN ph_moe_up(ArgsP ap, LAS unsigned char* lds, int l) {
    asm volatile("" : "+s"(ap)); const Args a = ld_args(ap); unsigned char* ws = a.ws;
    const MoeTab T = moe_tab_ptrs(lds);
    const int G = gridDim.x, bx = blockIdx.x; const int vcu = (G % 8 == 0) ? (bx % 8) * (G / 8) + bx / 8 : bx;
    moe_table(a, l, T);
    pg8::MoeSched<true> S{(const char*)(ws + WS_XMB), (const char*)(ws + WS_W1 + (size_t)l * NE * 1024 * DM * 2), (const int*)(ws + WS_LIST), T.tpre, T.dcnt, DM, 4, T.tpre[NE], G, vcu, (size_t)1024 * DM * 2};
    EpiUp E{(bf16_t*)(ws + WS_H), (const int*)(ws + WS_LIST), (const float*)(ws + WS_LISTG), (const float*)(ws + WS_RSTD2), T.tpre};
    pg8::gemm_phase(lds, DM, S, E);
    skinny_up(a, l, lds, T);
    if (REPEAT_PH == 71) { skinny_up(a, l, lds, T); skinny_up(a, l, lds, T); }
}
PHASE_FN ph_moe_down(ArgsP ap, LAS unsigned char* lds, int l) {
    asm volatile("" : "+s"(ap)); const Args a = ld_args(ap); unsigned char* ws = a.ws;
    const MoeTab T = moe_tab_ptrs(lds);
    const int G = gridDim.x, bx = blockIdx.x; const int vcu = (G % 8 == 0) ? (bx % 8) * (G / 8) + bx / 8 : bx;
    moe_table(a, l, T);
    pg8::MoeSched<false> S{(const char*)(ws + WS_H), (const char*)(ws + WS_WD + (size_t)l * NE * DM * FF * 2), nullptr, T.tpre, T.dcnt, FF, 8, T.tpre[NE], G, vcu, (size_t)DM * FF * 2};
    EpiDown E{(bf16_t*)(ws + WS_Y), T.tpre};
    pg8::gemm_phase(lds, FF, S, E);
    skinny_down(a, l, T);
    if (REPEAT_PH == 81) { skinny_down(a, l, T); skinny_down(a, l, T); }
}
PHASE_FN ph_deferred(ArgsP ap, LAS unsigned char* lds, int which) {
    asm volatile("" : "+s"(ap)); const Args a = ld_args(ap);
    const MoeTab T = moe_tab_ptrs(lds);
    const int G = gridDim.x, bx = blockIdx.x; const int vcu = (G % 8 == 0) ? (bx % 8) * (G / 8) + bx / 8 : bx;
    const int nunits = T.tpre[NE] * (which ? 8 : 4), e = nunits % G;
    const int DLO = which ? DEF2_LO : DEF_LO, DN = which ? DEF2_N : DEF_N;
    const int ns = (e == 0) ? G : G - e; int p1 = ns * DEF_QUOTA; p1 = p1 < DN ? p1 : DN;
    if (e == 0) cvt_deferred(a, lds, vcu, G, DLO, p1);
    else if (vcu >= e) cvt_deferred(a, lds, vcu - e, ns, DLO, p1);
    if (p1 < DN) cvt_deferred(a, lds, vcu, G, DLO + p1, DN - p1);
}
PHASE_FN ph_combine(ArgsP ap, LAS unsigned char* lds, int l) {
    asm volatile("" : "+s"(ap)); const Args a = ld_args(ap);
    const MoeTab T = moe_tab_ptrs(lds);
    moe_table(a, l, T);
    p9_combine(a, l, T);
}

__global__ void __launch_bounds__(NTHR, 2) mk_fwd(Args a_unused) {
    extern __shared__ __attribute__((aligned(16))) unsigned char lds_raw[];
    LAS unsigned char* lds = (LAS unsigned char*)lds_raw;
    volatile LAS unsigned* lctl = (volatile LAS unsigned*)(lds + LDS_CTL);
    ArgsP ap = (ArgsP)__builtin_amdgcn_kernarg_segment_ptr();
    const int tid = ltid();
    if (tid < 128) lctl[tid] = 0u;
    __syncthreads();
    unsigned* ctl = (unsigned*)(ap->ws + WS_CTL);
    const int lo = ap->ph_lo, hi = ap->ph_hi;
    XcdBarrier bar; bar.bar = ctl + CW_BAR; bar.x = 0; bar.st = lctl;
    if (hi - lo > 1) bar = xcd_barrier_post(ctl + CW_BAR, lctl);
#define IN(k) (lo <= (k) && (k) < hi)
#define SEAM(k) do { if (IN(k) && IN((k) + 1)) xcd_barrier(bar); } while (0)
#ifndef REPEAT_PH
#define REPEAT_PH -1
#endif
#ifndef REPEAT_N
#define REPEAT_N 2
#endif
#define NREP(k) ((REPEAT_PH == (k)) ? REPEAT_N : 1)
#define RSEAM(k, r, n) do { if ((r) + 1 < (n)) xcd_barrier(bar); else SEAM(k); } while (0)
    if (IN(0)) { for (int r = 0; r < NREP(0); ++r) { ph_prologue(ap, lds); RSEAM(0, r, NREP(0)); } }
    for (int l = 0; l < NL; ++l) {
        const int pb = 1 + 9 * l;
        if (IN(pb + 0)) { for (int r = 0; r < NREP(1); ++r) { ph_inproj(ap, lds, l); RSEAM(pb + 0, r, NREP(1)); } }
        if (IN(pb + 1)) { for (int r = 0; r < NREP(2); ++r) { ph_prep(ap, lds, l); RSEAM(pb + 1, r, NREP(2)); } }
        if (IN(pb + 2)) { for (int r = 0; r < NREP(3); ++r) { ph_idx(ap, lds, l, r); ph_attnA(ap, lds, l, r); RSEAM(pb + 2, r, NREP(3)); }
            if (REPEAT_PH == 31) { xcd_barrier(bar); ph_idx(ap, lds, l, 1); }
            if (REPEAT_PH == 32) { xcd_barrier(bar); ph_attnA(ap, lds, l, 1); } }
        if (IN(pb + 3)) { for (int r = 0; r < NREP(4); ++r) { ph_attnB<0>(ap, lds, l, r); ph_attnC(ap, lds, l, r); RSEAM(pb + 3, r, NREP(4)); }
            if (REPEAT_PH == 41) { xcd_barrier(bar); ph_attnB<DBG_VAR>(ap, lds, l, 1); xcd_barrier(bar); }
            if (REPEAT_PH == 42) { xcd_barrier(bar); ph_attnC(ap, lds, l, 1); } }
        if (IN(pb + 4)) { for (int r = 0; r < NREP(5); ++r) { ph_outproj(ap, lds, l); RSEAM(pb + 4, r, NREP(5)); } }
        if (IN(pb + 5)) { ph_router(ap, lds, l); SEAM(pb + 5); }
        if (IN(pb + 6)) { for (int r = 0; r < NREP(7); ++r) { ph_moe_up(ap, lds, l); if (l == 0 && r == 0) ph_deferred(ap, lds, 0); RSEAM(pb + 6, r, NREP(7)); } }
        if (IN(pb + 7)) { for (int r = 0; r < NREP(8); ++r) { ph_moe_down(ap, lds, l); RSEAM(pb + 7, r, NREP(8)); } }
        if (IN(pb + 8)) { for (int r = 0; r < NREP(9); ++r) { ph_combine(ap, lds, l); RSEAM(pb + 8, r, NREP(9)); } }
    }
#undef IN
#undef SEAM
}

extern "C" void kernel_launch(void* const* d_in, const int* in_sizes, int n_in, void* d_out, int out_size, void* d_ws, size_t ws_size, hipStream_t stream) {
    static int grid = 0;
    if (grid == 0) {
        if (n_in != 21 || out_size != NT * DM || ws_size < WS_END) { fprintf(stderr, "kernel_launch: unexpected problem (n_in %d, out %d, ws %zu < %zu)\n", n_in, out_size, ws_size, (size_t)WS_END); grid = -1; return; }
        int dev = 0, cus = 0, per_cu = 0;
        if (hipGetDevice(&dev) != hipSuccess || hipDeviceGetAttribute(&cus, hipDeviceAttributeMultiprocessorCount, dev) != hipSuccess) { grid = -1; return; }
        if (hipFuncSetAttribute((const void*)mk_fwd, hipFuncAttributeMaxDynamicSharedMemorySize, LDS_BYTES) != hipSuccess) { fprintf(stderr, "kernel_launch: hipFuncSetAttribute failed\n"); grid = -1; return; }
        if (hipOccupancyMaxActiveBlocksPerMultiprocessor(&per_cu, (const void*)mk_fwd, NTHR, LDS_BYTES) != hipSuccess || per_cu < 1) { fprintf(stderr, "kernel_launch: occupancy query says %d\n", per_cu); }
        (void)hipGetLastError();
        grid = cus;
    }
    if (grid < 0) return;
    (void)hipMemsetAsync((char*)d_ws + WS_CTL, 0, CTL_BYTES, stream);
    Args a{};
    for (int i = 0; i < 21; ++i) a.in[i] = (const float*)d_in[i];
    a.out = (float*)d_out; a.ws = (unsigned char*)d_ws;
#if MK_ONE_LAUNCH
    a.ph_lo = 0; a.ph_hi = N_PHASES;
    hipLaunchKernelGGL(mk_fwd, dim3(grid), dim3(NTHR), LDS_BYTES, stream, a);
#else
    for (int p = 0; p < N_PHASES; ++p) { a.ph_lo = p; a.ph_hi = p + 1; hipLaunchKernelGGL(mk_fwd, dim3(grid), dim3(NTHR), LDS_BYTES, stream, a); }
#endif
}
```

```cpp
#include <hip/hip_runtime.h>
#include <cstdio>
#include <cstdint>

#ifndef DBG_VAR
#define DBG_VAR 0
#endif
#ifndef REPEAT_PH
#define REPEAT_PH -1
#endif
#ifndef MK_ONE_LAUNCH
#define MK_ONE_LAUNCH 1
#endif

#define LAS __attribute__((address_space(3)))
typedef unsigned short bf16_t;
typedef short bf16x8 __attribute__((ext_vector_type(8)));
typedef float f32x4 __attribute__((ext_vector_type(4)));
typedef float f32x16 __attribute__((ext_vector_type(16)));
typedef unsigned u32x4 __attribute__((ext_vector_type(4)));
typedef unsigned u32x2 __attribute__((ext_vector_type(2)));

constexpr int NB = 4, SEQ = 2048, DM = 2048, NT = NB * SEQ, NL = 2;
constexpr int IN_DIM = 6224, NPAD = 6400;
constexpr int OQA = 0, OKA = 768, OVA = 1536, OQB = 2304, OKB = 2944, OVB = 3584, OQC = 4224, OKC = 4864, OVC = 4992, OQI = 5120, OKI = 6144, OWI = 6208;
constexpr int NE = 32, FF = 512;
constexpr int HROWS = 24576;
constexpr float EPS = 1e-6f;
constexpr float LOG2E = 1.4426950408889634f;
constexpr int NTHR = 512;

constexpr size_t WS_CTL = 0;
constexpr size_t CTL_BYTES = 131072;
constexpr size_t WS_WIN = WS_CTL + CTL_BYTES;
constexpr size_t WS_WINS = WS_WIN + (size_t)NL * NPAD * DM;
constexpr size_t WS_WOUT = WS_WIN + (size_t)NL * NPAD * DM * 2;
constexpr size_t WS_W1 = WS_WOUT + (size_t)NL * DM * DM * 2;
constexpr size_t WS_W1S = WS_W1 + (size_t)NL * NE * 1024 * DM;
constexpr size_t WS_WD = WS_W1 + (size_t)NL * NE * 1024 * DM * 2;
constexpr size_t WS_WR = WS_WD + (size_t)NL * NE * DM * FF * 2;
constexpr size_t WS_XB = WS_WR + (size_t)NL * 64 * DM * 4;
constexpr size_t WS_RSTD1 = WS_XB + (size_t)NT * DM * 2;
constexpr size_t WS_PROJ = WS_RSTD1 + (size_t)NT * 4;
constexpr size_t WS_Y = WS_PROJ;
constexpr size_t WS_QA = WS_PROJ + (size_t)NT * NPAD * 2;
constexpr size_t WS_KA = WS_QA + (size_t)NT * 768 * 2;
constexpr size_t WS_VAT = WS_KA + (size_t)NT * 768 * 2;
constexpr size_t WS_QB = WS_VAT + (size_t)NT * 768 * 2;
constexpr size_t WS_KB = WS_QB + (size_t)NT * 640 * 2;
constexpr size_t WS_VBT = WS_KB + (size_t)NT * 640 * 2;
constexpr size_t WS_KMEAN = WS_VBT + (size_t)NT * 640 * 2;
constexpr size_t WS_QC = WS_KMEAN + (size_t)NB * 5 * 8 * 128 * 4;
constexpr size_t WS_KC = WS_QC + (size_t)NT * 640 * 2;
constexpr size_t WS_VCT = WS_KC + (size_t)NT * 128 * 2;
constexpr size_t WS_QI = WS_VCT + (size_t)NT * 128 * 2;
constexpr size_t WS_KI = WS_QI + (size_t)NT * 1024 * 2;
constexpr size_t WS_WI = WS_KI + (size_t)NT * 64 * 2;
constexpr size_t WS_MASK = WS_WI + (size_t)NT * 16 * 4;
constexpr size_t WS_MIXO = WS_MASK + (size_t)NT * 64 * 4;
constexpr size_t WS_XM = WS_MIXO + (size_t)NT * DM * 2;
constexpr size_t WS_XMB = WS_XM + (size_t)NT * DM * 4;
constexpr size_t WS_TOKE = WS_XMB + (size_t)NT * DM * 2;
constexpr size_t WS_TOKP = WS_TOKE + (size_t)NT * 2 * 4;
constexpr size_t WS_RSTD2 = WS_TOKP + (size_t)NT * 2 * 4;
constexpr size_t WS_LIST = WS_RSTD2 + (size_t)NT * 4;
constexpr size_t WS_LISTG = WS_LIST + (size_t)NE * NT * 4;
constexpr size_t WS_H = WS_LISTG + (size_t)NE * NT * 4;
constexpr size_t WS_X1 = WS_H + (size_t)HROWS * FF * 2;
constexpr size_t WS_END = WS_X1 + (size_t)NT * DM * 4;
static_assert((size_t)HROWS * DM * 2 <= (size_t)NT * NPAD * 2, "Y must fit in PROJ");

constexpr int CW_BAR = 0;
constexpr int CW_CNT = 4096;
constexpr int CW_CMAX = 8192;
constexpr int CW_Q = 4096 + 64;

constexpr int LDS_STAGE = 131072;
constexpr int LDS_CTL = LDS_STAGE;
constexpr int LDS_BYTES = 147456;

__device__ __forceinline__ float bf2f(bf16_t b) { return __uint_as_float(((unsigned)b) << 16); }
__device__ __forceinline__ float bflo(unsigned w) { return __uint_as_float(w << 16); }
__device__ __forceinline__ float bfhi(unsigned w) { return __uint_as_float(w & 0xffff0000u); }
typedef __bf16 bf16x2_t __attribute__((ext_vector_type(2)));
__device__ __forceinline__ unsigned cvt_pk(float lo, float hi) { bf16x2_t v = {(__bf16)lo, (__bf16)hi}; return __builtin_bit_cast(unsigned, v); }
__device__ __forceinline__ float pairmax(float x) { auto r = __builtin_amdgcn_permlane32_swap(__float_as_uint(x), __float_as_uint(x), false, false); return fmaxf(__uint_as_float(r[0]), __uint_as_float(r[1])); }
__device__ __forceinline__ float pairsum(float x) { auto r = __builtin_amdgcn_permlane32_swap(__float_as_uint(x), __float_as_uint(x), false, false); return __uint_as_float(r[0]) + __uint_as_float(r[1]); }
#define DPPF(x, ctrl) __int_as_float(__builtin_amdgcn_update_dpp(0, __float_as_int(x), (ctrl), 0xF, 0xF, true))
__device__ __forceinline__ float swap16f(float x, float& other) { auto r = __builtin_amdgcn_permlane16_swap(__float_as_uint(x), __float_as_uint(x), false, false); other = __uint_as_float(r[1]); return __uint_as_float(r[0]); }
__device__ __forceinline__ float swap32f(float x, float& other) { auto r = __builtin_amdgcn_permlane32_swap(__float_as_uint(x), __float_as_uint(x), false, false); other = __uint_as_float(r[1]); return __uint_as_float(r[0]); }
__device__ __forceinline__ float wave_sum(float x) {
    x += DPPF(x, 0xB1); x += DPPF(x, 0x4E); x += DPPF(x, 0x124); x += DPPF(x, 0x128);
    float o; x = swap16f(x, o) + o; x = swap32f(x, o) + o;
    return x;
}
__device__ __forceinline__ float wave_max(float x) {
    x = fmaxf(x, DPPF(x, 0xB1)); x = fmaxf(x, DPPF(x, 0x4E)); x = fmaxf(x, DPPF(x, 0x124)); x = fmaxf(x, DPPF(x, 0x128));
    float o; x = swap16f(x, o); x = fmaxf(x, o); x = swap32f(x, o); x = fmaxf(x, o);
    return x;
}
typedef int i32x4 __attribute__((ext_vector_type(4)));
__device__ __forceinline__ unsigned q8_pack(float a, float b, float c, float d) {
    const int ia = (int)__builtin_rintf(a), ib = (int)__builtin_rintf(b), ic = (int)__builtin_rintf(c), id = (int)__builtin_rintf(d);
    return ((unsigned)ia & 255u) | (((unsigned)ib & 255u) << 8) | (((unsigned)ic & 255u) << 16) | ((unsigned)id << 24);
}
__device__ __forceinline__ LAS unsigned char* llds(LAS unsigned char* p) { unsigned v = (unsigned)(size_t)p; asm volatile("" : "+s"(v)); return (LAS unsigned char*)(size_t)v; }
constexpr int LDS_WTAB = 131072 + 1024;
__device__ __forceinline__ unsigned hw_slot() { return (unsigned)__builtin_amdgcn_s_getreg(((6 - 1) << 11) | 4) & 63u; }
__device__ __forceinline__ int ltid() {
    const int w = *(volatile LAS int*)(size_t)(LDS_WTAB + hw_slot() * 4);
    unsigned z = 0u; asm volatile("" : "+v"(z));
    int t = w * 64 + (int)__builtin_amdgcn_mbcnt_hi(~0u, __builtin_amdgcn_mbcnt_lo(~0u, z));
    asm volatile("" : "+v"(t)); return t;
}
__device__ __forceinline__ int half_sum_i32(int v) {
    v += __builtin_amdgcn_update_dpp(0, v, 0xB1, 0xF, 0xF, true);
    v += __builtin_amdgcn_update_dpp(0, v, 0x4E, 0xF, 0xF, true);
    v += __builtin_amdgcn_update_dpp(0, v, 0x141, 0xF, 0xF, true);
    v += __builtin_amdgcn_update_dpp(0, v, 0x140, 0xF, 0xF, true);
    { auto r = __builtin_amdgcn_permlane16_swap((unsigned)v, (unsigned)v, false, false); v = (int)r[0] + (int)r[1]; }
    return v;
}
__device__ __forceinline__ unsigned ld_agent(const unsigned* p) { return __hip_atomic_load(p, __ATOMIC_RELAXED, __HIP_MEMORY_SCOPE_AGENT); }

#define XB_TMO      128
#define XB_XCNT(j)  (256  + 64 * (j))
#define XB_XSUB(j)  (1280 + 64 * (j))
#define XB_XGEN(j)  (2304 + 64 * (j))
#define XB_TOP      3328
#define XB_TOPGEN   3392
#define XCD_BAR_WORDS 3456
#define XB_SPIN_CAP (1u << 22)

__device__ __forceinline__ unsigned xb_ld(unsigned* p)              { return __hip_atomic_load(p, __ATOMIC_RELAXED, __HIP_MEMORY_SCOPE_AGENT); }
__device__ __forceinline__ unsigned xb_add(unsigned* p, unsigned v) { return __hip_atomic_fetch_add(p, v, __ATOMIC_RELAXED, __HIP_MEMORY_SCOPE_AGENT); }
__device__ __forceinline__ unsigned xb_xcc_id() { return (unsigned)__builtin_amdgcn_s_getreg((3 << 11) | 20) & 0xFu; }
#define XB_SPIN(cond, bar) do { unsigned _sp = 0; while (cond) { __builtin_amdgcn_s_sleep(1); \
    if ((++_sp & 255u) == 0u) { if (xb_ld(&(bar)[XB_TMO])) break; if (_sp > XB_SPIN_CAP) { atomicAdd(&(bar)[XB_TMO], 1u); break; } } } } while (0)

struct XcdBarrier { unsigned* bar; unsigned x; volatile LAS unsigned* st; };

__device__ __forceinline__ XcdBarrier xcd_barrier_post(unsigned* bar, volatile LAS unsigned* st) {
    XcdBarrier b; b.bar = bar; b.x = xb_xcc_id(); b.st = st;
    if (ltid() == 0) (void)xb_add(&bar[XB_XCNT(b.x)], 1u);
    return b;
}
__device__ __forceinline__ void xcd_barrier_complete(unsigned* bar, unsigned x, unsigned& nloc, unsigned& nx) {
    const unsigned G = gridDim.x * gridDim.y * gridDim.z;
    unsigned sum, cnt, mine, sp = 0u;
    for (;;) {
        sum = 0u; cnt = 0u; mine = 0u;
#pragma unroll
        for (unsigned j = 0; j < 16; ++j) { const unsigned c = xb_ld(&bar[XB_XCNT(j)]); sum += c; cnt += (c > 0u) ? 1u : 0u; mine = (j == x) ? c : mine; }
        if (sum == G) break;
        __builtin_amdgcn_s_sleep(1);
        if ((++sp & 255u) == 0u) { if (xb_ld(&bar[XB_TMO])) break; if (sp > XB_SPIN_CAP) { atomicAdd(&bar[XB_TMO], 1u); break; } }
    }
    nloc = mine > 0u ? mine : 1u; nx = cnt > 0u ? cnt : 1u;
}
__device__ __forceinline__ void xcd_barrier(const XcdBarrier& b) {
    asm volatile("s_waitcnt vmcnt(0)" ::: "memory");
    __syncthreads();
    if (ltid() == 0) {
        unsigned* bar = b.bar;
        __builtin_amdgcn_s_waitcnt(0);
        unsigned nloc = b.st[0], nx = b.st[1];
        if (nloc == 0u) { xcd_barrier_complete(bar, b.x, nloc, nx); b.st[0] = nloc; b.st[1] = nx; }
        const unsigned old = xb_add(&bar[XB_XSUB(b.x)], 1u);
        const unsigned gen = old / nloc;
        if (old + 1u == (gen + 1u) * nloc) {
            __builtin_amdgcn_fence(__ATOMIC_RELEASE, "agent");
            asm volatile("s_waitcnt vmcnt(0)" ::: "memory");
            const unsigned og = xb_add(&bar[XB_TOP], 1u);
            const unsigned tg = og / nx;
            if (og + 1u == (tg + 1u) * nx) xb_add(&bar[XB_TOPGEN], 1u);
            else XB_SPIN(xb_ld(&bar[XB_TOPGEN]) == tg, bar);
            __builtin_amdgcn_fence(__ATOMIC_ACQUIRE, "agent");
            xb_add(&bar[XB_XGEN(b.x)], 1u);
            asm volatile("s_waitcnt vmcnt(0)" ::: "memory");
        } else {
            XB_SPIN(xb_ld(&bar[XB_XGEN(b.x)]) == gen, bar);
            __builtin_amdgcn_fence(__ATOMIC_ACQUIRE, "agent");
            asm volatile("s_waitcnt vmcnt(0)" ::: "memory");
        }
    }
    __syncthreads();
}

struct Args { const float* in[21]; float* out; unsigned char* ws; int ph_lo, ph_hi; };
enum { I_X = 0, I_N1G, I_WIN, I_AQN, I_AKN, I_ALAM, I_ASUB, I_BQN, I_BKN, I_CQN, I_CKN, I_IKN, I_WOUT, I_N2G, I_WGRP, I_BGRP, I_WEXP, I_BEXP, I_WGATE, I_WUP, I_WDOWN };

__device__ __forceinline__ int next_unit(unsigned* ctr, volatile LAS int* slot) {
    __syncthreads();
    if (ltid() == 0) *slot = (int)atomicAdd(ctr, 1u);
    __syncthreads();
    return *slot;
}

namespace pg8 {
constexpr int BM = 256, BK = 64, HALF = 128, HTB = HALF * BK * 2, STAGE_BYTES = 8 * HTB;
__device__ __forceinline__ int lds_byte(int r, int c) { const int st = (r >> 4) * 2 + (c >> 5), rr = r & 15, cc = c & 31, ob = rr * 64 + cc * 2; return st * 1024 + (ob ^ (((ob >> 9) & 1) << 5)); }
__device__ __forceinline__ void stage_rc(int b, int& R, int& C) { const int st = b / 1024, sb = b % 1024, swz = sb ^ (((sb >> 9) & 1) << 5); R = (st >> 1) * 16 + swz / 64; C = (st & 1) * 32 + (swz % 64) / 2; }

__device__ __forceinline__ int perm32(int rho) { const int n = rho >> 4, i = rho & 15; return 8 * (i >> 2) + 4 * n + (i & 3); }
struct Unit { const char* a; const char* b; int m0, n0, e, cnt; };

template <bool I8> struct Mma1;
template <> struct Mma1<false> { static __device__ __forceinline__ f32x4 f(bf16x8 b, bf16x8 a, f32x4 c) { return __builtin_amdgcn_mfma_f32_16x16x32_bf16(b, a, c, 0, 0, 0); } };
template <> struct Mma1<true> { static __device__ __forceinline__ f32x4 f(bf16x8 b, bf16x8 a, f32x4 c) {
    return __builtin_bit_cast(f32x4, __builtin_amdgcn_mfma_i32_16x16x64_i8(__builtin_bit_cast(i32x4, b), __builtin_bit_cast(i32x4, a), __builtin_bit_cast(i32x4, c), 0, 0, 0)); } };
template <class Epi, class Sched>
__device__ __forceinline__ void gemm_phase(LAS unsigned char* lds, const int K, const Sched& S, const Epi& E) {
    const int tid = ltid(), wid = __builtin_amdgcn_readfirstlane(tid >> 6), lane = tid & 63, wr = wid >> 2, wc = wid & 3, fr = lane & 15, fq = lane >> 4;
    const int nt = K / BK;
    int Rst[2], Cst[2]; unsigned voffB[2];
#pragma unroll
    for (int i = 0; i < 2; ++i) { int R, C; stage_rc(tid * 16 + i * 8192, R, C); Rst[i] = R; Cst[i] = C; const int Rb = Epi::PERM ? ((R & ~31) + perm32(R & 31)) : R; voffB[i] = (unsigned)(Rb * K + C) * 2u; }
    const size_t kstep = (size_t)(BK * 2);
    const size_t hstep = (size_t)HALF * K * 2;
    const unsigned ldsw = (unsigned)wid * 1024u;
    const int aoff = lds_byte(wr * 64 + fr, fq * 8), boff = lds_byte(wc * 32 + fr, fq * 8);
#define PG8_SA(b, h) (((b) * 2 + (h)) * HTB)
#define PG8_SB(b, h) ((4 + (b) * 2 + (h)) * HTB)
#define PG8_STAGE2(bufoff, gbase, o0, o1) do { \
        __builtin_amdgcn_global_load_lds((const unsigned*)((const char*)(gbase) + (o0)), (LAS unsigned*)(lds + (bufoff) + ldsw), 16, 0, 0); \
        __builtin_amdgcn_global_load_lds((const unsigned*)((const char*)(gbase) + (o1)), (LAS unsigned*)(lds + (bufoff) + ldsw + 8192), 16, 0, 0); } while (0)
#define PG8_STAGEB(bufoff, gbase) PG8_STAGE2(bufoff, gbase, voffB[0], voffB[1])
#define PG8_LDA(dst, b, h) do { _Pragma("unroll") for (int m = 0; m < 4; ++m) _Pragma("unroll") for (int k = 0; k < 2; ++k) dst[m][k] = *(const LAS bf16x8*)(lds + PG8_SA(b, h) + aoff + m * 2048 + k * 1024); } while (0)
#define PG8_LDB(dst, b, h) do { _Pragma("unroll") for (int n = 0; n < 2; ++n) _Pragma("unroll") for (int k = 0; k < 2; ++k) dst[n][k] = *(const LAS bf16x8*)(lds + PG8_SB(b, h) + boff + n * 2048 + k * 1024); } while (0)
#define PG8_MMA(ai, bj, At, Bt) do { __builtin_amdgcn_s_setprio(1); _Pragma("unroll") for (int m = 0; m < 4; ++m) _Pragma("unroll") for (int n = 0; n < 2; ++n) _Pragma("unroll") for (int k = 0; k < 2; ++k) \
        acc[ai][bj][m][n] = Mma1<Epi::I8>::f(Bt[n][k], At[m][k], acc[ai][bj][m][n]); __builtin_amdgcn_s_setprio(0); } while (0)
#define PG8_WAIT_V(n) asm volatile("s_waitcnt vmcnt(" #n ")" ::: "memory")
#define PG8_WAIT_L(n) asm volatile("s_waitcnt lgkmcnt(" #n ")" ::: "memory")
#define PG8_BAR __builtin_amdgcn_s_barrier()
#define PG8_SCHED __builtin_amdgcn_sched_barrier(0)
    Unit cur, nxt; int ui = 0;
    if (!S.next(0, cur)) return;
    f32x4 acc[2][2][4][2];
#pragma unroll
    for (int a = 0; a < 2; ++a)
#pragma unroll
        for (int b = 0; b < 2; ++b)
#pragma unroll
            for (int m = 0; m < 4; ++m)
#pragma unroll
                for (int n = 0; n < 2; ++n) acc[a][b][m][n] = (f32x4){0.f, 0.f, 0.f, 0.f};
    bf16x8 At[4][2], B0[2][2], B1[2][2];
    unsigned c00, c01, c10, c11, n00, n01, n10, n11;
    c00 = S.arow(cur, Rst[0]) + Cst[0] * 2; c01 = S.arow(cur, Rst[1]) + Cst[1] * 2; c10 = S.arow(cur, 128 + Rst[0]) + Cst[0] * 2; c11 = S.arow(cur, 128 + Rst[1]) + Cst[1] * 2;
    const char* cA = cur.a; const char* cB = cur.b;
    PG8_STAGEB(PG8_SB(0, 0), cB); PG8_STAGE2(PG8_SA(0, 0), cA, c00, c01); PG8_STAGEB(PG8_SB(0, 1), cB + hstep); PG8_STAGE2(PG8_SA(0, 1), cA, c10, c11);
    if (wr == 1) PG8_BAR;
    PG8_WAIT_V(4); PG8_BAR;
    PG8_STAGEB(PG8_SB(1, 0), cB + kstep); PG8_STAGE2(PG8_SA(1, 0), cA + kstep, c00, c01); PG8_STAGEB(PG8_SB(1, 1), cB + hstep + kstep);
    PG8_WAIT_V(6); PG8_BAR;
    for (;;) {
        const bool has_next = S.next(ui + 1, nxt);
        const char* nA = cA; const char* nB = cB; n00 = c00; n01 = c01; n10 = c10; n11 = c11;
        if (has_next) { nA = nxt.a; nB = nxt.b;
            n00 = S.arow(nxt, Rst[0]) + Cst[0] * 2; n01 = S.arow(nxt, Rst[1]) + Cst[1] * 2; n10 = S.arow(nxt, 128 + Rst[0]) + Cst[0] * 2; n11 = S.arow(nxt, 128 + Rst[1]) + Cst[1] * 2; }
        for (int t = 0; t < nt; t += 2) {
            const bool last = (t == nt - 2);
            const char* a1 = cA + (size_t)(t + 1) * kstep;
            const char* a2 = last ? nA : cA + (size_t)(t + 2) * kstep; const char* b2 = last ? nB : cB + (size_t)(t + 2) * kstep;
            const char* a3 = a2 + kstep; const char* b3 = b2 + kstep;
            const unsigned o00 = last ? n00 : c00, o01 = last ? n01 : c01, o10 = last ? n10 : c10, o11 = last ? n11 : c11;
            PG8_LDB(B0, 0, 0); PG8_SCHED; PG8_LDA(At, 0, 0); PG8_STAGE2(PG8_SA(1, 1), a1, c10, c11);
            PG8_WAIT_L(8); PG8_BAR; PG8_WAIT_L(0); PG8_MMA(0, 0, At, B0); PG8_BAR; PG8_SCHED;
            PG8_LDB(B1, 0, 1); PG8_STAGEB(PG8_SB(0, 0), b2);
            PG8_BAR; PG8_WAIT_L(0); PG8_MMA(0, 1, At, B1); PG8_BAR;
            PG8_LDA(At, 0, 1); PG8_STAGE2(PG8_SA(0, 0), a2, o00, o01);
            PG8_BAR; PG8_WAIT_L(0); PG8_MMA(1, 0, At, B0); PG8_BAR; PG8_SCHED;
            PG8_STAGEB(PG8_SB(0, 1), b2 + hstep);
            PG8_WAIT_V(6); PG8_BAR; PG8_MMA(1, 1, At, B1); PG8_BAR;
            PG8_LDB(B0, 1, 0); PG8_SCHED; PG8_LDA(At, 1, 0); PG8_STAGE2(PG8_SA(0, 1), a2, o10, o11);
            PG8_WAIT_L(8); PG8_BAR; PG8_WAIT_L(0); PG8_MMA(0, 0, At, B0); PG8_BAR; PG8_SCHED;
            PG8_LDB(B1, 1, 1); PG8_STAGEB(PG8_SB(1, 0), b3);
            PG8_BAR; PG8_WAIT_L(0); PG8_MMA(0, 1, At, B1); PG8_BAR;
            PG8_LDA(At, 1, 1); PG8_STAGE2(PG8_SA(1, 0), a3, o00, o01);
            PG8_BAR; PG8_WAIT_L(0); PG8_MMA(1, 0, At, B0); PG8_BAR; PG8_SCHED;
            PG8_STAGEB(PG8_SB(1, 1), b3 + hstep);
            PG8_WAIT_V(6); PG8_BAR; PG8_MMA(1, 1, At, B1); PG8_BAR;
        }
        E(acc, cur, wr, wc, fr, fq);
        if (!has_next) break;
#pragma unroll
        for (int a = 0; a < 2; ++a)
#pragma unroll
            for (int b = 0; b < 2; ++b)
#pragma unroll
                for (int m = 0; m < 4; ++m)
#pragma unroll
                    for (int n = 0; n < 2; ++n) acc[a][b][m][n] = (f32x4){0.f, 0.f, 0.f, 0.f};
        cur = nxt; cA = nA; cB = nB; c00 = n00; c01 = n01; c10 = n10; c11 = n11; ++ui;
    }
    PG8_WAIT_V(0);
    if (wr == 0) PG8_BAR;
    PG8_BAR;
#undef PG8_SA
#undef PG8_SB
#undef PG8_STAGE2
#undef PG8_STAGEB
#undef PG8_LDA
#undef PG8_LDB
#undef PG8_MMA
#undef PG8_WAIT_V
#undef PG8_WAIT_L
#undef PG8_BAR
#undef PG8_SCHED
}

struct DenseSched {
    const char* A; const char* Bt; int K, nM, nN, nwg, G, c;
    __device__ __forceinline__ void init(const void* A_, const void* Bt_, int M, int N, int K_, int G_, int c_) { A = (const char*)A_; Bt = (const char*)Bt_; K = K_; nM = M / BM; nN = N / BM; nwg = nM * nN; G = G_; c = c_; }
    __device__ __forceinline__ bool next(int i, Unit& u) const {
        const long L = (long)i * G + c; if (L >= nwg) return false;
        int wgid = (int)L; { const int q = nwg / 8, r = nwg % 8, xcd = wgid % 8, off = wgid / 8; wgid = (xcd < r ? xcd * (q + 1) : r * (q + 1) + (xcd - r) * q) + off; }
        const int nig = 8 * nN, gid = wgid / nig, fm = gid * 8, gsz = (nM - fm) < 8 ? (nM - fm) : 8;
        const int pm = fm + ((wgid % nig) % gsz), pn = (wgid % nig) / gsz;
        u.m0 = pm * BM; u.n0 = pn * BM; u.e = 0; u.cnt = 0;
        u.a = A + (size_t)u.m0 * K * 2; u.b = Bt + (size_t)u.n0 * K * 2; return true;
    }
    __device__ __forceinline__ unsigned arow(const Unit&, int r) const { return (unsigned)(r * K) * 2u; }
};

template <bool GATHER>
struct MoeSched {
    const char* A; const char* Bt; const int* list; volatile LAS int* tpre; volatile LAS int* cnt; int K, NPN, ntiles, G, c; size_t bstride;
    __device__ __forceinline__ bool next(int i, Unit& u) const {
        const long L = (long)i * G + c; if (L >= (long)ntiles * NPN) return false;
        const int mg = (int)(L / NPN), pn = (int)(L % NPN);
        int e = 0;
#pragma unroll 1
        for (int j = 1; j < NE; ++j) e = (tpre[j] <= mg) ? j : e;
        e = __builtin_amdgcn_readfirstlane(e);
        u.e = e; u.m0 = (mg - tpre[e]) * BM; u.cnt = cnt[e]; u.n0 = pn * BM;
        u.b = Bt + (size_t)e * bstride + (size_t)u.n0 * K * 2;
        if (GATHER) u.a = A; else u.a = A + (size_t)mg * BM * K * 2;
        return true;
    }
    __device__ __forceinline__ unsigned arow(const Unit& u, int r) const {
        if (GATHER) { int m = u.m0 + r; m = m < u.cnt ? m : u.m0; const int tok = list[(size_t)u.e * NT + m]; return (unsigned)(tok * K) * 2u; }
        return (unsigned)(r * K) * 2u;
    }
};
}

struct EpiProj {
    static constexpr bool PERM = true, I8 = true;
    bf16_t* out; const float* rstd; const float* csc;
    __device__ __forceinline__ void operator()(const f32x4 (&acc)[2][2][4][2], const pg8::Unit& u, int wr, int wc, int fr, int fq) const {
        float rs[2][4]; f32x4 cs[2][2];
#pragma unroll
        for (int ai = 0; ai < 2; ++ai)
#pragma unroll
            for (int m = 0; m < 4; ++m) rs[ai][m] = rstd[u.m0 + 128 * ai + 64 * wr + 16 * m + fr];
#pragma unroll
        for (int bj = 0; bj < 2; ++bj)
#pragma unroll
            for (int h = 0; h < 2; ++h) cs[bj][h] = *(const f32x4*)(csc + u.n0 + 128 * bj + 32 * wc + 8 * fq + 4 * h);
        __builtin_amdgcn_sched_barrier(0);
#pragma unroll
        for (int ai = 0; ai < 2; ++ai)
#pragma unroll
            for (int m = 0; m < 4; ++m) {
                const int row = u.m0 + 128 * ai + 64 * wr + 16 * m + fr;
                bf16_t* rp = out + (size_t)row * NPAD + u.n0 + 32 * wc + 8 * fq;
#pragma unroll
                for (int bj = 0; bj < 2; ++bj) { f32x4 v0, v1;
#pragma unroll
                    for (int j = 0; j < 4; ++j) { v0[j] = (float)__float_as_int(acc[ai][bj][m][0][j]) * rs[ai][m] * cs[bj][0][j]; v1[j] = (float)__float_as_int(acc[ai][bj][m][1][j]) * rs[ai][m] * cs[bj][1][j]; }
                    u32x4 w = {cvt_pk(v0[0], v0[1]), cvt_pk(v0[2], v0[3]), cvt_pk(v1[0], v1[1]), cvt_pk(v1[2], v1[3])}; *(u32x4*)(rp + 128 * bj) = w; }
            }
    }
};
struct EpiOut {
    static constexpr bool PERM = true, I8 = false;
    const bf16_t* xin; bf16_t* xm;
    __device__ __forceinline__ void operator()(const f32x4 (&acc)[2][2][4][2], const pg8::Unit& u, int wr, int wc, int fr, int fq) const {
#pragma unroll
        for (int ai = 0; ai < 2; ++ai) {
            u32x4 xw[4][2];
#pragma unroll
            for (int m = 0; m < 4; ++m) { const int row = u.m0 + 128 * ai + 64 * wr + 16 * m + fr; const size_t o = (size_t)row * DM + u.n0 + 32 * wc + 8 * fq;
#pragma unroll
                for (int bj = 0; bj < 2; ++bj) xw[m][bj] = *(const u32x4*)(xin + o + 128 * bj); }
            __builtin_amdgcn_sched_barrier(0);
#pragma unroll
            for (int m = 0; m < 4; ++m) { const int row = u.m0 + 128 * ai + 64 * wr + 16 * m + fr; const size_t o = (size_t)row * DM + u.n0 + 32 * wc + 8 * fq;
#pragma unroll
                for (int bj = 0; bj < 2; ++bj) { const size_t oo = o + 128 * bj; const u32x4 w = xw[m][bj];
                    const f32x4 v0 = acc[ai][bj][m][0] + (f32x4){bflo(w[0]), bfhi(w[0]), bflo(w[1]), bfhi(w[1])}, v1 = acc[ai][bj][m][1] + (f32x4){bflo(w[2]), bfhi(w[2]), bflo(w[3]), bfhi(w[3])};
                    u32x4 q = {cvt_pk(v0[0], v0[1]), cvt_pk(v0[2], v0[3]), cvt_pk(v1[0], v1[1]), cvt_pk(v1[2], v1[3])}; *(u32x4*)(xm + oo) = q; } }
            __builtin_amdgcn_sched_barrier(0);
        }
    }
};
struct EpiUp {
    static constexpr bool PERM = true, I8 = true;
    bf16_t* H; const int* list; const float* listg; const float* rstd2; volatile LAS int* tpre; const float* csc;
    __device__ __forceinline__ void operator()(const f32x4 (&acc)[2][2][4][2], const pg8::Unit& u, int wr, int wc, int fr_, int fq_) const {
        int fr = fr_, fq = fq_; asm volatile("" : "+v"(fr), "+v"(fq));
        const int rowbase = tpre[u.e] * 256;
        int tok[2][4]; float gv[2][4], rs[2][4]; f32x4 cg[2], cu[2];
#pragma unroll
        for (int ai = 0; ai < 2; ++ai)
#pragma unroll
            for (int m = 0; m < 4; ++m) { int mr = u.m0 + 128 * ai + 64 * wr + 16 * m + fr; mr = mr < u.cnt ? mr : u.m0; tok[ai][m] = list[(size_t)u.e * NT + mr]; gv[ai][m] = listg[(size_t)u.e * NT + mr]; }
#pragma unroll
        for (int n = 0; n < 2; ++n) { const float* cp = csc + (size_t)u.e * 1024 + u.n0 + 32 * wc + 8 * fq + 4 * n; cg[n] = *(const f32x4*)cp; cu[n] = *(const f32x4*)(cp + 128); }
        __builtin_amdgcn_sched_barrier(0);
#pragma unroll
        for (int ai = 0; ai < 2; ++ai)
#pragma unroll
            for (int m = 0; m < 4; ++m) rs[ai][m] = rstd2[tok[ai][m]];
        __builtin_amdgcn_sched_barrier(0);
#pragma unroll
        for (int ai = 0; ai < 2; ++ai)
#pragma unroll
            for (int m = 0; m < 4; ++m) {
                const int mr = u.m0 + 128 * ai + 64 * wr + 16 * m + fr;
                if (mr < u.cnt) {
                    bf16_t* rp = H + (size_t)(rowbase + mr) * FF + (u.n0 >> 1) + 32 * wc + 8 * fq;
                    float h[8];
#pragma unroll
                    for (int n = 0; n < 2; ++n) {
#pragma unroll
                        for (int j = 0; j < 4; ++j) { const float g = (float)__float_as_int(acc[ai][0][m][n][j]) * rs[ai][m] * cg[n][j], up = (float)__float_as_int(acc[ai][1][m][n][j]) * rs[ai][m] * cu[n][j];
                            const float sl = g / (1.f + __expf(-g)); h[4 * n + j] = sl * up * gv[ai][m]; } }
                    u32x4 w = {cvt_pk(h[0], h[1]), cvt_pk(h[2], h[3]), cvt_pk(h[4], h[5]), cvt_pk(h[6], h[7])}; *(u32x4*)rp = w;
                }
            }
    }
};
struct EpiDown {
    static constexpr bool PERM = true, I8 = false;
    bf16_t* Y; volatile LAS int* tpre;
    __device__ __forceinline__ void operator()(const f32x4 (&acc)[2][2][4][2], const pg8::Unit& u, int wr, int wc, int fr, int fq) const {
        const int rowbase = tpre[u.e] * 256;
#pragma unroll
        for (int ai = 0; ai < 2; ++ai)
#pragma unroll
            for (int m = 0; m < 4; ++m) {
                const int mr = u.m0 + 128 * ai + 64 * wr + 16 * m + fr;
                if (mr < u.cnt) {
                    bf16_t* rp = Y + (size_t)(rowbase + mr) * DM + u.n0 + 32 * wc + 8 * fq;
#pragma unroll
                    for (int bj = 0; bj < 2; ++bj) { const f32x4 v0 = acc[ai][bj][m][0], v1 = acc[ai][bj][m][1];
                        u32x4 w = {cvt_pk(v0[0], v0[1]), cvt_pk(v0[2], v0[3]), cvt_pk(v1[0], v1[1]), cvt_pk(v1[2], v1[3])}; *(u32x4*)(rp + 128 * bj) = w; }
                }
            }
    }
};

struct CvtJob { const float* src; const float* gain; bf16_t* dst; int ld, nvalid, k0, n0; size_t dst_ld, dst_row0; int kind; unsigned* cmax; };
constexpr int J_Q8 = NL * NE * 2 * 16 * 8 + NL * NE * 4 * 32 + NL * 16 * 100 + NL * 16 * 32;
__device__ __forceinline__ void cvt_decode(const Args& a, int job, CvtJob& J) {
    unsigned char* ws = a.ws;
    constexpr int J_W1 = NL * NE * 2 * 16 * 8, J_WD = NL * NE * 4 * 32, J_WIN = NL * 16 * 100;
    int j = job;
    J.kind = 0; J.cmax = nullptr;
    if (j >= J_Q8) {
        j -= J_Q8; const int nt = j % 100; j /= 100; const int kt = j & 15; const int l = j >> 4;
        J.src = a.in[I_WIN] + (size_t)l * DM * IN_DIM; J.gain = a.in[I_N1G] + l * DM; J.kind = 2; J.cmax = (unsigned*)(ws + WS_CTL) + CW_CMAX + l * NPAD + nt * 64;
        J.dst = (bf16_t*)(ws + WS_WIN + (size_t)l * NPAD * DM); J.ld = IN_DIM; J.nvalid = IN_DIM; J.k0 = kt * 128; J.n0 = nt * 64; J.dst_ld = DM; J.dst_row0 = (size_t)(nt * 64);
    } else if (j < J_W1) {
        const int nt = j & 7; j >>= 3; const int kt = j & 15; j >>= 4; const int which = j & 1; j >>= 1; const int e = j & 31; const int l = j >> 5;
        const int f0 = nt * 64;
        J.src = (which ? a.in[I_WUP] : a.in[I_WGATE]) + ((size_t)(l * NE + e)) * DM * FF; J.gain = a.in[I_N2G] + l * DM;
        J.dst = (bf16_t*)(ws + WS_W1) + ((size_t)(l * NE + e)) * 1024 * DM; J.ld = FF; J.nvalid = FF; J.k0 = kt * 128; J.n0 = f0; J.dst_ld = DM;
        J.dst_row0 = (size_t)((f0 >> 7) * 256 + which * 128 + (f0 & 127));
    } else if ((j -= J_W1) < J_WD) {
        const int nt = j & 31; j >>= 5; const int kt = j & 3; j >>= 2; const int e = j & 31; const int l = j >> 5;
        J.src = a.in[I_WDOWN] + ((size_t)(l * NE + e)) * FF * DM; J.gain = nullptr;
        J.dst = (bf16_t*)(ws + WS_WD) + ((size_t)(l * NE + e)) * DM * FF; J.ld = DM; J.nvalid = DM; J.k0 = kt * 128; J.n0 = nt * 64; J.dst_ld = FF; J.dst_row0 = (size_t)(nt * 64);
    } else if ((j -= J_WD) < J_WIN) {
        const int nt = j % 100; j /= 100; const int kt = j & 15; const int l = j >> 4;
        J.src = a.in[I_WIN] + (size_t)l * DM * IN_DIM; J.gain = a.in[I_N1G] + l * DM; J.kind = 1; J.cmax = (unsigned*)(ws + WS_CTL) + CW_CMAX + l * NPAD + nt * 64;
        J.dst = (bf16_t*)(ws + WS_WIN) + (size_t)l * NPAD * DM; J.ld = IN_DIM; J.nvalid = IN_DIM; J.k0 = kt * 128; J.n0 = nt * 64; J.dst_ld = DM; J.dst_row0 = (size_t)(nt * 64);
    } else {
        j -= J_WIN; const int nt = j & 31; j >>= 5; const int kt = j & 15; const int l = j >> 4;
        J.src = a.in[I_WOUT] + (size_t)l * DM * DM; J.gain = nullptr;
        J.dst = (bf16_t*)(ws + WS_WOUT) + (size_t)l * DM * DM; J.ld = DM; J.nvalid = DM; J.k0 = kt * 128; J.n0 = nt * 64; J.dst_ld = DM; J.dst_row0 = (size_t)(nt * 64);
    }
}
__device__ __forceinline__ void cvt_load(const CvtJob& J, int tid, f32x4 (&v)[4], float (&g)[4]) {
    const int kk = tid >> 4, nn = (tid & 15) * 4;
#pragma unroll
    for (int i = 0; i < 4; ++i) { const int k = J.k0 + kk + 32 * i;
        float z = 0.f; asm volatile("" : "+v"(z));
        v[i] = (f32x4){z, z, z, z};
        if (J.n0 + nn < J.nvalid) v[i] = __builtin_nontemporal_load((const f32x4*)(J.src + (size_t)k * J.ld + J.n0 + nn));
        g[i] = J.gain ? J.gain[k] : 1.f; }
}
__device__ __forceinline__ void cvt_store(LAS unsigned char* lds, const CvtJob& J, int tid, const f32x4 (&v)[4], const float (&g)[4]) {
    if (J.kind == 1) {
        LAS unsigned* cm = (LAS unsigned*)lds;
        if (tid < 64) cm[tid] = 0u;
        __syncthreads();
        { const int nn = (tid & 15) * 4; f32x4 m = {0.f, 0.f, 0.f, 0.f};
#pragma unroll
          for (int i = 0; i < 4; ++i) { const f32x4 x = v[i] * g[i];
#pragma unroll
              for (int j = 0; j < 4; ++j) m[j] = fmaxf(m[j], __builtin_fabsf(x[j])); }
#pragma unroll
          for (int j = 0; j < 4; ++j) atomicMax((unsigned*)(cm + nn + j), __float_as_uint(m[j])); }
        __syncthreads();
        if (tid < 64 && J.n0 + tid < J.nvalid) atomicMax(J.cmax + tid, cm[tid]);
        __syncthreads();
        return;
    }
    if (J.kind == 2) {
        LAS unsigned char* T8 = lds; constexpr int P8 = 144;
        { const int kk = tid >> 4, nn = (tid & 15) * 4;
          const u32x4 cb = *(const u32x4*)(J.cmax + nn); float inv[4];
#pragma unroll
          for (int j = 0; j < 4; ++j) { const float cmx = __uint_as_float(cb[j]); inv[j] = cmx > 0.f ? 127.f / cmx : 0.f; }
#pragma unroll
          for (int i = 0; i < 4; ++i) { const int k = kk + 32 * i; const f32x4 x = v[i] * g[i];
#pragma unroll
              for (int j = 0; j < 4; ++j) T8[(nn + j) * P8 + k] = (unsigned char)((int)__builtin_rintf(x[j] * inv[j]) & 255); } }
        __syncthreads();
        { const int n = tid >> 3, c = tid & 7;
          const u32x4 w = *(const LAS u32x4*)(T8 + n * P8 + c * 16);
          *(u32x4*)((unsigned char*)J.dst + (J.dst_row0 + n) * J.dst_ld + J.k0 + c * 16) = w; }
        __syncthreads();
        return;
    }
    LAS bf16_t* T = (LAS bf16_t*)lds;
    constexpr int P = 130;
    { const int kk = tid >> 4, nn = (tid & 15) * 4;
#pragma unroll
      for (int i = 0; i < 4; ++i) { const int k = kk + 32 * i; const f32x4 x = v[i] * g[i];
          const unsigned w0 = cvt_pk(x[0], x[1]), w1 = cvt_pk(x[2], x[3]);
          T[(nn + 0) * P + k] = (bf16_t)(w0 & 0xffffu); T[(nn + 1) * P + k] = (bf16_t)(w0 >> 16);
          T[(nn + 2) * P + k] = (bf16_t)(w1 & 0xffffu); T[(nn + 3) * P + k] = (bf16_t)(w1 >> 16); } }
    __syncthreads();
    { const int n = tid >> 4, kc = (tid & 15) * 8;
      const LAS unsigned* ra = (const LAS unsigned*)(T + n * P + kc); const LAS unsigned* rb = (const LAS unsigned*)(T + (n + 32) * P + kc);
      u32x4 a = {ra[0], ra[1], ra[2], ra[3]}, b = {rb[0], rb[1], rb[2], rb[3]};
      bf16_t* dp = J.dst + (J.dst_row0 + n) * J.dst_ld + J.k0 + kc;
      *(u32x4*)dp = a; *(u32x4*)(dp + 32 * J.dst_ld) = b; }
    __syncthreads();
}

constexpr int NSTRIP = NL * NE * 2 * 8, STRIP_PRO_L0 = NE * 2 * 8, STRIP_DEF_N = 400, STRIP_PRO_N = STRIP_PRO_L0 + (NSTRIP - STRIP_PRO_L0 - STRIP_DEF_N);
__device__ __forceinline__ int s8_addr(int r, int kb) { return r * 2048 + (kb ^ (((r >> 2) & 7) << 4)); }
__device__ __forceinline__ void cvt_strip(const Args& a, LAS unsigned char* lds, int sid) {
    unsigned char* ws = a.ws;
    const int tid = ltid();
    const float* src; const float* gain; int ld, ncols; unsigned char* dp0; float* sc0;
    if (sid < NSTRIP) { const int nt = sid & 7, which = (sid >> 3) & 1, e = (sid >> 4) & 31, l = sid >> 9, f0 = nt * 64;
        src = (which ? a.in[I_WUP] : a.in[I_WGATE]) + ((size_t)(l * NE + e)) * DM * FF + f0; gain = a.in[I_N2G] + l * DM; ld = FF; ncols = 64;
        const size_t orow = (size_t)(l * NE + e) * 1024 + (size_t)((f0 >> 7) * 256 + which * 128 + (f0 & 127));
        dp0 = ws + WS_W1 + orow * DM; sc0 = (float*)(ws + WS_W1S) + orow;
    } else { const int j = sid - NSTRIP, l = j / 100, nt = j - l * 100;
        src = a.in[I_WIN] + (size_t)l * DM * IN_DIM + nt * 64; gain = a.in[I_N1G] + l * DM; ld = IN_DIM; ncols = IN_DIM - nt * 64; ncols = ncols < 0 ? 0 : (ncols > 64 ? 64 : ncols);
        const size_t orow = (size_t)l * NPAD + nt * 64;
        dp0 = ws + WS_WIN + orow * DM; sc0 = (float*)(ws + WS_WINS) + orow; }
    unsigned lb = (unsigned)(size_t)lds; asm volatile("" : "+s"(lb));
    LAS unsigned char* S8 = (LAS unsigned char*)(size_t)lb;
    LAS float* lsc = (LAS float*)(S8 + LDS_CTL + 2048);
    LAS unsigned* cm = (LAS unsigned*)(S8 + LDS_CTL + 2048 + 4096);
    const int kk = tid >> 4, nn = (tid & 15) * 4;
    f32x4 v0[4], v1[4], g0, g1;
#define STRIP_LOAD(KT, V, GV) do { _Pragma("unroll") for (int i = 0; i < 4; ++i) { float z = 0.f; asm volatile("" : "+v"(z)); V[i] = (f32x4){z, z, z, z}; \
            if (nn < ncols) V[i] = __builtin_nontemporal_load((const f32x4*)(src + (size_t)((KT) * 128 + 4 * kk + i) * ld + nn)); } \
        GV = *(const f32x4*)(gain + (KT) * 128 + 4 * kk); } while (0)
#define STRIP_PROC(KT, V, GV) do { \
        if (tid < 64) cm[tid] = 0u; \
        __syncthreads(); \
        f32x4 x[4], m = {0.f, 0.f, 0.f, 0.f}; \
        _Pragma("unroll") for (int i = 0; i < 4; ++i) { x[i] = V[i] * GV[i]; _Pragma("unroll") for (int j = 0; j < 4; ++j) m[j] = fmaxf(m[j], __builtin_fabsf(x[i][j])); } \
        _Pragma("unroll") for (int j = 0; j < 4; ++j) atomicMax((unsigned*)(cm + nn + j), __float_as_uint(m[j])); \
        __syncthreads(); \
        _Pragma("unroll") for (int j = 0; j < 4; ++j) { const float cmx = __uint_as_float(cm[nn + j]); const float inv = cmx > 0.f ? 127.f / cmx : 0.f; \
            *(LAS unsigned*)(S8 + s8_addr(nn + j, (KT) * 128 + 4 * kk)) = q8_pack(x[0][j] * inv, x[1][j] * inv, x[2][j] * inv, x[3][j] * inv); } \
        if (tid < 64) lsc[(KT) * 64 + tid] = __uint_as_float(cm[tid]); \
        __syncthreads(); } while (0)
    STRIP_LOAD(0, v0, g0);
#pragma unroll 1
    for (int kt = 0; kt < 16; kt += 2) {
        STRIP_LOAD(kt + 1, v1, g1);
        STRIP_PROC(kt, v0, g0);
        if (kt + 2 < 16) STRIP_LOAD(kt + 2, v0, g0);
        STRIP_PROC(kt + 1, v1, g1);
    }
#undef STRIP_LOAD
#undef STRIP_PROC
    { const int n = tid >> 3, c = tid & 7;
      float gmax = 0.f;
#pragma unroll
      for (int kt = 0; kt < 16; ++kt) gmax = fmaxf(gmax, lsc[kt * 64 + n]);
      const float ig = gmax > 0.f ? 1.f / gmax : 0.f;
      unsigned char* dp = dp0 + (size_t)n * DM;
#pragma unroll 2
      for (int kt = 0; kt < 16; ++kt) { const float ratio = lsc[kt * 64 + n] * ig;
          const u32x4 w = *(const LAS u32x4*)(S8 + s8_addr(n, kt * 128 + c * 16)); u32x4 o;
#pragma unroll
          for (int d = 0; d < 4; ++d) { const unsigned wx = w[d] ^ 0x80808080u; const float off = -128.f * ratio;
              o[d] = q8_pack(fmaf((float)(wx & 255u), ratio, off), fmaf((float)((wx >> 8) & 255u), ratio, off), fmaf((float)((wx >> 16) & 255u), ratio, off), fmaf((float)(wx >> 24), ratio, off)); }
          *(u32x4*)(dp + kt * 128 + c * 16) = o; }
      if (c == 0) sc0[n] = gmax * (1.f / 127.f); }
    __syncthreads();
}

constexpr int DEF_LO = NE * 2 * 16 * 8, DEF_N = 6400, DEF_HI = DEF_LO + DEF_N;
constexpr int DEF_QUOTA = 32;
constexpr int DEF2_LO = NL * NE * 2 * 16 * 8 + NE * 4 * 32, DEF2_N = NE * 4 * 32, DEF2_HI = DEF2_LO + DEF2_N;
constexpr int DEF3_LO = NL * NE * 2 * 16 * 8 + NL * NE * 4 * 32 + 16 * 100, DEF3_A = 16 * 100, DEF3_GAP = 16 * 32, DEF3_N = DEF3_A + 16 * 32;
constexpr int DEF3_QUOTA = 13;
__device__ __forceinline__ int def_id(const int DLO, int job) {
    if (DLO != DEF3_LO) return DLO + job;
    return job < DEF3_A ? J_Q8 + DEF3_A + job : DLO + job + DEF3_GAP; }
__device__ __forceinline__ void cvt_deferred(const Args& a, LAS unsigned char* lds, int s_rank, int ns, const int DLO, const int DOFF, const int DN) {
    const int tid = ltid();
    CvtJob J0, J1; f32x4 v0[4], v1[4]; float g0[4], g1[4];
#pragma unroll
    for (int i = 0; i < 4; ++i) { v0[i] = (f32x4){0.f, 0.f, 0.f, 0.f}; v1[i] = v0[i]; g0[i] = 0.f; g1[i] = 0.f; }
    int job = s_rank;
    if (job < DN) { cvt_decode(a, def_id(DLO, DOFF + job), J0); cvt_load(J0, tid, v0, g0); }
    for (; job < DN; job += 2 * ns) {
        const bool h1 = (job + ns) < DN;
        if (h1) { cvt_decode(a, def_id(DLO, DOFF + job + ns), J1); cvt_load(J1, tid, v1, g1); }
        cvt_store(lds, J0, tid, v0, g0);
        const bool h2 = (job + 2 * ns) < DN;
        if (h2) { cvt_decode(a, def_id(DLO, DOFF + job + 2 * ns), J0); cvt_load(J0, tid, v0, g0); }
        if (h1) cvt_store(lds, J1, tid, v1, g1);
    }
}
__device__ __forceinline__ void p0_prologue(const Args& a, LAS unsigned char* lds) {
    unsigned char* ws = a.ws;
    const int G = gridDim.x, bx = blockIdx.x, tid = ltid();
    constexpr int J_ALL = NL * NE * 2 * 16 * 8 + NL * NE * 4 * 32 + NL * 16 * 100 + NL * 16 * 32;
    constexpr int P_WD0_LO = NL * NE * 2 * 16 * 8, P_WD0_N = NE * 4 * 32, P_REST_LO = P_WD0_LO + NL * NE * 4 * 32 + NL * 16 * 100, P_REST_N = 16 * 32;
    constexpr int J_RUN = P_WD0_N + P_REST_N;
#define PRO_ID(j) ((j) < P_WD0_N ? P_WD0_LO + (j) : P_REST_LO + ((j) - P_WD0_N))
    {
        constexpr int NSTRIPS_PRO = STRIP_PRO_N + 100, NHEAVY = NSTRIPS_PRO - 2 * 256, PRO_EXTRA = 16;
        static_assert(NHEAVY > 0 && NHEAVY < 256, "strip split assumes 256 workgroups, between two and three strips each");
        const bool light = (G == 256) && (bx >= NHEAVY); const int nlight = 256 - NHEAVY, xtra = (G == 256) ? nlight * PRO_EXTRA : 0;
#define PRO_IDX(v) (light ? ((v) < PRO_EXTRA ? (bx - NHEAVY) + nlight * (v) : xtra + bx + G * ((v) - PRO_EXTRA)) : xtra + bx + G * (v))
        CvtJob J0, J1; f32x4 v0[4], v1[4]; float g0[4], g1[4];
        int v = 0;
        if (PRO_IDX(0) < J_RUN) { cvt_decode(a, PRO_ID(PRO_IDX(0)), J0); cvt_load(J0, tid, v0, g0); }
        for (; PRO_IDX(v) < J_RUN; v += 2) {
            const bool h1 = PRO_IDX(v + 1) < J_RUN;
            if (h1) { cvt_decode(a, PRO_ID(PRO_IDX(v + 1)), J1); cvt_load(J1, tid, v1, g1); }
            cvt_store(lds, J0, tid, v0, g0);
            const bool h2 = PRO_IDX(v + 2) < J_RUN;
            if (h2) { cvt_decode(a, PRO_ID(PRO_IDX(v + 2)), J0); cvt_load(J0, tid, v0, g0); }
            if (h1) cvt_store(lds, J1, tid, v1, g1);
        }
#undef PRO_IDX
    }
#undef PRO_ID
    for (int i = bx; i < STRIP_PRO_N + 100; i += G) cvt_strip(a, lds, i < STRIP_PRO_L0 ? i : (i < STRIP_PRO_N ? i + STRIP_DEF_N : NSTRIP + (i - STRIP_PRO_N)));
    for (int i = bx * NTHR + tid; i < NL * 36 * DM; i += G * NTHR) {
        const int k = i % DM; const int jj = (i / DM) % 36; const int l = i / (DM * 36);
        const float g = a.in[I_N2G][l * DM + k];
        const float w = jj < 4 ? a.in[I_WGRP][((size_t)l * DM + k) * 4 + jj] : a.in[I_WEXP][((size_t)l * DM + k) * 32 + (jj - 4)];
        { const float gw = g * w; const bf16x2_t hb = {(__bf16)gw, (__bf16)0.f}; const float hf = __uint_as_float((__builtin_bit_cast(unsigned, hb) & 0xffffu) << 16);
          const bf16x2_t lb = {(__bf16)(gw - hf), (__bf16)0.f}; const size_t o = ((size_t)l * 64 + (jj < 4 ? 32 + jj : jj - 4)) * DM + k;
          ((bf16_t*)(ws + WS_WR))[o] = (bf16_t)(__builtin_bit_cast(unsigned, hb) & 0xffffu); ((bf16_t*)(ws + WS_WR) + (size_t)NL * 64 * DM)[o] = (bf16_t)(__builtin_bit_cast(unsigned, lb) & 0xffffu); }
    }
    { const int wave = tid >> 6, lane = tid & 63;
      for (int row = bx * 8 + wave; row < NT; row += G * 8) {
          const float* xp = a.in[I_X] + (size_t)row * DM; unsigned char* bp = ws + WS_XB + (size_t)row * DM; float ss = 0.f, mx = 0.f;
          f32x4 xv[8];
#pragma unroll
          for (int i = 0; i < 4; ++i) { xv[2 * i] = *(const f32x4*)(xp + i * 512 + lane * 8); xv[2 * i + 1] = *(const f32x4*)(xp + i * 512 + lane * 8 + 4); }
          __builtin_amdgcn_sched_barrier(0);
#pragma unroll
          for (int i = 0; i < 8; ++i) { const f32x4 v = xv[i]; ss += v[0] * v[0] + v[1] * v[1] + v[2] * v[2] + v[3] * v[3];
              mx = fmaxf(fmaxf(mx, fmaxf(__builtin_fabsf(v[0]), __builtin_fabsf(v[1]))), fmaxf(__builtin_fabsf(v[2]), __builtin_fabsf(v[3]))); }
          ss = wave_sum(ss); mx = wave_max(mx);
          const float inv = mx > 0.f ? 127.f / mx : 0.f;
#pragma unroll
          for (int i = 0; i < 4; ++i) { const f32x4 v0 = xv[2 * i], v1 = xv[2 * i + 1];
              u32x2 q = {q8_pack(v0[0] * inv, v0[1] * inv, v0[2] * inv, v0[3] * inv), q8_pack(v1[0] * inv, v1[1] * inv, v1[2] * inv, v1[3] * inv)}; *(u32x2*)(bp + i * 512 + lane * 8) = q;
              u32x4 w = {cvt_pk(v0[0], v0[1]), cvt_pk(v0[2], v0[3]), cvt_pk(v1[0], v1[1]), cvt_pk(v1[2], v1[3])}; *(u32x4*)((bf16_t*)(ws + WS_X1) + (size_t)row * DM + i * 512 + lane * 8) = w; }
          if (lane == 0) ((float*)(ws + WS_RSTD1))[row] = rsqrtf(ss * (1.f / DM) + EPS) * mx * (1.f / 127.f);
      } }
}

template <int HALFR>
__device__ __forceinline__ void rope_inplace(float* v, int pos) {
#pragma unroll
    for (int i = 0; i < HALFR; ++i) {
        const float inv = exp2f(-(float)(2 * i) / (float)(2 * HALFR) * 18.931568569324174f);
        const float ang = (float)pos * inv;
        float t = ang * 0.15915494309189535f; t -= rintf(t);
        const float s = __builtin_amdgcn_sinf(t), c = __builtin_amdgcn_cosf(t);
        const float x1 = v[i], x2 = v[i + HALFR];
        v[i] = x1 * c - x2 * s; v[i + HALFR] = x2 * c + x1 * s;
    }
}
__device__ __forceinline__ void load64(const bf16_t* p, float* v) {
#pragma unroll
    for (int i = 0; i < 8; ++i) { const u32x4 w = *(const u32x4*)(p + i * 8);
#pragma unroll
        for (int j = 0; j < 4; ++j) { v[i * 8 + 2 * j] = bflo(w[j]); v[i * 8 + 2 * j + 1] = bfhi(w[j]); } }
}
__device__ __forceinline__ void store64(bf16_t* p, const float* v) {
#pragma unroll
    for (int i = 0; i < 8; ++i) { u32x4 w;
#pragma unroll
        for (int j = 0; j < 4; ++j) w[j] = cvt_pk(v[i * 8 + 2 * j], v[i * 8 + 2 * j + 1]);
        *(u32x4*)(p + i * 8) = w; }
}

__device__ __forceinline__ void p2_prep(const Args& a, int l, LAS unsigned char* lds) {
    unsigned char* ws = a.ws;
    const int G = gridDim.x, bx = blockIdx.x, tid = ltid(), wave = tid >> 6, lane = tid & 63;
    const bf16_t* PROJ = (const bf16_t*)(ws + WS_PROJ);
    constexpr int NJOB = 49;
    for (int unit = bx; unit < 32 * NJOB; unit += G) {
        const int rb = unit / NJOB, job = unit % NJOB;
        const int b = rb >> 3, blk = rb & 7, s0 = blk * 256, tok0 = rb * 256;
        const bool is_v = (job >= 12 && job < 18) || (job >= 28 && job < 33) || job == 39;
        if (is_v) {
            int col0; bf16_t* dst;
            if (job < 18) { const int h = job - 12; col0 = OVA + h * 128; dst = (bf16_t*)(ws + WS_VAT) + ((size_t)(b * 6 + h) * 128) * SEQ; }
            else if (job < 33) { const int h = job - 28; col0 = OVB + h * 128; dst = (bf16_t*)(ws + WS_VBT) + ((size_t)(b * 5 + h) * 128) * SEQ; }
            else { col0 = OVC; dst = (bf16_t*)(ws + WS_VCT) + ((size_t)b * 128) * SEQ; }
            { const int c = tid & 15;
#pragma unroll
              for (int i = 0; i < 8; ++i) { const int t = (tid >> 4) + 32 * i;
                  const u32x4 w = *(const u32x4*)(PROJ + (size_t)(tok0 + t) * NPAD + col0 + c * 8);
                  *(LAS u32x4*)(lds + t * 256 + c * 16) = w; } }
            __syncthreads();
            {
              unsigned lo[16], hi[16];
#pragma unroll
              for (int i = 0; i < 16; ++i) {
                  const unsigned w0 = *(const LAS unsigned*)(lds + (wave * 32 + 2 * i) * 256 + lane * 4);
                  const unsigned w1 = *(const LAS unsigned*)(lds + (wave * 32 + 2 * i + 1) * 256 + lane * 4);
                  lo[i] = (w0 & 0xffffu) | (w1 << 16); hi[i] = (w0 >> 16) | (w1 & 0xffff0000u); }
              bf16_t* d0 = dst + (size_t)(2 * lane) * SEQ + s0 + wave * 32; bf16_t* d1 = d0 + SEQ;
#pragma unroll
              for (int i = 0; i < 4; ++i) { u32x4 x = {lo[4 * i], lo[4 * i + 1], lo[4 * i + 2], lo[4 * i + 3]}, y = {hi[4 * i], hi[4 * i + 1], hi[4 * i + 2], hi[4 * i + 3]};
                  *(u32x4*)(d0 + i * 8) = x; *(u32x4*)(d1 + i * 8) = y; } }
            __syncthreads();
        } else if (job != 48) {
            const int t = tid >> 1, half = tid & 1, pos = s0 + t;
            int col0, kind = 0, hh = 0, dstride = 128; bf16_t* drow; const float* gp = nullptr;
            bool isq = false;
            if (job < 12) { isq = job < 6; hh = isq ? job : job - 6; col0 = (isq ? OQA : OKA) + hh * 128; gp = isq ? a.in[I_AQN] : a.in[I_AKN]; drow = (bf16_t*)(ws + (isq ? WS_QA : WS_KA)) + ((size_t)(b * 6 + hh) * SEQ + s0) * 128; }
            else if (job < 23) { kind = 1; hh = job - 18; col0 = OQB + hh * 128; gp = a.in[I_BQN]; drow = (bf16_t*)(ws + WS_QB) + ((size_t)(b * 5 + hh) * SEQ + s0) * 128; isq = true; }
            else if (job < 28) { kind = 2; hh = job - 23; col0 = OKB + hh * 128; gp = a.in[I_BKN]; drow = (bf16_t*)(ws + WS_KB) + ((size_t)(b * 5 + hh) * SEQ + s0) * 128; }
            else if (job < 38) { kind = 1; hh = job - 33; col0 = OQC + hh * 128; gp = a.in[I_CQN]; drow = (bf16_t*)(ws + WS_QC) + ((size_t)(b * 5 + hh) * SEQ + s0) * 128; isq = true; }
            else if (job < 40) { kind = 3; col0 = OKC; gp = a.in[I_CKN]; drow = (bf16_t*)(ws + WS_KC) + ((size_t)b * SEQ + s0) * 128; }
            else { kind = 4; col0 = OQI + (job - 40) * 128; drow = (bf16_t*)(ws + WS_QI) + (size_t)tok0 * 1024 + (job - 40) * 128; dstride = 1024; }
            { const int c = tid & 15, r0 = tid >> 4; u32x4 w[8];
#pragma unroll
              for (int i = 0; i < 8; ++i) w[i] = *(const u32x4*)(PROJ + (size_t)(tok0 + r0 + 32 * i) * NPAD + col0 + c * 8);
              __builtin_amdgcn_sched_barrier(0);
#pragma unroll
              for (int i = 0; i < 8; ++i) *(LAS u32x4*)(lds + (r0 + 32 * i) * 272 + c * 16) = w[i]; }
            __syncthreads();
            LAS unsigned char* seg = lds + t * 272 + half * 128;
            float v[64];
#pragma unroll
            for (int i = 0; i < 8; ++i) { const u32x4 w = *(const LAS u32x4*)(seg + i * 16);
#pragma unroll
                for (int j = 0; j < 4; ++j) { v[i * 8 + 2 * j] = bflo(w[j]); v[i * 8 + 2 * j + 1] = bfhi(w[j]); } }
            if (kind == 0) {
                float ss = 0.f;
#pragma unroll
                for (int i = 0; i < 64; ++i) ss += v[i] * v[i];
                const float rs = rsqrtf(ss * (1.f / 64.f) + EPS);
                const float* g = gp + l * 64;
#pragma unroll
                for (int i = 0; i < 64; ++i) v[i] = v[i] * rs * g[i];
                rope_inplace<8>(v, pos);
                if (isq) {
#pragma unroll
                    for (int i = 0; i < 64; ++i) v[i] *= 0.125f * LOG2E;
                }
            } else if (kind < 4) {
                float ss = 0.f;
#pragma unroll
                for (int i = 0; i < 64; ++i) ss += v[i] * v[i];
                ss += DPPF(ss, 0xB1);
                const float rs = rsqrtf(ss * (1.f / 128.f) + EPS);
                const float* g = gp + l * 128 + half * 64;
#pragma unroll
                for (int i = 0; i < 64; ++i) v[i] = v[i] * rs * g[i];
                if (half == 0) rope_inplace<16>(v, pos);
                if (kind == 2) {
                    LAS float* red = (LAS float*)(lds + 73728);
#pragma unroll
                    for (int i = 0; i < 64; ++i) { float x = v[i];
                        x += __int_as_float(__builtin_amdgcn_update_dpp(0, __float_as_int(x), 0x4E, 0xF, 0xF, true));
                        x += __int_as_float(__builtin_amdgcn_update_dpp(0, __float_as_int(x), 0x124, 0xF, 0xF, true));
                        x += __int_as_float(__builtin_amdgcn_update_dpp(0, __float_as_int(x), 0x128, 0xF, 0xF, true));
                        if ((lane & 15) < 2) red[(wave * 4 + (lane >> 4)) * 128 + half * 64 + i] = x; }
                    __syncthreads();
                    if (tid < 128) { float sm = 0.f;
#pragma unroll
                        for (int w = 0; w < 32; ++w) sm += red[w * 128 + tid];
                        ((float*)(ws + WS_KMEAN))[((size_t)(b * 5 + hh) * 8 + blk) * 128 + tid] = sm * (1.f / 256.f); }
                }
                if (isq) {
#pragma unroll
                    for (int i = 0; i < 64; ++i) v[i] *= 0.08838834764831845f * LOG2E;
                }
            } else {
                rope_inplace<8>(v, pos);
            }
#pragma unroll
            for (int i = 0; i < 8; ++i) { u32x4 w;
#pragma unroll
                for (int j = 0; j < 4; ++j) w[j] = cvt_pk(v[i * 8 + 2 * j], v[i * 8 + 2 * j + 1]);
                *(LAS u32x4*)(seg + i * 16) = w; }
            __syncthreads();
            { const int c = tid & 15, r0 = tid >> 4; u32x4 w[8];
#pragma unroll
              for (int i = 0; i < 8; ++i) w[i] = *(const LAS u32x4*)(lds + (r0 + 32 * i) * 272 + c * 16);
#pragma unroll
              for (int i = 0; i < 8; ++i) *(u32x4*)(drow + (size_t)(r0 + 32 * i) * dstride + c * 8) = w[i]; }
            __syncthreads();
        } else {
            const int t = tid >> 1, half = tid & 1, tok = tok0 + t, pos = s0 + t;
            float v[64];
            if (half == 0) {
                load64(PROJ + (size_t)tok * NPAD + OKI, v);
                float ss = 0.f;
#pragma unroll
                for (int i = 0; i < 64; ++i) ss += v[i] * v[i];
                const float rs = rsqrtf(ss * (1.f / 64.f) + EPS);
                const float* g = a.in[I_IKN] + l * 64;
#pragma unroll
                for (int i = 0; i < 64; ++i) v[i] = v[i] * rs * g[i];
                rope_inplace<8>(v, pos);
                store64((bf16_t*)(ws + WS_KI) + (size_t)tok * 64, v);
            } else {
                const bf16_t* p = PROJ + (size_t)tok * NPAD + OWI; float* wo = (float*)(ws + WS_WI) + (size_t)tok * 16;
                const u32x4 w0 = *(const u32x4*)p, w1 = *(const u32x4*)(p + 8);
#pragma unroll
                for (int j = 0; j < 4; ++j) { wo[2 * j] = bflo(w0[j]) * 0.03125f; wo[2 * j + 1] = bfhi(w0[j]) * 0.03125f; wo[8 + 2 * j] = bflo(w1[j]) * 0.03125f; wo[8 + 2 * j + 1] = bfhi(w1[j]) * 0.03125f; }
            }
        }
    }
}

__device__ __forceinline__ unsigned f2key(float f) { const unsigned u = __float_as_uint(f); return (u & 0x80000000u) ? ~u : (u | 0x80000000u); }
__device__ __forceinline__ float key2f(unsigned k) { const unsigned u = (k & 0x80000000u) ? (k & 0x7fffffffu) : ~k; return __uint_as_float(u); }

constexpr int IX_P = 144, IX_BUF = 256 * IX_P;
__device__ __forceinline__ void idx_unit(const Args& a, int unit, LAS unsigned char* lds) {
    unsigned char* ws = a.ws;
    const int tid = ltid(), wave = tid >> 6, lane = tid & 63, l31 = lane & 31, hi = lane >> 5;
    const int qblk = (unit & 3) * 128 + (127 - (unit >> 2));
    const int tokb = qblk * 16, tok0 = tokb + wave * 2;
    const int b = tok0 >> 11, sa = tok0 & 2047;
    const int myq = sa + hi;
    const int nchunk = (((tokb & 2047) + 15) >> 8) + 1;
    const bf16_t* QI = (const bf16_t*)(ws + WS_QI); const bf16_t* KI = (const bf16_t*)(ws + WS_KI) + (size_t)b * SEQ * 64; const float* WI = (const float*)(ws + WS_WI);
    bf16x8 qf[4];
    { const int qloc = l31 >> 4, head = l31 & 15; const bf16_t* qp = QI + (size_t)(tok0 + qloc) * 1024 + head * 64 + 8 * hi;
#pragma unroll
      for (int ks = 0; ks < 4; ++ks) qf[ks] = *(const bf16x8*)(qp + ks * 16); }
    float wq[16];
    { const f32x4 a0 = *(const f32x4*)(WI + (size_t)tok0 * 16 + 4 * hi), a1 = *(const f32x4*)(WI + (size_t)tok0 * 16 + 8 + 4 * hi);
      const f32x4 b0 = *(const f32x4*)(WI + (size_t)(tok0 + 1) * 16 + 4 * hi), b1 = *(const f32x4*)(WI + (size_t)(tok0 + 1) * 16 + 8 + 4 * hi);
#pragma unroll
      for (int j = 0; j < 4; ++j) { wq[j] = 0.5f * a0[j]; wq[4 + j] = 0.5f * a1[j]; wq[8 + j] = 0.5f * b0[j]; wq[12 + j] = 0.5f * b1[j]; } }
    u32x4 st[4];
    const u32x4* gsrc = (const u32x4*)KI + tid;
    int ldst[4];
#pragma unroll
    for (int i = 0; i < 4; ++i) { const int p = tid + 512 * i; ldst[i] = (p >> 3) * IX_P + (p & 7) * 16; }
#pragma unroll
    for (int i = 0; i < 4; ++i) st[i] = gsrc[512 * i];
#pragma unroll
    for (int i = 0; i < 4; ++i) *(LAS u32x4*)(lds + ldst[i]) = st[i];
    __syncthreads();
    const int rdo = l31 * IX_P + 16 * hi;
    float sc[64];
#pragma unroll
    for (int c = 0; c < 8; ++c) {
        if (c < nchunk) {
            const bool more = (c + 1) < nchunk;
            if (more) {
#pragma unroll
                for (int i = 0; i < 4; ++i) st[i] = gsrc[(c + 1) * 2048 + 512 * i]; }
            const LAS unsigned char* B = lds + (c & 1) * IX_BUF + rdo;
#pragma unroll
            for (int tp = 0; tp < 8; tp += 2) {
                bf16x8 kf[2][4];
#pragma unroll
                for (int u = 0; u < 2; ++u)
#pragma unroll
                    for (int ks = 0; ks < 4; ++ks) kf[u][ks] = *(const LAS bf16x8*)(B + (tp + u) * 32 * IX_P + ks * 32);
                __builtin_amdgcn_sched_barrier(0);
                f32x16 acc0 = {0.f, 0.f, 0.f, 0.f, 0.f, 0.f, 0.f, 0.f, 0.f, 0.f, 0.f, 0.f, 0.f, 0.f, 0.f, 0.f}, acc1 = acc0;
#pragma unroll
                for (int ks = 0; ks < 4; ++ks) { acc0 = __builtin_amdgcn_mfma_f32_32x32x16_bf16(qf[ks], kf[0][ks], acc0, 0, 0, 0); acc1 = __builtin_amdgcn_mfma_f32_32x32x16_bf16(qf[ks], kf[1][ks], acc1, 0, 0, 0); }
                __builtin_amdgcn_sched_barrier(0);
#pragma unroll
                for (int u = 0; u < 2; ++u) { const int tt = tp + u;
                    float p0 = 0.f, p1 = 0.f;
#pragma unroll
                    for (int r = 0; r < 8; ++r) { const float x0 = u ? acc1[r] : acc0[r], x1 = u ? acc1[8 + r] : acc0[8 + r];
                        p0 = fmaf(wq[r], x0, p0); p0 = fmaf(wq[r], __builtin_fabsf(x0), p0); p1 = fmaf(wq[8 + r], x1, p1); p1 = fmaf(wq[8 + r], __builtin_fabsf(x1), p1); }
                    auto sw = __builtin_amdgcn_permlane32_swap(__float_as_uint(p0), __float_as_uint(p1), false, false);
                    const float s = __uint_as_float(sw[0]) + __uint_as_float(sw[1]);
                    const int key = (c * 8 + tt) * 32 + l31;
                    sc[c * 8 + tt] = (key <= myq) ? s : -INFINITY; }
            }
            if (more) {
#pragma unroll
                for (int i = 0; i < 4; ++i) *(LAS u32x4*)(lds + ((c + 1) & 1) * IX_BUF + ldst[i]) = st[i]; }
            __syncthreads();
        } else {
#pragma unroll
            for (int tt = 0; tt < 8; ++tt) sc[c * 8 + tt] = -INFINITY;
        }
    }
    float thr = -3.0e38f;
    const bool need = (myq + 1) > 256;
    if (__any(need)) {
        float vmin = 3.0e38f, vmax = -3.0e38f;
#pragma unroll
        for (int t = 0; t < 64; ++t) { vmax = fmaxf(vmax, sc[t]); vmin = fminf(vmin, (sc[t] == -INFINITY) ? 3.0e38f : sc[t]); }
        { vmax = fmaxf(vmax, DPPF(vmax, 0xB1)); vmax = fmaxf(vmax, DPPF(vmax, 0x4E)); vmax = fmaxf(vmax, DPPF(vmax, 0x124)); vmax = fmaxf(vmax, DPPF(vmax, 0x128));
          vmin = fminf(vmin, DPPF(vmin, 0xB1)); vmin = fminf(vmin, DPPF(vmin, 0x4E)); vmin = fminf(vmin, DPPF(vmin, 0x124)); vmin = fminf(vmin, DPPF(vmin, 0x128));
          float o; vmax = swap16f(vmax, o); vmax = fmaxf(vmax, o); vmin = swap16f(vmin, o); vmin = fminf(vmin, o); }
        float lo_v = vmin, hi_v = vmax; int c_lo = myq + 1, c_hi = 1;
        bool done = !need;
        for (int it = 0; it < 128; ++it) {
            const unsigned klo = f2key(lo_v), khi = f2key(hi_v);
            float t = lo_v + (hi_v - lo_v) * (((float)(c_lo - 256) + 0.5f) / (float)(c_lo - c_hi));
            if ((it % 3) == 2 || !(t > lo_v && t < hi_v)) t = key2f(klo + ((khi - klo) >> 1));
            if (c_lo == 256 || khi - klo <= 1u) done = true;
            if (__all(done)) break;
            unsigned n0 = 0u, n1 = 0u, n2 = 0u, n3 = 0u;
#pragma unroll
            for (int q = 0; q < 64; q += 4) { n0 += __float_as_uint(sc[q] - t) >> 31; n1 += __float_as_uint(sc[q + 1] - t) >> 31; n2 += __float_as_uint(sc[q + 2] - t) >> 31; n3 += __float_as_uint(sc[q + 3] - t) >> 31; }
            int c = 64 - (int)((n0 + n1) + (n2 + n3));
            c = half_sum_i32(c);
            if (!done) { if (c >= 256) { lo_v = t; c_lo = c; } else { hi_v = t; c_hi = c; } }
        }
        if (need) thr = lo_v;
    }
    unsigned mylo = 0u, myhi = 0u;
#pragma unroll
    for (int t = 0; t < 64; ++t) {
        const unsigned long long bal = __ballot(sc[t] >= thr);
        if (lane == t) { mylo = (unsigned)bal; myhi = (unsigned)(bal >> 32); }
    }
    unsigned* MASK = (unsigned*)(ws + WS_MASK);
    MASK[(size_t)tok0 * 64 + lane] = mylo;
    MASK[(size_t)(tok0 + 1) * 64 + lane] = myhi;
}

constexpr int AT_KP = 272, AT_VP = 144, AT_KB = 64 * AT_KP, AT_VB = 128 * AT_VP, AT_BUF = AT_KB + AT_VB;

__device__ __forceinline__ bf16x8 pack8(float a0, float a1, float a2, float a3, float a4, float a5, float a6, float a7) {
    u32x4 w = {cvt_pk(a0, a1), cvt_pk(a2, a3), cvt_pk(a4, a5), cvt_pk(a6, a7)}; return __builtin_bit_cast(bf16x8, w);
}

template <int KD, int MODE, int DBG = 0>
__device__ __forceinline__ void attn_core(LAS unsigned char* lds, const bf16_t* kg, const bf16_t* vtg, const int n_kt, const bf16_t* qrow, const int kcol0,
                                          const int qpos, const int wqmax, const unsigned selbits, const int own0, const unsigned* mrow, f32x16 (&o)[4], float& l_out) {
    const int tid = ltid(), lane = tid & 63, l31 = lane & 31, hi = lane >> 5;
    constexpr int NKS = KD / 16;
    bf16x8 qf[NKS];
#pragma unroll
    for (int ks = 0; ks < NKS; ++ks) qf[ks] = *(const bf16x8*)(qrow + kcol0 + ks * 16 + 8 * hi);
#pragma unroll
    for (int d = 0; d < 4; ++d)
#pragma unroll
        for (int r = 0; r < 16; ++r) o[d][r] = 0.f;
    float m = 0.f, l = 0.f; bool has = false;
    const int kc = tid & 15, kr = tid >> 4;
    const int vc = tid & 7, vd = tid >> 3;
    const bf16_t* kgp = kg + (size_t)kr * 128 + kc * 8;
    const bf16_t* vgp = vtg + (size_t)vd * SEQ + vc * 8;
    const int klo = kr * AT_KP + kc * 16, vlo = AT_KB + vd * AT_VP + vc * 16;
    const int kap = (l31 & 0x13) | ((l31 & 4) << 1) | ((l31 & 8) >> 1);
    const int kro = kap * AT_KP + (kcol0 + 8 * hi) * 2, vro = AT_KB + l31 * AT_VP + 16 * hi;
    u32x4 st0, st1, st2, st3;
    st0 = *(const u32x4*)(kgp); st1 = *(const u32x4*)(kgp + 32 * 128); st2 = *(const u32x4*)(vgp); st3 = *(const u32x4*)(vgp + 64 * SEQ);
    *(LAS u32x4*)(lds + klo) = st0; *(LAS u32x4*)(lds + klo + 32 * AT_KP) = st1; *(LAS u32x4*)(lds + vlo) = st2; *(LAS u32x4*)(lds + vlo + 64 * AT_VP) = st3;
    __syncthreads();
    u32x2 mw = {0u, 0u};
    if (MODE == 2) mw = *(const u32x2*)(mrow);
    const int grp = __builtin_amdgcn_readfirstlane(DBG == 17 ? ((tid >> 6) & 1) : DBG == 18 ? ((tid >> 7) & 1) : DBG == 19 ? 0 : (tid >> 8));
    bf16x8 pf[4];
    bool act_prev = false;
    int bcur = 0, bprev = 2, bnext = 1;
#define ATT_PV(BUFIDX) do { const LAS unsigned char* Bv = lds + (BUFIDX) * AT_BUF; \
        _Pragma("unroll") for (int k2 = 0; k2 < 4; k2 += 2) { bf16x8 vf[8]; \
            _Pragma("unroll") for (int kk = 0; kk < 2; ++kk) _Pragma("unroll") for (int d = 0; d < 4; ++d) vf[kk * 4 + d] = *(const LAS bf16x8*)(Bv + vro + d * 32 * AT_VP + (k2 + kk) * 32); \
            __builtin_amdgcn_sched_barrier(0); \
            _Pragma("unroll") for (int kk = 0; kk < 2; ++kk) _Pragma("unroll") for (int d = 0; d < 4; ++d) o[d] = __builtin_amdgcn_mfma_f32_32x32x16_bf16(vf[kk * 4 + d], pf[k2 + kk], o[d], 0, 0, 0); \
            __builtin_amdgcn_sched_barrier(0); } } while (0)
    for (int kt = 0; kt < n_kt; ++kt) {
        const bool more = (kt + 1) < n_kt;
        if (more && DBG != 2 && DBG != 3 && DBG != 11) { const bf16_t* kp = kgp + (size_t)(kt + 1) * 64 * 128; const bf16_t* vp = vgp + (kt + 1) * 64;
            st0 = *(const u32x4*)(kp); st1 = *(const u32x4*)(kp + 32 * 128); st2 = *(const u32x4*)(vp); st3 = *(const u32x4*)(vp + 64 * SEQ); }
        if (grp == 1 && act_prev && DBG != 5) ATT_PV(bprev);
        const int key0 = kt * 64;
        bool act = key0 <= wqmax;
        const bool past = (MODE == 1) && (key0 < own0);
        const bool selq = ((selbits >> (key0 >> 8)) & 1u) != 0u;
        if (MODE == 1 && past) act = __ballot(selq) != 0ull;
        u32x2 mwn = {0u, 0u};
        if (MODE == 2 && more) mwn = *(const u32x2*)(mrow + 2 * (kt + 1));
        if (act && DBG != 6) {
            const LAS unsigned char* B = lds + bcur * AT_BUF;
            f32x16 s0, s1;
#pragma unroll
            for (int r = 0; r < 16; ++r) { s0[r] = 0.f; s1[r] = 0.f; }
#pragma unroll
            for (int kb = 0; kb < (DBG == 8 ? 0 : NKS); kb += 4) {
                bf16x8 kf[8];
#pragma unroll
                for (int ks = 0; ks < 4; ++ks) { if (DBG == 14 || DBG == 16) { kf[2 * ks] = qf[ks]; kf[2 * ks + 1] = qf[ks + 4]; } else { kf[2 * ks] = *(const LAS bf16x8*)(B + kro + (kb + ks) * 32); kf[2 * ks + 1] = *(const LAS bf16x8*)(B + kro + 32 * AT_KP + (kb + ks) * 32); } }
                __builtin_amdgcn_sched_barrier(0); if (DBG == 12) __builtin_amdgcn_s_setprio(1);
#pragma unroll
                for (int ks = 0; ks < 4; ++ks) {
                    s0 = __builtin_amdgcn_mfma_f32_32x32x16_bf16(kf[2 * ks], qf[kb + ks], s0, 0, 0, 0);
                    s1 = __builtin_amdgcn_mfma_f32_32x32x16_bf16(kf[2 * ks + 1], qf[kb + ks], s1, 0, 0, 0);
                }
                if (DBG == 12) __builtin_amdgcn_s_setprio(0); __builtin_amdgcn_sched_barrier(0);
            }
            if (DBG != 9) {
            const bool diag = (MODE != 2) && !past && (key0 + 63 > wqmax - 31);
            if (diag) {
                const int d0 = qpos - key0 - 8 * hi;
#pragma unroll
                for (int r = 0; r < 16; ++r) { const int c = 16 * (r >> 3) + (r & 7);
                    s0[r] = (c <= d0) ? s0[r] : -3.0e38f; s1[r] = (c + 32 <= d0) ? s1[r] : -3.0e38f; }
            }
            float mx = fmaxf(s0[0], s1[0]);
            if (DBG != 7)
#pragma unroll
            for (int r = 1; r < 16; ++r) mx = fmaxf(mx, fmaxf(s0[r], s1[r]));
            mx = pairmax(mx);
            const bool needm = (mx > -1.0e30f) && (!has || (mx - m) > 12.f);
            if (__any(needm)) {
                const float mn = needm ? (has ? fmaxf(m, mx) : mx) : m;
                const float alpha = has ? __builtin_amdgcn_exp2f(m - mn) : 1.f;
                m = mn; has = has || needm; l *= alpha;
#pragma unroll
                for (int d = 0; d < 4; ++d)
#pragma unroll
                    for (int r = 0; r < 16; ++r) o[d][r] *= alpha;
            }
#pragma unroll
            for (int r = 0; r < 16; ++r) { if (DBG == 4) { s0[r] = s0[r] - m; s1[r] = s1[r] - m; } else { s0[r] = __builtin_amdgcn_exp2f(s0[r] - m); s1[r] = __builtin_amdgcn_exp2f(s1[r] - m); } }
            if (MODE == 2) {
                const int w0 = (int)(mw[0] >> (8 * hi)), w1 = (int)(mw[1] >> (8 * hi));
#pragma unroll
                for (int r = 0; r < 16; ++r) { const int c = 16 * (r >> 3) + (r & 7);
                    s0[r] = __uint_as_float(__float_as_uint(s0[r]) & (unsigned)__builtin_amdgcn_sbfe(w0, c, 1));
                    s1[r] = __uint_as_float(__float_as_uint(s1[r]) & (unsigned)__builtin_amdgcn_sbfe(w1, c, 1)); }
            } else if (MODE == 1 && past) {
                const unsigned km = selq ? 0xffffffffu : 0u;
#pragma unroll
                for (int r = 0; r < 16; ++r) { s0[r] = __uint_as_float(__float_as_uint(s0[r]) & km); s1[r] = __uint_as_float(__float_as_uint(s1[r]) & km); }
            }
            float ps = 0.f;
#pragma unroll
            for (int r = 0; r < 16; ++r) ps += s0[r] + s1[r];
            l += ps;
            } else l += 1.f;
            pf[0] = pack8(s0[0], s0[1], s0[2], s0[3], s0[4], s0[5], s0[6], s0[7]);
            pf[1] = pack8(s0[8], s0[9], s0[10], s0[11], s0[12], s0[13], s0[14], s0[15]);
            pf[2] = pack8(s1[0], s1[1], s1[2], s1[3], s1[4], s1[5], s1[6], s1[7]);
            pf[3] = pack8(s1[8], s1[9], s1[10], s1[11], s1[12], s1[13], s1[14], s1[15]);
            if (grp == 0 && DBG != 5) ATT_PV(bcur);
        }
        act_prev = act;
        if (MODE == 2) mw = mwn;
        if (more && DBG != 3 && DBG != 11) { LAS unsigned char* Bn = lds + bnext * AT_BUF;
            *(LAS u32x4*)(Bn + klo) = st0; *(LAS u32x4*)(Bn + klo + 32 * AT_KP) = st1; *(LAS u32x4*)(Bn + vlo) = st2; *(LAS u32x4*)(Bn + vlo + 64 * AT_VP) = st3; }
        { const int t = bprev; bprev = bcur; bcur = bnext; bnext = t; }
        if (DBG != 11) __syncthreads();
    }
    if (grp == 1 && act_prev) ATT_PV(bprev);
#undef ATT_PV
    __syncthreads();
    l_out = pairsum(l);
}

__device__ __forceinline__ void store_o(LAS unsigned char* img, bf16_t* out0, const f32x16 (&o)[4], float scale, int lane) {
    const int l31 = lane & 31, hi = lane >> 5;
#pragma unroll
    for (int d = 0; d < 4; ++d)
#pragma unroll
        for (int g = 0; g < 4; ++g) {
            u32x2 w = {cvt_pk(o[d][4 * g] * scale, o[d][4 * g + 1] * scale), cvt_pk(o[d][4 * g + 2] * scale, o[d][4 * g + 3] * scale)};
            *(LAS u32x2*)(img + l31 * 272 + (d * 32 + 8 * g + 4 * hi) * 2) = w;
        }
    const int r0 = lane >> 4, c = lane & 15;
    u32x4 v[8];
#pragma unroll
    for (int i = 0; i < 8; ++i) v[i] = *(const LAS u32x4*)(img + (r0 + 4 * i) * 272 + c * 16);
#pragma unroll
    for (int i = 0; i < 8; ++i) *(u32x4*)(out0 + (size_t)(r0 + 4 * i) * DM + c * 8) = v[i];
}

__device__ __forceinline__ void attnA_unit(const Args& a, int l, int unit, LAS unsigned char* lds) {
    unsigned char* ws = a.ws;
    const int tid = ltid(), wave = tid >> 6, lane = tid & 63, l31 = lane & 31, hi = lane >> 5;
    const int qt = 15 - unit / 24, bh = unit % 24, b = bh / 6, h = bh % 6, q0 = qt * 128;
    const int comp = wave >> 2, wq0 = q0 + (wave & 3) * 32, qpos = wq0 + l31;
    const bf16_t* kg = (const bf16_t*)(ws + WS_KA) + (size_t)(b * 6 + h) * SEQ * 128;
    const bf16_t* vtg = (const bf16_t*)(ws + WS_VAT) + (size_t)(b * 6 + h) * 128 * SEQ;
    const bf16_t* qrow = (const bf16_t*)(ws + WS_QA) + ((size_t)(b * 6 + h) * SEQ + qpos) * 128;
    f32x16 o[4]; float lsum;
    attn_core<64, 0>(lds, kg, vtg, (q0 + 128) / 64, qrow, comp * 64, qpos, wq0 + 31, 0u, 0, nullptr, o, lsum);
    const float inv = 1.f / lsum;
    LAS float* xp = (LAS float*)lds + (wave & 3) * 4096 + lane;
    if (comp == 1) {
#pragma unroll
        for (int d = 0; d < 4; ++d)
#pragma unroll
            for (int r = 0; r < 16; ++r) xp[(d * 16 + r) * 64] = o[d][r] * inv;
    }
    __syncthreads();
    if (comp == 0) {
        const float* lp = a.in[I_ALAM] + l * 256;
        const float s01 = wave_sum(lp[lane] * lp[64 + lane]), s23 = wave_sum(lp[128 + lane] * lp[192 + lane]);
        const float lam_init = 0.8f - 0.6f * __expf(-0.3f * (float)l);
        const float lam = __expf(s01) - __expf(s23) + lam_init;
        float ss = 0.f;
#pragma unroll
        for (int d = 0; d < 4; ++d) {
            asm volatile("" ::: "memory");
#pragma unroll
            for (int r = 0; r < 16; ++r) { const float v = o[d][r] * inv - lam * xp[(d * 16 + r) * 64]; o[d][r] = v; ss += v * v; }
        }
        ss = pairsum(ss);
        const float rs = rsqrtf(ss * (1.f / 128.f) + EPS) * (1.f - lam_init);
        const float* g = a.in[I_ASUB] + l * 128;
        { f32x4 gv[16];
#pragma unroll
          for (int d = 0; d < 4; ++d)
#pragma unroll
              for (int gq = 0; gq < 4; ++gq) gv[d * 4 + gq] = *(const f32x4*)(g + d * 32 + 8 * gq + 4 * hi);
          __builtin_amdgcn_sched_barrier(0);
#pragma unroll
          for (int d = 0; d < 4; ++d)
#pragma unroll
              for (int gq = 0; gq < 4; ++gq)
#pragma unroll
                  for (int j = 0; j < 4; ++j) o[d][4 * gq + j] *= gv[d * 4 + gq][j]; }
        store_o(lds + 65536 + (wave & 3) * 8704, (bf16_t*)(ws + WS_MIXO) + (size_t)(b * SEQ + wq0) * DM + h * 128, o, rs, lane);
    }
}

template <int DBG>
__device__ __forceinline__ void attnB_unit(const Args& a, int unit, LAS unsigned char* lds) {
    unsigned char* ws = a.ws;
    const int tid = ltid(), wave = tid >> 6, lane = tid & 63, l31 = lane & 31, hi = lane >> 5;
    const int jb = 7 - unit / 20, bh = unit % 20, b = bh / 5, h = bh % 5, q0 = jb * 256;
    const int wq0 = q0 + wave * 32, qpos = wq0 + l31;
    const bf16_t* kg = (const bf16_t*)(ws + WS_KB) + (size_t)(b * 5 + h) * SEQ * 128;
    const bf16_t* vtg = (const bf16_t*)(ws + WS_VBT) + (size_t)(b * 5 + h) * 128 * SEQ;
    const bf16_t* qrow = (const bf16_t*)(ws + WS_QB) + ((size_t)(b * 5 + h) * SEQ + qpos) * 128;
    unsigned sel = 0u;
    if (jb <= 3) sel = (1u << jb) - 1u;
    else {
        float qv[64];
#pragma unroll
        for (int ks = 0; ks < 8; ++ks) { const u32x4 w = *(const u32x4*)(qrow + ks * 16 + 8 * hi);
#pragma unroll
            for (int j = 0; j < 4; ++j) { qv[ks * 8 + 2 * j] = bflo(w[j]); qv[ks * 8 + 2 * j + 1] = bfhi(w[j]); } }
        LAS float* kml = (LAS float*)(lds + 108544);
        { const float* km = (const float*)(ws + WS_KMEAN) + (size_t)(b * 5 + h) * 8 * 128; const float k0 = km[tid], k1 = km[tid + 512]; kml[tid] = k0; kml[tid + 512] = k1; }
        __syncthreads();
        float gt[7];
#pragma unroll
        for (int n = 0; n < 7; ++n) {
            float sgate = -INFINITY;
            if (n < jb) {
                f32x4 kv[16];
#pragma unroll
                for (int ks = 0; ks < 8; ++ks) { kv[2 * ks] = *(const LAS f32x4*)(kml + n * 128 + ks * 16 + 8 * hi); kv[2 * ks + 1] = *(const LAS f32x4*)(kml + n * 128 + ks * 16 + 8 * hi + 4); }
                __builtin_amdgcn_sched_barrier(0);
                float sacc = 0.f;
#pragma unroll
                for (int ks = 0; ks < 8; ++ks)
#pragma unroll
                    for (int j = 0; j < 4; ++j) { sacc = fmaf(qv[ks * 8 + j], kv[2 * ks][j], sacc); sacc = fmaf(qv[ks * 8 + 4 + j], kv[2 * ks + 1][j], sacc); }
                sgate = pairsum(sacc); }
            gt[n] = sgate;
        }
#pragma unroll
        for (int pick = 0; pick < 3; ++pick) { float best = -INFINITY; int bi = 0;
#pragma unroll
            for (int n = 0; n < 7; ++n) { const bool ok = (n < jb) && !((sel >> n) & 1u) && (gt[n] > best); best = ok ? gt[n] : best; bi = ok ? n : bi; }
            sel |= 1u << bi; }
    }
    f32x16 o[4]; float lsum;
    attn_core<128, 1, DBG>(lds, kg, vtg, DBG == 10 ? 1 : DBG == 20 ? ((q0 + 256) / 64 < 16 ? (q0 + 256) / 64 : 16) : DBG == 21 ? ((q0 + 256) / 64 < 8 ? (q0 + 256) / 64 : 8) : (q0 + 256) / 64, qrow, 0, qpos, wq0 + 31, sel, q0, nullptr, o, lsum);
    store_o(lds + wave * 8704, (bf16_t*)(ws + (DBG ? WS_XM : WS_MIXO)) + (size_t)(b * SEQ + wq0) * DM + 768 + h * 128, o, 1.f / lsum, lane);
}

__device__ __forceinline__ void attnC_unit(const Args& a, int unit, LAS unsigned char* lds) {
    unsigned char* ws = a.ws;
    const int tid = ltid(), wave = tid >> 6, lane = tid & 63, l31 = lane & 31, hi = lane >> 5;
    const int jb = 7 - unit / 20, bh = unit % 20, b = bh / 5, h = bh % 5, q0 = jb * 256;
    const int wq0 = q0 + wave * 32, qpos = wq0 + l31;
    const bf16_t* kg = (const bf16_t*)(ws + WS_KC) + (size_t)b * SEQ * 128;
    const bf16_t* vtg = (const bf16_t*)(ws + WS_VCT) + (size_t)b * 128 * SEQ;
    const bf16_t* qrow = (const bf16_t*)(ws + WS_QC) + ((size_t)(b * 5 + h) * SEQ + qpos) * 128;
    const unsigned* mrow = (const unsigned*)(ws + WS_MASK) + (size_t)(b * SEQ + qpos) * 64;
    f32x16 o[4]; float lsum;
    attn_core<128, 2>(lds, kg, vtg, (q0 + 256) / 64, qrow, 0, qpos, wq0 + 31, 0u, 0, mrow, o, lsum);
    store_o(lds + wave * 8704, (bf16_t*)(ws + WS_MIXO) + (size_t)(b * SEQ + wq0) * DM + 1408 + h * 128, o, 1.f / lsum, lane);
}

__device__ __forceinline__ float sel8(const float* v, int i) {
    float r = v[0];
#pragma unroll
    for (int k = 1; k < 8; ++k) r = (i == k) ? v[k] : r;
    return r;
}
__device__ __forceinline__ void p6_router(const Args& a, int l, LAS unsigned char* lds) {
    unsigned char* ws = a.ws;
    const int G = gridDim.x, bx = blockIdx.x, tid = ltid(), wave = tid >> 6, lane = tid & 63, l31 = lane & 31, hi = lane >> 5;
    const bf16_t* XM = (const bf16_t*)(ws + WS_XM); const bf16_t* WRH = (const bf16_t*)(ws + WS_WR) + (size_t)l * 64 * DM; const bf16_t* WRL = WRH + (size_t)NL * 64 * DM;
    unsigned* cnt = (unsigned*)(ws + WS_CTL) + CW_CNT + l * 32;
    int* LIST = (int*)(ws + WS_LIST); float* LISTG = (float*)(ws + WS_LISTG); int* TOKE = (int*)(ws + WS_TOKE); int* TOKP = (int*)(ws + WS_TOKP);
    LAS float* red = (LAS float*)lds;
    LAS float* ssred = (LAS float*)(lds + 65536);
    LAS float* lg = (LAS float*)(lds + 65536 + 1024);
    LAS int* lcnt = (LAS int*)(lds + 65536 + 1024 + 8192);
    LAS float* mxred = (LAS float*)(lds + 65536 + 1024 + 8192 + 512);
    for (int tb = bx; tb < NT / 32; tb += G) {
        const int tok0 = tb * 32;
        f32x16 acc0, acc1;
#pragma unroll
        for (int r = 0; r < 16; ++r) { acc0[r] = 0.f; acc1[r] = 0.f; }
        float ss = 0.f, mx = 0.f;
        const bf16_t* xp = XM + (size_t)(tok0 + l31) * DM + wave * 256 + 8 * hi;
        const bf16_t* h0 = WRH + (size_t)l31 * DM + wave * 256 + 8 * hi; const bf16_t* h1 = h0 + (size_t)32 * DM;
        const bf16_t* q0 = WRL + (size_t)l31 * DM + wave * 256 + 8 * hi; const bf16_t* q1 = q0 + (size_t)32 * DM;
        if (tid < 32) lcnt[tid] = 0;
#pragma unroll 4
        for (int st = 0; st < 16; ++st) {
            const u32x4 xw = *(const u32x4*)(xp + st * 16);
            const bf16x8 xa = __builtin_bit_cast(bf16x8, xw), bh0 = *(const bf16x8*)(h0 + st * 16), bh1 = *(const bf16x8*)(h1 + st * 16), bl0 = *(const bf16x8*)(q0 + st * 16), bl1 = *(const bf16x8*)(q1 + st * 16);
#pragma unroll
            for (int j = 0; j < 4; ++j) { const float a0 = bflo(xw[j]), a1 = bfhi(xw[j]); ss += a0 * a0 + a1 * a1; mx = fmaxf(mx, fmaxf(__builtin_fabsf(a0), __builtin_fabsf(a1))); }
            acc0 = __builtin_amdgcn_mfma_f32_32x32x16_bf16(xa, bh0, acc0, 0, 0, 0); acc1 = __builtin_amdgcn_mfma_f32_32x32x16_bf16(xa, bh1, acc1, 0, 0, 0);
            acc0 = __builtin_amdgcn_mfma_f32_32x32x16_bf16(xa, bl0, acc0, 0, 0, 0); acc1 = __builtin_amdgcn_mfma_f32_32x32x16_bf16(xa, bl1, acc1, 0, 0, 0);
        }
#pragma unroll
        for (int r = 0; r < 16; ++r) { const int trow = (r & 3) + 8 * (r >> 2) + 4 * hi;
            red[(wave * 32 + trow) * 64 + l31] = acc0[r]; red[(wave * 32 + trow) * 64 + 32 + l31] = acc1[r]; }
        ss = pairsum(ss); mx = pairmax(mx);
        if (hi == 0) { ssred[wave * 32 + l31] = ss; mxred[wave * 32 + l31] = mx; }
        __syncthreads();
        { const int t = tid >> 4, c4 = (tid & 15) * 4;
          f32x4 sum = {0.f, 0.f, 0.f, 0.f}; float st = 0.f, mt = 0.f;
#pragma unroll
          for (int w = 0; w < 8; ++w) { sum += *(const LAS f32x4*)(red + (w * 32 + t) * 64 + c4); st += ssred[w * 32 + t]; mt = fmaxf(mt, mxred[w * 32 + t]); }
          const float rs = rsqrtf(st * (1.f / DM) + EPS);
          if (c4 < 36) {
#pragma unroll
              for (int j = 0; j < 4; ++j) { const int c = c4 + j; const float bias = c < 32 ? a.in[I_BEXP][l * 32 + c] : a.in[I_BGRP][l * 4 + (c - 32)]; lg[t * 64 + c] = sum[j] * rs + bias; }
          }
          if (c4 == 60) { lg[t * 64 + 63] = rs; lg[t * 64 + 62] = mt; } }
        __syncthreads();
#pragma unroll 1
        for (int i = 0; i < 4; ++i) { const int t = wave * 4 + i; const float mrow = lg[t * 64 + 62]; const float inv = mrow > 0.f ? 127.f / mrow : 0.f;
            const bf16_t* xr = XM + (size_t)(tok0 + t) * DM + lane * 8; unsigned char* qr = ws + WS_XMB + (size_t)(tok0 + t) * DM + lane * 8;
            u32x4 xw8[4];
#pragma unroll
            for (int j = 0; j < 4; ++j) xw8[j] = *(const u32x4*)(xr + j * 512);
#pragma unroll
            for (int j = 0; j < 4; ++j) { const u32x4 w = xw8[j];
                u32x2 q = {q8_pack(bflo(w[0]) * inv, bfhi(w[0]) * inv, bflo(w[1]) * inv, bfhi(w[1]) * inv), q8_pack(bflo(w[2]) * inv, bfhi(w[2]) * inv, bflo(w[3]) * inv, bfhi(w[3]) * inv)};
                *(u32x2*)(qr + j * 512) = q; } }
        int e0 = 0, e1 = 0, lp0 = 0, lp1 = 0; float g0 = 0.f, g1 = 0.f;
        if (tid < 32) {
            const LAS float* L = lg + tid * 64;
            int gi = 0; float gm = L[32];
            for (int j = 1; j < 4; ++j) { const float v = L[32 + j]; if (v > gm) { gm = v; gi = j; } }
            float gs = 0.f;
            for (int j = 0; j < 4; ++j) gs += __expf(L[32 + j] - gm);
            const float gw = 1.f / gs;
            float em = L[gi * 8];
            for (int k = 1; k < 8; ++k) em = fmaxf(em, L[gi * 8 + k]);
            float es = 0.f;
            for (int k = 0; k < 8; ++k) es += __expf(L[gi * 8 + k] - em);
            const float ies = 1.f / es;
            int i0 = 0; float v0 = -1.f;
            for (int k = 0; k < 8; ++k) { const float p = __expf(L[gi * 8 + k] - em) * ies; if (p > v0) { v0 = p; i0 = k; } }
            int i1 = 0; float v1 = -1.f;
            for (int k = 0; k < 8; ++k) { const float p = __expf(L[gi * 8 + k] - em) * ies; if (k != i0 && p > v1) { v1 = p; i1 = k; } }
            const float inv = 1.f / (v0 + v1);
            g0 = gw * v0 * inv; g1 = gw * v1 * inv; e0 = gi * 8 + i0; e1 = gi * 8 + i1;
            lp0 = atomicAdd((int*)(lcnt + e0), 1); lp1 = atomicAdd((int*)(lcnt + e1), 1);
        }
        __syncthreads();
        if (tid < 32) { const int c = lcnt[tid]; lcnt[32 + tid] = c > 0 ? (int)atomicAdd(cnt + tid, (unsigned)c) : 0; }
        __syncthreads();
        if (tid < 32) {
            const int tok = tok0 + tid, p0 = lcnt[32 + e0] + lp0, p1 = lcnt[32 + e1] + lp1;
            LIST[(size_t)e0 * NT + p0] = tok; LISTG[(size_t)e0 * NT + p0] = g0; LIST[(size_t)e1 * NT + p1] = tok; LISTG[(size_t)e1 * NT + p1] = g1;
            TOKE[tok * 2] = e0; TOKE[tok * 2 + 1] = e1; TOKP[tok * 2] = p0; TOKP[tok * 2 + 1] = p1;
            ((float*)(ws + WS_RSTD2))[tok] = lg[tid * 64 + 63] * lg[tid * 64 + 62] * (1.f / 127.f);
        }
        __syncthreads();
    }
}

constexpr int SK_MAX = 0;
struct MoeTab { volatile LAS int* tpre; volatile LAS int* dcnt; volatile LAS int* skrows; volatile LAS int* skbase; volatile LAS int* ske; volatile LAS int* skn; };
__device__ __forceinline__ MoeTab moe_tab_ptrs(LAS unsigned char* lds) {
    MoeTab T; T.tpre = (volatile LAS int*)(lds + LDS_CTL + 64); T.dcnt = (volatile LAS int*)(lds + LDS_CTL + 256); T.skrows = (volatile LAS int*)(lds + LDS_CTL + 384);
    T.skbase = (volatile LAS int*)(lds + LDS_CTL + 512); T.ske = (volatile LAS int*)(lds + LDS_CTL + 640); T.skn = (volatile LAS int*)(lds + LDS_CTL + 768); return T;
}
__device__ __forceinline__ void moe_table(const Args& a, int l, const MoeTab& T) {
    const unsigned* cnt = (const unsigned*)(a.ws + WS_CTL) + CW_CNT + l * 32;
    const int tid = ltid();
    __syncthreads();
    if (tid < 32) T.dcnt[tid] = (int)ld_agent(cnt + tid);
    __syncthreads();
    if (tid == 0) { int acc = 0, nsk = 0;
#pragma unroll 1
        for (int e = 0; e < NE; ++e) { const int c = T.dcnt[e], f = c >> 8, rem = c & 255; const int sk = (rem > 0 && rem <= SK_MAX) ? rem : 0;
            T.tpre[e] = acc; acc += f + ((rem > SK_MAX) ? 1 : 0); T.dcnt[e] = sk ? (f << 8) : c; T.skrows[e] = sk; if (sk) { T.ske[nsk] = e; ++nsk; } }
        T.tpre[NE] = acc; *T.skn = nsk;
        int base = acc * 256;
#pragma unroll 1
        for (int i = 0; i < nsk; ++i) { T.skbase[T.ske[i]] = base; base += 64; } }
    __syncthreads();
}
__device__ __forceinline__ size_t moe_row(const MoeTab& T, int e, int pos) {
    const int d = T.dcnt[e]; return pos < d ? (size_t)T.tpre[e] * 256 + pos : (size_t)T.skbase[e] + (pos - d);
}

template <int NR, int NC, int U = 4, bool I8 = false>
__device__ __forceinline__ void wave_gemm(const bf16_t* const (&ap)[NR], const bf16_t* const (&bp)[NC], const int nr, const int nsteps, f32x4 (&acc)[NR][NC]) {
#pragma unroll
    for (int i = 0; i < NR; ++i)
#pragma unroll
        for (int j = 0; j < NC; ++j) acc[i][j] = (f32x4){0.f, 0.f, 0.f, 0.f};
#pragma unroll 1
    for (int s0 = 0; s0 < nsteps; s0 += U) {
        bf16x8 af[U][NR], bf[U][NC];
#pragma unroll
        for (int u = 0; u < U; ++u) {
#pragma unroll
            for (int i = 0; i < NR; ++i) if (i < nr) af[u][i] = *(const bf16x8*)(ap[i] + (s0 + u) * 32);
#pragma unroll
            for (int j = 0; j < NC; ++j) bf[u][j] = *(const bf16x8*)(bp[j] + (s0 + u) * 32);
        }
        __builtin_amdgcn_sched_barrier(0);
#pragma unroll
        for (int u = 0; u < U; ++u)
#pragma unroll
            for (int i = 0; i < NR; ++i) if (i < nr)
#pragma unroll
                for (int j = 0; j < NC; ++j) acc[i][j] = pg8::Mma1<I8>::f(bf[u][j], af[u][i], acc[i][j]);
    }
}

__device__ __forceinline__ void skinny_kiwi(const Args& a, int l, LAS unsigned char* lds) {
    unsigned char* ws = a.ws;
    const int G = gridDim.x, bx = blockIdx.x, tid = ltid(), wave = tid >> 6, lane = tid & 63, fr = lane & 15, fq = lane >> 4, rg = wave >> 2, kq = wave & 3;
    const unsigned char* XB = ws + WS_XB; const unsigned char* W = ws + WS_WIN + (size_t)l * NPAD * DM; bf16_t* PROJ = (bf16_t*)(ws + WS_PROJ);
    const float* csc = (const float*)(ws + WS_WINS) + (size_t)l * NPAD;
    LAS f32x4* red = (LAS f32x4*)lds;
    for (int rb = bx; rb < NT / 32; rb += G) {
        const int row = rb * 32 + rg * 16 + fr;
        const bf16_t* ap[1] = {(const bf16_t*)(XB + (size_t)row * DM + kq * 512 + 16 * fq)};
        const bf16_t* bp[5];
#pragma unroll
        for (int j = 0; j < 5; ++j) bp[j] = (const bf16_t*)(W + (size_t)(6144 + 16 * j + fr) * DM + kq * 512 + 16 * fq);
        f32x4 acc[1][5];
        wave_gemm<1, 5, 4, true>(ap, bp, 1, 8, acc);
#pragma unroll
        for (int j = 0; j < 5; ++j)
#pragma unroll
            for (int k = 0; k < 4; ++k) acc[0][j][k] = (float)__float_as_int(acc[0][j][k]);
        if (kq > 0) {
#pragma unroll
            for (int j = 0; j < 5; ++j) red[((rg * 3 + kq - 1) * 5 + j) * 64 + lane] = acc[0][j]; }
        __syncthreads();
        if (kq == 0) { const float rs = ((const float*)(ws + WS_RSTD1))[row];
#pragma unroll
            for (int j = 0; j < 5; ++j) { f32x4 v = acc[0][j];
#pragma unroll
                for (int k = 0; k < 3; ++k) v += red[((rg * 3 + k) * 5 + j) * 64 + lane];
                const f32x4 cb = *(const f32x4*)(csc + 6144 + 16 * j + 4 * fq);
#pragma unroll
                for (int k = 0; k < 4; ++k) v[k] = v[k] * rs * cb[k];
                u32x2 w = {cvt_pk(v[0], v[1]), cvt_pk(v[2], v[3])}; *(u32x2*)(PROJ + (size_t)row * NPAD + 6144 + 16 * j + 4 * fq) = w; } }
        __syncthreads();
    }
}

__device__ __forceinline__ void skinny_up(const Args& a, int l, LAS unsigned char* lds, const MoeTab& T) {
    unsigned char* ws = a.ws;
    const int G = gridDim.x, bx = blockIdx.x, tid = ltid(), wave = tid >> 6, lane = tid & 63, fr = lane & 15, fq = lane >> 4;
    const bf16_t* XMB = (const bf16_t*)(ws + WS_XMB); const int* LIST = (const int*)(ws + WS_LIST); const float* LISTG = (const float*)(ws + WS_LISTG);
    bf16_t* H = (bf16_t*)(ws + WS_H);
    const int ntask = (*T.skn) * 16;
    for (int bt = bx; bt < ntask; bt += G) {
        const int e = T.ske[bt >> 4], rows = T.skrows[e], p0 = T.dcnt[e];
        const int wt = (bt & 15) * 8 + wave, rg = wt >> 5, f0 = (wt & 31) * 16;
        if (rg * 16 < rows) {
            const bf16_t* W = (const bf16_t*)(ws + WS_W1) + ((size_t)(l * NE + e)) * 1024 * DM;
            int r = 16 * rg + fr; const bool rv = r < rows; r = rv ? r : rows - 1;
            const int tok = LIST[(size_t)e * NT + p0 + r];
            const bf16_t* ap[1] = {XMB + (size_t)tok * DM + 8 * fq};
            const bf16_t* bp[2];
            bp[0] = W + (size_t)((f0 >> 7) * 256 + (f0 & 127) + fr) * DM + 8 * fq; bp[1] = bp[0] + (size_t)128 * DM;
            f32x4 acc[1][2];
            wave_gemm<1, 2, 8>(ap, bp, 1, 64, acc);
            if (rv) { const float rs = ((const float*)(ws + WS_RSTD2))[tok], gv = LISTG[(size_t)e * NT + p0 + r]; const f32x4 g = acc[0][0] * rs, up = acc[0][1] * rs; float h[4];
#pragma unroll
                for (int q = 0; q < 4; ++q) { const float sg = g[q] / (1.f + __expf(-g[q])); h[q] = sg * up[q] * gv; }
                u32x2 w = {cvt_pk(h[0], h[1]), cvt_pk(h[2], h[3])}; *(u32x2*)(H + ((size_t)T.skbase[e] + r) * FF + f0 + 4 * fq) = w; }
        }
    }
}

__device__ __forceinline__ void skinny_down(const Args& a, int l, const MoeTab& T) {
    unsigned char* ws = a.ws;
    const int G = gridDim.x, bx = blockIdx.x, tid = ltid(), wave = tid >> 6, lane = tid & 63, fr = lane & 15, fq = lane >> 4;
    const bf16_t* H = (const bf16_t*)(ws + WS_H); bf16_t* Y = (bf16_t*)(ws + WS_Y);
    const int ntask = (*T.skn) * 8;
    for (int bt = bx; bt < ntask; bt += G) {
        const int e = T.ske[bt >> 3], rows = T.skrows[e], nr = (rows + 15) >> 4, n0 = (bt & 7) * 256 + wave * 32;
        const size_t rb = (size_t)T.skbase[e];
        const bf16_t* W = (const bf16_t*)(ws + WS_WD) + ((size_t)(l * NE + e)) * DM * FF;
        const bf16_t* ap[4];
#pragma unroll
        for (int i = 0; i < 4; ++i) { int r = 16 * i + fr; r = r < rows ? r : rows - 1; ap[i] = H + (rb + r) * FF + 8 * fq; }
        const bf16_t* bp[2] = {W + (size_t)(n0 + fr) * FF + 8 * fq, W + (size_t)(n0 + 16 + fr) * FF + 8 * fq};
        f32x4 acc[4][2];
        wave_gemm<4, 2>(ap, bp, nr, 16, acc);
#pragma unroll
        for (int i = 0; i < 4; ++i) { const int r = 16 * i + fr;
            if (r < rows) {
#pragma unroll
                for (int j = 0; j < 2; ++j) { const f32x4 v = acc[i][j]; u32x2 w = {cvt_pk(v[0], v[1]), cvt_pk(v[2], v[3])}; *(u32x2*)(Y + (rb + r) * DM + n0 + 16 * j + 4 * fq) = w; } } }
    }
}

__device__ __forceinline__ void p9_combine(const Args& a, int l, const MoeTab& T) {
    unsigned char* ws = a.ws;
    const int G = gridDim.x, bx = blockIdx.x, tid = ltid(), wave = tid >> 6, lane = tid & 63;
    const bf16_t* XM = (const bf16_t*)(ws + WS_XM); const bf16_t* Y = (const bf16_t*)(ws + WS_Y);
    const int* TOKE = (const int*)(ws + WS_TOKE); const int* TOKP = (const int*)(ws + WS_TOKP);
    float* xo = a.out; bf16_t* xh = (bf16_t*)(ws + WS_X1); const bool last = (l == NL - 1);
    unsigned char* XB = ws + WS_XB; float* RSTD1 = (float*)(ws + WS_RSTD1);
    constexpr int MAXR = 4;
    int rows[MAXR]; size_t ra[MAXR], rb[MAXR]; int nr = 0;
#pragma unroll
    for (int k = 0; k < MAXR; ++k) { const int row = bx * 8 + wave + k * G * 8; rows[k] = row; ra[k] = 0; rb[k] = 0;
        if (row < NT) { nr = k + 1; const int e0 = TOKE[row * 2], e1 = TOKE[row * 2 + 1]; ra[k] = moe_row(T, e0, TOKP[row * 2]); rb[k] = moe_row(T, e1, TOKP[row * 2 + 1]); } }
    u32x4 xa[4], ya[4], yb[4], xn[4], yn[4], zn[4];
#define CMB_LOAD(K, XA, YA, YB) do { _Pragma("unroll") for (int i = 0; i < 4; ++i) { const int c = i * 512 + lane * 8; \
        XA[i] = *(const u32x4*)(XM + (size_t)rows[K] * DM + c); YA[i] = *(const u32x4*)(Y + ra[K] * DM + c); YB[i] = *(const u32x4*)(Y + rb[K] * DM + c); } } while (0)
#pragma unroll
    for (int i = 0; i < 4; ++i) { xa[i] = (u32x4){0u, 0u, 0u, 0u}; ya[i] = xa[i]; yb[i] = xa[i]; xn[i] = xa[i]; yn[i] = xa[i]; zn[i] = xa[i]; }
    if (nr > 0) CMB_LOAD(0, xa, ya, yb);
#pragma unroll
    for (int k = 0; k < MAXR; ++k) {
        if (k < nr) {
            const int row = rows[k];
            if (k + 1 < MAXR && k + 1 < nr) CMB_LOAD(k + 1, xn, yn, zn);
            __builtin_amdgcn_sched_barrier(0);
            float ss = 0.f, mx = 0.f; f32x4 xv[4][2];
#pragma unroll
            for (int i = 0; i < 4; ++i) { const int c = i * 512 + lane * 8;
#pragma unroll
                for (int h = 0; h < 2; ++h) { const unsigned x0 = xa[i][2 * h], x1 = xa[i][2 * h + 1], p0 = ya[i][2 * h], p1 = ya[i][2 * h + 1], q0 = yb[i][2 * h], q1 = yb[i][2 * h + 1];
                    f32x4 v = {(bflo(x0) + bflo(p0)) + bflo(q0), (bfhi(x0) + bfhi(p0)) + bfhi(q0), (bflo(x1) + bflo(p1)) + bflo(q1), (bfhi(x1) + bfhi(p1)) + bfhi(q1)};
                    xv[i][h] = v;
                    ss += v[0] * v[0] + v[1] * v[1] + v[2] * v[2] + v[3] * v[3];
                    mx = fmaxf(fmaxf(mx, fmaxf(__builtin_fabsf(v[0]), __builtin_fabsf(v[1]))), fmaxf(__builtin_fabsf(v[2]), __builtin_fabsf(v[3]))); }
                if (last) { *(f32x4*)(xo + (size_t)row * DM + c) = xv[i][0]; *(f32x4*)(xo + (size_t)row * DM + c + 4) = xv[i][1]; }
                else { u32x4 w = {cvt_pk(xv[i][0][0], xv[i][0][1]), cvt_pk(xv[i][0][2], xv[i][0][3]), cvt_pk(xv[i][1][0], xv[i][1][1]), cvt_pk(xv[i][1][2], xv[i][1][3])}; *(u32x4*)(xh + (size_t)row * DM + c) = w; } }
            if (l < NL - 1) {
                ss = wave_sum(ss); mx = wave_max(mx);
                const float inv = mx > 0.f ? 127.f / mx : 0.f;
#pragma unroll
                for (int i = 0; i < 4; ++i) { const f32x4 v0 = xv[i][0], v1 = xv[i][1];
                    u32x2 q = {q8_pack(v0[0] * inv, v0[1] * inv, v0[2] * inv, v0[3] * inv), q8_pack(v1[0] * inv, v1[1] * inv, v1[2] * inv, v1[3] * inv)};
                    *(u32x2*)(XB + (size_t)row * DM + i * 512 + lane * 8) = q; }
                if (lane == 0) RSTD1[row] = rsqrtf(ss * (1.f / DM) + EPS) * mx * (1.f / 127.f);
            }
#pragma unroll
            for (int i = 0; i < 4; ++i) { xa[i] = xn[i]; ya[i] = yn[i]; yb[i] = zn[i]; }
        }
    }
#undef CMB_LOAD
}

constexpr int N_PHASES = 1 + 9 * NL;
typedef const Args __attribute__((address_space(4)))* ArgsP;
#define PHASE_FN static __device__ __forceinline__ void
__device__ __forceinline__ Args ld_args(ArgsP ap) {
    Args a;
#pragma unroll
    for (int i = 0; i < 21; ++i) a.in[i] = ap->in[i];
    a.out = ap->out; a.ws = ap->ws; a.ph_lo = ap->ph_lo; a.ph_hi = ap->ph_hi; return a;
}

PHASE_FN ph_prologue(ArgsP ap, LAS unsigned char* lds) { asm volatile("" : "+s"(ap)); const Args a = ld_args(ap); p0_prologue(a, lds); }
PHASE_FN ph_inproj(ArgsP ap, LAS unsigned char* lds, int l) {
    asm volatile("" : "+s"(ap)); const Args a = ld_args(ap); unsigned char* ws = a.ws;
    pg8::DenseSched S; S.init(ws + WS_XB, ws + WS_WIN + (size_t)l * NPAD * DM, NT, 6144, DM / 2, gridDim.x, blockIdx.x);
    EpiProj E{(bf16_t*)(ws + WS_PROJ), (const float*)(ws + WS_RSTD1), (const float*)(ws + WS_WINS) + (size_t)l * NPAD};
    pg8::gemm_phase(lds, DM / 2, S, E);
    skinny_kiwi(a, l, lds);
    if (REPEAT_PH == 11) { skinny_kiwi(a, l, lds); skinny_kiwi(a, l, lds); }
}
PHASE_FN ph_prep(ArgsP ap, LAS unsigned char* lds, int l) { asm volatile("" : "+s"(ap)); const Args a = ld_args(ap); p2_prep(a, l, lds); }
PHASE_FN ph_idx(ArgsP ap, LAS unsigned char* lds, int l, int rep) {
    asm volatile("" : "+s"(ap)); const Args a = ld_args(ap); unsigned* qh = (unsigned*)(a.ws + WS_CTL) + CW_Q + l * 8 * 64; volatile LAS int* slot = (volatile LAS int*)(lds + LDS_CTL + 32);
    for (;;) { const int u = next_unit(qh + (0 + 4 * rep) * 64, slot); if (u >= 512) break; idx_unit(a, u, lds); }
}
PHASE_FN ph_attnA(ArgsP ap, LAS unsigned char* lds, int l, int rep) {
    asm volatile("" : "+s"(ap)); const Args a = ld_args(ap); unsigned* qh = (unsigned*)(a.ws + WS_CTL) + CW_Q + l * 8 * 64; volatile LAS int* slot = (volatile LAS int*)(lds + LDS_CTL + 32);
    for (;;) { const int u = next_unit(qh + (1 + 4 * rep) * 64, slot); if (u >= 384) break; attnA_unit(a, l, u, lds); }
}
template <int DBG>
PHASE_FN ph_attnB(ArgsP ap, LAS unsigned char* lds, int l, int rep) {
    asm volatile("" : "+s"(ap)); const Args a = ld_args(ap); unsigned* qh = (unsigned*)(a.ws + WS_CTL) + CW_Q + l * 8 * 64; volatile LAS int* slot = (volatile LAS int*)(lds + LDS_CTL + 32);
    for (;;) { const int u = next_unit(qh + (2 + 4 * rep) * 64, slot); if (u >= 160) break; attnB_unit<DBG>(a, u, lds); }
}
PHASE_FN ph_attnC(ArgsP ap, LAS unsigned char* lds, int l, int rep) {
    asm volatile("" : "+s"(ap)); const Args a = ld_args(ap); unsigned* qh = (unsigned*)(a.ws + WS_CTL) + CW_Q + l * 8 * 64; volatile LAS int* slot = (volatile LAS int*)(lds + LDS_CTL + 32);
    for (;;) { const int u = next_unit(qh + (3 + 4 * rep) * 64, slot); if (u >= 160) break; attnC_unit(a, u, lds); }
}
PHASE_FN ph_attX(ArgsP ap, LAS unsigned char* lds, int l, int rep) {
    volatile LAS int* slot = (volatile LAS int*)(lds + LDS_CTL + 32);
    for (;;) {
        asm volatile("" : "+s"(ap)); const Args a = ld_args(ap); unsigned* qh = (unsigned*)(a.ws + WS_CTL) + CW_Q + l * 8 * 64;
        const int u = __builtin_amdgcn_readfirstlane(next_unit(qh + (0 + 4 * rep) * 64, slot)); if (u >= 672) break;
        const int g = u / 84, r = u - g * 84;
        if (r >= 20) idx_unit(a, g * 64 + (r - 20), lds);
        else attnB_unit<0>(a, g * 20 + r, lds);
    }
}
PHASE_FN ph_attY(ArgsP ap, LAS unsigned char* lds, int l, int rep) {
    volatile LAS int* slot = (volatile LAS int*)(lds + LDS_CTL + 32);
    for (;;) {
        asm volatile("" : "+s"(ap)); const Args a = ld_args(ap); unsigned* qh = (unsigned*)(a.ws + WS_CTL) + CW_Q + l * 8 * 64;
        const int u = __builtin_amdgcn_readfirstlane(next_unit(qh + (1 + 4 * rep) * 64, slot)); if (u >= 544) break;
        const int g = u / 68, r = u - g * 68;
        if (r < 20) attnC_unit(a, g * 20 + r, lds);
        else attnA_unit(a, l, g * 48 + (r - 20), lds);
    }
}
PHASE_FN ph_outproj(ArgsP ap, LAS unsigned char* lds, int l) {
    asm volatile("" : "+s"(ap)); const Args a = ld_args(ap); unsigned char* ws = a.ws;
    pg8::DenseSched S; S.init(ws + WS_MIXO, ws + WS_WOUT + (size_t)l * DM * DM * 2, NT, DM, DM, gridDim.x, blockIdx.x);
    EpiOut E{(const bf16_t*)(ws + WS_X1), (bf16_t*)(ws + WS_XM)};
    pg8::gemm_phase(lds, DM, S, E);
}
PHASE_FN ph_router(ArgsP ap, LAS unsigned char* lds, int l) { asm volatile("" : "+s"(ap)); const Args a = ld_args(ap); p6_router(a, l, lds); }
PHASE_FN ph_moe_up(ArgsP ap, LAS unsigned char* lds, int l) {
    asm volatile("" : "+s"(ap)); const Args a = ld_args(ap); unsigned char* ws = a.ws;
    const MoeTab T = moe_tab_ptrs(lds);
    const int G = gridDim.x, bx = blockIdx.x; const int vcu = (G % 8 == 0) ? (bx % 8) * (G / 8) + bx / 8 : bx;
    moe_table(a, l, T);
    pg8::MoeSched<true> S{(const char*)(ws + WS_XMB), (const char*)(ws + WS_W1 + (size_t)l * NE * 1024 * DM), (const int*)(ws + WS_LIST), T.tpre, T.dcnt, DM / 2, 4, T.tpre[NE], G, vcu, (size_t)1024 * DM};
    EpiUp E{(bf16_t*)(ws + WS_H), (const int*)(ws + WS_LIST), (const float*)(ws + WS_LISTG), (const float*)(ws + WS_RSTD2), T.tpre, (const float*)(ws + WS_W1S) + (size_t)l * NE * 1024};
    pg8::gemm_phase(lds, DM / 2, S, E);
}
PHASE_FN ph_moe_down(ArgsP ap, LAS unsigned char* lds, int l) {
    asm volatile("" : "+s"(ap)); const Args a = ld_args(ap); unsigned char* ws = a.ws;
    const MoeTab T = moe_tab_ptrs(lds);
    const int G = gridDim.x, bx = blockIdx.x; const int vcu = (G % 8 == 0) ? (bx % 8) * (G / 8) + bx / 8 : bx;
    moe_table(a, l, T);
    pg8::MoeSched<false> S{(const char*)(ws + WS_H), (const char*)(ws + WS_WD + (size_t)l * NE * DM * FF * 2), nullptr, T.tpre, T.dcnt, FF, 8, T.tpre[NE], G, vcu, (size_t)DM * FF * 2};
    EpiDown E{(bf16_t*)(ws + WS_Y), T.tpre};
    pg8::gemm_phase(lds, FF, S, E);
}
PHASE_FN ph_deferred(ArgsP ap, LAS unsigned char* lds, int which) {
    asm volatile("" : "+s"(ap)); const Args a = ld_args(ap);
    const MoeTab T = moe_tab_ptrs(lds);
    const int G = gridDim.x, bx = blockIdx.x; const int vcu = (G % 8 == 0) ? (bx % 8) * (G / 8) + bx / 8 : bx;
    const int nunits = T.tpre[NE] * (which == 2 ? 8 : 4), e = nunits % G;
    const int DLO = which == 2 ? DEF3_LO : which ? DEF2_LO : DEF_LO, DN = which == 2 ? DEF3_N : which ? DEF2_N : DEF_N, QUOTA = which == 2 ? DEF3_QUOTA : DEF_QUOTA;
    const int ns = (e == 0) ? G : G - e;
    if (which != 1) {
        const bool idle = (e == 0) || (vcu >= e); const int rank = (e == 0) ? vcu : vcu - e;
        int t, lim, step, base, t2, lim2;
        if (which == 0) { int q1 = ns * 2; q1 = q1 < STRIP_DEF_N ? q1 : STRIP_DEF_N; base = STRIP_PRO_L0; t = idle ? rank : q1; lim = q1; step = ns; t2 = q1 + vcu; lim2 = STRIP_DEF_N; }
        else { const int nsw = ns < 100 ? ns : 100; base = NSTRIP + 100; t = (idle && rank < nsw) ? rank : 100; lim = 100; step = nsw; t2 = 100; lim2 = 100; }
        bool second = false;
        for (;;) {
            if (t >= lim) { if (second) break; second = true; t = t2; lim = lim2; step = G; continue; }
            cvt_strip(a, lds, base + t); t += step;
        }
        if (which == 2) { constexpr int WOUT1_LO = NL * NE * 2 * 16 * 8 + NL * NE * 4 * 32 + NL * 16 * 100 + 16 * 32;
            const int nsw = ns < 100 ? ns : 100, ntw = ns - nsw;
            if (ntw > 0) { if (idle && rank >= nsw) cvt_deferred(a, lds, rank - nsw, ntw, WOUT1_LO, 0, 16 * 32); }
            else cvt_deferred(a, lds, vcu, G, WOUT1_LO, 0, 16 * 32); }
        return;
    }
    int p1 = ns * QUOTA; p1 = p1 < DN ? p1 : DN;
    if (e == 0) cvt_deferred(a, lds, vcu, G, DLO, 0, p1);
    else if (vcu >= e) cvt_deferred(a, lds, vcu - e, ns, DLO, 0, p1);
    if (p1 < DN) cvt_deferred(a, lds, vcu, G, DLO, p1, DN - p1);
}
PHASE_FN ph_combine(ArgsP ap, LAS unsigned char* lds, int l) {
    asm volatile("" : "+s"(ap)); const Args a = ld_args(ap);
    const MoeTab T = moe_tab_ptrs(lds);
    moe_table(a, l, T);
    p9_combine(a, l, T);
}

__global__ void __launch_bounds__(NTHR, 2) mk_fwd(Args a_unused) {
    extern __shared__ __attribute__((aligned(16))) unsigned char lds_raw[];
    LAS unsigned char* lds = (LAS unsigned char*)lds_raw;
    volatile LAS unsigned* lctl = (volatile LAS unsigned*)(lds + LDS_CTL);
    ArgsP ap = (ArgsP)__builtin_amdgcn_kernarg_segment_ptr();
    { const int t0 = (int)threadIdx.x; if (t0 < 128) lctl[t0] = 0u; if ((t0 & 63) == 0) *(volatile LAS int*)(size_t)(LDS_WTAB + hw_slot() * 4) = t0 >> 6; }
    __syncthreads();
    unsigned* ctl = (unsigned*)(ap->ws + WS_CTL);
    const int lo = ap->ph_lo, hi = ap->ph_hi;
    XcdBarrier bar; bar.bar = ctl + CW_BAR; bar.x = 0; bar.st = lctl;
    if (hi - lo > 1) bar = xcd_barrier_post(ctl + CW_BAR, lctl);
#define IN(k) (lo <= (k) && (k) < hi)
#define SEAM(k) do { if (IN(k) && IN((k) + 1)) xcd_barrier(bar); } while (0)
#ifndef REPEAT_PH
#define REPEAT_PH -1
#endif
#ifndef REPEAT_N
#define REPEAT_N 2
#endif
#define NREP(k) ((REPEAT_PH == (k)) ? REPEAT_N : 1)
#define RSEAM(k, r, n) do { if ((r) + 1 < (n)) xcd_barrier(bar); else SEAM(k); } while (0)
    if (IN(0)) { ph_prologue(ap, lds); SEAM(0); }
    for (int l = 0; l < NL; ++l) {
        const int pb = 1 + 9 * l;
        if (IN(pb + 0)) { for (int r = 0; r < NREP(1); ++r) { ph_inproj(ap, lds, l); RSEAM(pb + 0, r, NREP(1)); } }
        if (IN(pb + 1)) { for (int r = 0; r < NREP(2); ++r) { ph_prep(ap, lds, l); RSEAM(pb + 1, r, NREP(2)); } }
        if (IN(pb + 2)) { for (int r = 0; r < NREP(3); ++r) { ph_attX(ap, lds, l, r); RSEAM(pb + 2, r, NREP(3)); }
            if (REPEAT_PH == 31) { xcd_barrier(bar); ph_idx(ap, lds, l, 1); }
            if (REPEAT_PH == 32) { xcd_barrier(bar); ph_attnA(ap, lds, l, 1); } }
        if (IN(pb + 3)) { for (int r = 0; r < NREP(4); ++r) { ph_attY(ap, lds, l, r); RSEAM(pb + 3, r, NREP(4)); }
            if (REPEAT_PH == 41) { xcd_barrier(bar); ph_attnB<DBG_VAR>(ap, lds, l, 1); xcd_barrier(bar); }
            if (REPEAT_PH == 42) { xcd_barrier(bar); ph_attnC(ap, lds, l, 1); } }
        if (IN(pb + 4)) { for (int r = 0; r < NREP(5); ++r) { ph_outproj(ap, lds, l); RSEAM(pb + 4, r, NREP(5)); } }
        if (IN(pb + 5)) { ph_router(ap, lds, l); SEAM(pb + 5); }
        if (IN(pb + 6)) { for (int r = 0; r < NREP(7); ++r) { ph_moe_up(ap, lds, l); if (r == 0) ph_deferred(ap, lds, l); RSEAM(pb + 6, r, NREP(7)); } }
        if (IN(pb + 7)) { for (int r = 0; r < NREP(8); ++r) { ph_moe_down(ap, lds, l); if (r == 0 && l == 0) ph_deferred(ap, lds, 2); RSEAM(pb + 7, r, NREP(8)); } }
        if (IN(pb + 8)) { for (int r = 0; r < NREP(9); ++r) { ph_combine(ap, lds, l); RSEAM(pb + 8, r, NREP(9)); } }
    }
#undef IN
#undef SEAM
}

extern "C" void kernel_launch(void* const* d_in, const int* in_sizes, int n_in, void* d_out, int out_size, void* d_ws, size_t ws_size, hipStream_t stream) {
    static int grid = 0;
    if (grid == 0) {
        if (n_in != 21 || out_size != NT * DM || ws_size < WS_END) { fprintf(stderr, "kernel_launch: unexpected problem (n_in %d, out %d, ws %zu < %zu)\n", n_in, out_size, ws_size, (size_t)WS_END); grid = -1; return; }
        int dev = 0, cus = 0, per_cu = 0;
        if (hipGetDevice(&dev) != hipSuccess || hipDeviceGetAttribute(&cus, hipDeviceAttributeMultiprocessorCount, dev) != hipSuccess) { grid = -1; return; }
        if (hipFuncSetAttribute((const void*)mk_fwd, hipFuncAttributeMaxDynamicSharedMemorySize, LDS_BYTES) != hipSuccess) { fprintf(stderr, "kernel_launch: hipFuncSetAttribute failed\n"); grid = -1; return; }
        if (hipOccupancyMaxActiveBlocksPerMultiprocessor(&per_cu, (const void*)mk_fwd, NTHR, LDS_BYTES) != hipSuccess || per_cu < 1) { fprintf(stderr, "kernel_launch: occupancy query says %d\n", per_cu); }
        (void)hipGetLastError();
        grid = cus;
    }
    if (grid < 0) return;
    (void)hipMemsetAsync((char*)d_ws + WS_CTL, 0, CTL_BYTES, stream);
    Args a{};
    for (int i = 0; i < 21; ++i) a.in[i] = (const float*)d_in[i];
    a.out = (float*)d_out; a.ws = (unsigned char*)d_ws;
#if MK_ONE_LAUNCH
    a.ph_lo = 0; a.ph_hi = N_PHASES;
    hipLaunchKernelGGL(mk_fwd, dim3(grid), dim3(NTHR), LDS_BYTES, stream, a);
#else
    for (int p = 0; p < N_PHASES; ++p) { a.ph_lo = p; a.ph_hi = p + 1; hipLaunchKernelGGL(mk_fwd, dim3(grid), dim3(NTHR), LDS_BYTES, stream, a); }
#endif
}
```
